# Optimizing an MI355X kernel written in HIP

```python
import jax, jax.numpy as jnp
from jax import lax
import numpy as np

D_MODEL = 1024
BATCH = 8
SEQ = 4096
DEPTH = 4

CTX_LEN = 256
GRID_W = 64

F_GROUPS = 4
F_GROUP_DIM = D_MODEL // 16
F_WIDTH = F_GROUPS * F_GROUP_DIM
G_HEADS = 4
G_HEAD_DIM = D_MODEL // 16
G_WIDTH = G_HEADS * G_HEAD_DIM
CHUNK = 128
A_HEADS = 8
A_NOPE = D_MODEL // 16
A_ROPE = D_MODEL // 32
A_V = D_MODEL // 16
A_QK = A_NOPE + A_ROPE
A_WIDTH = A_HEADS * A_V
Q_LORA = D_MODEL // 4
KV_LORA = D_MODEL // 8

MIX_WIDTH = F_WIDTH + G_WIDTH + A_WIDTH
IN_WIDTH = 2 * F_WIDTH + 3 * G_WIDTH + Q_LORA + KV_LORA + A_ROPE + A_WIDTH
ROPE_BASE = 10000.0
EPS = 1e-6
Q_BLOCK = 128

kernel_name = "hybrid_fourier_gmlp_mla_prefix_dit"


def _rmsnorm(t, g):
    tf = t.astype(jnp.float32)
    tf = tf * lax.rsqrt(jnp.mean(tf * tf, axis=-1, keepdims=True) + EPS)
    return (tf * g.astype(jnp.float32)).astype(t.dtype)


def _layernorm(t, g):
    tf = t.astype(jnp.float32)
    tf = tf - jnp.mean(tf, axis=-1, keepdims=True)
    tf = tf * lax.rsqrt(jnp.mean(tf * tf, axis=-1, keepdims=True) + EPS)
    return (tf * g.astype(jnp.float32)).astype(t.dtype)


def _split_in(p):
    sizes = (F_WIDTH, F_WIDTH, G_WIDTH, G_WIDTH, G_WIDTH, Q_LORA, KV_LORA, A_ROPE, A_WIDTH)
    parts = []
    start = 0
    for s in sizes:
        parts.append(p[..., start:start + s])
        start += s
    return parts


def _axial_rope(n):
    rows = n // GRID_W
    row = jnp.repeat(jnp.arange(rows, dtype=jnp.float32), GRID_W)
    col = jnp.tile(jnp.arange(GRID_W, dtype=jnp.float32), rows)
    half = A_ROPE // 2
    inv = ROPE_BASE ** (-jnp.arange(0, half, 2, dtype=jnp.float32) / half)
    ang_r = row[:, None] * inv[None, :]
    ang_c = col[:, None] * inv[None, :]
    ang = jnp.concatenate([ang_r, ang_r, ang_c, ang_c], axis=-1)
    return jnp.cos(ang), jnp.sin(ang)


def _apply_rope(t, rope):
    cos, sin = rope
    q = A_ROPE // 4
    x1, x2, x3, x4 = t[..., :q], t[..., q:2 * q], t[..., 2 * q:3 * q], t[..., 3 * q:]
    rot = jnp.concatenate([-x2, x1, -x4, x3], axis=-1)
    cos = cos[:, None, :].astype(t.dtype)
    sin = sin[:, None, :].astype(t.dtype)
    return t * cos + rot * sin


def _fourier(u):
    b, n, _ = u.shape
    ug = u.astype(jnp.float32).reshape(b, n, F_GROUPS, F_GROUP_DIM).transpose(0, 2, 1, 3)
    f = jnp.fft.fft2(ug, norm="ortho").real
    return f.transpose(0, 2, 1, 3).reshape(b, n, F_WIDTH).astype(u.dtype)


def _spatial_gate(u, v, ln_g, ws, bs):
    b, n, _ = v.shape
    vh = v.reshape(b, n // CHUNK, CHUNK, G_HEADS, G_HEAD_DIM)
    vh = _layernorm(vh, ln_g)
    mixed = jnp.einsum('hpq,bcqhd->bcphd', ws, vh) + bs.T[None, None, :, :, None]
    return u * mixed.reshape(b, n, G_WIDTH)


def _mla_qkv(c_q, c_kv, k_rope, q_a_g, w_uq, kv_a_g, w_ukv, q_norm_g, k_norm_g, rope):
    b, n, _ = c_q.shape
    q = (_rmsnorm(c_q, q_a_g) @ w_uq).reshape(b, n, A_HEADS, A_QK)
    kv = (_rmsnorm(c_kv, kv_a_g) @ w_ukv).reshape(b, n, A_HEADS, A_NOPE + A_V)
    k_nope, v = kv[..., :A_NOPE], kv[..., A_NOPE:]
    k_r = jnp.broadcast_to(k_rope[:, :, None, :], (b, n, A_HEADS, A_ROPE))
    k = jnp.concatenate([k_nope, k_r], axis=-1)
    q = _rmsnorm(q, q_norm_g)
    k = _rmsnorm(k, k_norm_g)
    if rope is not None:
        q = jnp.concatenate([q[..., :A_NOPE], _apply_rope(q[..., A_NOPE:], rope)], axis=-1)
        k = jnp.concatenate([k[..., :A_NOPE], _apply_rope(k[..., A_NOPE:], rope)], axis=-1)
    return q, k, v


def _branches(h, w_in, w_fmix, g_ln_g, g_ws, g_bs, q_a_g, w_uq, kv_a_g, w_ukv, q_norm_g, k_norm_g, rope):
    f_in, f_gate, g_u, g_v, g_gate, c_q, c_kv, k_rope, a_gate = _split_in(h @ w_in)
    f_out = (_fourier(f_in) @ w_fmix) * jax.nn.silu(f_gate)
    g_out = _spatial_gate(g_u, g_v, g_ln_g, g_ws, g_bs) * jax.nn.silu(g_gate)
    q, k, v = _mla_qkv(c_q, c_kv, k_rope, q_a_g, w_uq, kv_a_g, w_ukv, q_norm_g, k_norm_g, rope)
    return f_out, g_out, q, k, v, a_gate


def _attend(q, k, v):
    s = jnp.einsum('bqhd,bkhd->bhqk', q, k).astype(jnp.float32) * (A_QK ** -0.5)
    p = jax.nn.softmax(s, axis=-1).astype(v.dtype)
    return jnp.einsum('bhqk,bkhd->bqhd', p, v)


def _blocked_attention(q, k, v):
    b, n, h, d = q.shape
    nb = n // Q_BLOCK
    qb = q.reshape(b, nb, Q_BLOCK, h, d).transpose(1, 0, 2, 3, 4)
    o = lax.map(lambda blk: _attend(blk, k, v), qb)
    return o.transpose(1, 0, 2, 3, 4).reshape(b, n, h * A_V)


def setup_inputs(seed: int = 0) -> dict:
    key = jax.random.key(seed)
    ks = jax.random.split(key, 24)
    f32 = jnp.float32
    nrm = lambda k, shape, s: jax.random.normal(k, shape, f32) * s
    gain = lambda k, shape: 1.0 + 0.02 * jax.random.normal(k, shape, f32)
    return {
        "x": nrm(ks[0], (BATCH, SEQ, D_MODEL), 1.0),
        "c": nrm(ks[1], (BATCH, D_MODEL), 1.0),
        "ctx": nrm(ks[2], (BATCH, CTX_LEN, D_MODEL), 1.0),
        "c_ctx": nrm(ks[3], (D_MODEL,), 1.0),
        "w_mod": nrm(ks[4], (DEPTH, D_MODEL, 3 * D_MODEL), 0.5 * D_MODEL ** -0.5),
        "b_mod": nrm(ks[5], (DEPTH, 3 * D_MODEL), 0.01),
        "norm_g": gain(ks[6], (DEPTH, D_MODEL)),
        "w_in": nrm(ks[7], (DEPTH, D_MODEL, IN_WIDTH), D_MODEL ** -0.5),
        "w_fmix": nrm(ks[8], (DEPTH, F_WIDTH, F_WIDTH), F_WIDTH ** -0.5),
        "g_ln_g": gain(ks[9], (DEPTH, G_HEAD_DIM)),
        "g_ws": nrm(ks[10], (DEPTH, G_HEADS, CHUNK, CHUNK), CHUNK ** -0.5),
        "g_bs": 1.0 + nrm(ks[11], (DEPTH, G_HEADS, CHUNK), 0.01),
        "q_a_g": gain(ks[12], (DEPTH, Q_LORA)),
        "w_uq": nrm(ks[13], (DEPTH, Q_LORA, A_HEADS * A_QK), Q_LORA ** -0.5),
        "kv_a_g": gain(ks[14], (DEPTH, KV_LORA)),
        "w_ukv": nrm(ks[15], (DEPTH, KV_LORA, A_HEADS * (A_NOPE + A_V)), KV_LORA ** -0.5),
        "q_norm_g": gain(ks[16], (DEPTH, A_QK)),
        "k_norm_g": gain(ks[17], (DEPTH, A_QK)),
        "w_out": nrm(ks[18], (DEPTH, MIX_WIDTH, D_MODEL), MIX_WIDTH ** -0.5),
    }


def reference(x, c, ctx, c_ctx, w_mod, b_mod, norm_g, w_in, w_fmix, g_ln_g, g_ws, g_bs,
              q_a_g, w_uq, kv_a_g, w_ukv, q_norm_g, k_norm_g, w_out):
    n = x.shape[1]
    rope = _axial_rope(n)
    y = ctx
    silu_c = jax.nn.silu(c)
    silu_cc = jax.nn.silu(c_ctx)
    for l in range(DEPTH):
        shift, scale, gate = jnp.split(silu_c @ w_mod[l] + b_mod[l], 3, axis=-1)
        shift_c, scale_c, gate_c = jnp.split(silu_cc @ w_mod[l] + b_mod[l], 3, axis=-1)
        hx = _rmsnorm(x, norm_g[l]) * (1.0 + scale[:, None, :]) + shift[:, None, :]
        hy = _rmsnorm(y, norm_g[l]) * (1.0 + scale_c) + shift_c
        params = (w_in[l], w_fmix[l], g_ln_g[l], g_ws[l], g_bs[l], q_a_g[l], w_uq[l],
                  kv_a_g[l], w_ukv[l], q_norm_g[l], k_norm_g[l])
        fy, gy, qy, ky, vy, ay = _branches(hy, *params, None)
        fx, gx, qx, kx, vx, ax = _branches(hx, *params, rope)
        k_all = jnp.concatenate([ky, kx], axis=1)
        v_all = jnp.concatenate([vy, vx], axis=1)
        ox = _blocked_attention(qx, k_all, v_all) * jax.nn.silu(ax)
        x = x + gate[:, None, :] * (jnp.concatenate([fx, gx, ox], axis=-1) @ w_out[l])
        if l < DEPTH - 1:
            b = y.shape[0]
            oy = _attend(qy, ky, vy).reshape(b, y.shape[1], A_WIDTH) * jax.nn.silu(ay)
            y = y + gate_c * (jnp.concatenate([fy, gy, oy], axis=-1) @ w_out[l])
    return x
```

```cpp
#include <hip/hip_runtime.h>
#include <hip/hip_cooperative_groups.h>
#include <cstdio>
#include <cstdint>
namespace cg = cooperative_groups;

typedef unsigned short u16;
typedef __attribute__((ext_vector_type(8))) short bf16x8;
typedef __attribute__((ext_vector_type(16))) float f32x16;
typedef __attribute__((ext_vector_type(2))) __bf16 bf2_t;
typedef __attribute__((ext_vector_type(2))) float f2_t;
#define DI __device__ __forceinline__

constexpr int NB = 8, SEQ = 4096, DEPTH = 4, CTX = 256;
constexpr int MX = NB * SEQ, MY = NB * CTX, MT = MX + MY;
constexpr int NP = 2304, INW = 2208;
constexpr int C_FIN = 0, C_FGATE = 256, C_GU = 512, C_GV = 768, C_GGATE = 1024, C_CQ = 1280, C_CKV = 1536, C_KROPE = 1664, C_AGATE = 1696;
constexpr int KPOS = CTX + SEQ;
constexpr int NT_ = 512;
constexpr int PITCH = 144;
constexpr int LDS_BYTES = 131072;
constexpr int RSTD_OFF = 129024;
constexpr float EPS = 1e-6f;
constexpr float PI_F = 3.14159265358979323846f;

struct Params {
  const float *x, *c, *ctx, *c_ctx, *w_mod, *b_mod, *norm_g, *w_in, *w_fmix, *g_ln_g, *g_ws, *g_bs, *q_a_g, *w_uq, *kv_a_g, *w_ukv, *q_norm_g, *k_norm_g, *w_out;
  float* out;
  unsigned* bar;
  float *yw, *mod, *tw, *rope, *stats;
  u16 *win_t, *wout_t, *wuq_t, *wukv_t, *gws_b, *mf_t, *t1, *t2, *t256, *hmix, *p, *q, *k, *vt, *a1, *yf;
};

DI int ltid() { int t = threadIdx.x; asm volatile("" : "+v"(t)); return t; }
DI float bf2f(u16 v) { return __uint_as_float(((unsigned)v) << 16); }
DI unsigned pk2(float a, float b) { f2_t v = {a, b}; bf2_t r = __builtin_convertvector(v, bf2_t); return __builtin_bit_cast(unsigned, r); }
DI u16 f2bf(float a) { return (u16)(pk2(a, 0.f) & 0xffffu); }
DI float silu(float x) { return x / (1.f + __expf(-x)); }
DI int crow(int reg, int h) { return (reg & 3) + 8 * (reg >> 2) + 4 * h; }
DI float lo16(unsigned w) { return __uint_as_float(w << 16); }
DI float hi16(unsigned w) { return __uint_as_float(w & 0xffff0000u); }
DI f32x16 mfma(bf16x8 a, bf16x8 b, f32x16 c) { return __builtin_amdgcn_mfma_f32_32x32x16_bf16(a, b, c, 0, 0, 0); }
DI void unpack8(const uint4& v, float* f) {
  f[0] = lo16(v.x); f[1] = hi16(v.x); f[2] = lo16(v.y); f[3] = hi16(v.y);
  f[4] = lo16(v.z); f[5] = hi16(v.z); f[6] = lo16(v.w); f[7] = hi16(v.w);
}

#define XB_TMO      128
#define XB_XCNT(j)  (256  + 64 * (j))
#define XB_XSUB(j)  (1280 + 64 * (j))
#define XB_XGEN(j)  (2304 + 64 * (j))
#define XB_TOP      3328
#define XB_TOPGEN   3392
#define XCD_BAR_WORDS 3456
#define XB_SPIN_CAP (1u << 18)
#define LAS __attribute__((address_space(3)))
DI unsigned xb_ld(unsigned* p)              { return __hip_atomic_load(p, __ATOMIC_RELAXED, __HIP_MEMORY_SCOPE_AGENT); }
DI unsigned xb_add(unsigned* p, unsigned v) { return __hip_atomic_fetch_add(p, v, __ATOMIC_RELAXED, __HIP_MEMORY_SCOPE_AGENT); }
DI unsigned xb_xcc_id() { return (unsigned)__builtin_amdgcn_s_getreg((3 << 11) | 20) & 0xFu; }
#define XB_SPIN(cond, bar) do { unsigned _sp = 0; while (cond) { __builtin_amdgcn_s_sleep(1); \
    if ((++_sp & 255u) == 0u) { if (xb_ld(&(bar)[XB_TMO])) break; if (_sp > XB_SPIN_CAP) { atomicAdd(&(bar)[XB_TMO], 1u); break; } } } } while (0)
struct XcdBarrier { unsigned* bar; unsigned x; volatile LAS unsigned* st; };
DI XcdBarrier xcd_barrier_post(unsigned* bar, volatile LAS unsigned* st) {
  XcdBarrier b; b.bar = bar; b.x = xb_xcc_id(); b.st = st;
  if (threadIdx.x == 0) (void)xb_add(&bar[XB_XCNT(b.x)], 1u);
  return b;
}
DI void xcd_barrier_complete(unsigned* bar, unsigned x, unsigned& nloc, unsigned& nx) {
  const unsigned G = gridDim.x * gridDim.y * gridDim.z;
  unsigned sum, cnt, mine, sp = 0u;
  for (;;) {
    sum = 0u; cnt = 0u; mine = 0u;
#pragma unroll
    for (unsigned j = 0; j < 16; ++j) { const unsigned c = xb_ld(&bar[XB_XCNT(j)]); sum += c; cnt += (c > 0u) ? 1u : 0u; mine = (j == x) ? c : mine; }
    if (sum == G) break;
    __builtin_amdgcn_s_sleep(1);
    if ((++sp & 255u) == 0u) { if (xb_ld(&bar[XB_TMO])) break; if (sp > XB_SPIN_CAP) { atomicAdd(&bar[XB_TMO], 1u); break; } }
  }
  nloc = mine > 0u ? mine : 1u; nx = cnt > 0u ? cnt : 1u;
}
DI void xcd_barrier(const XcdBarrier& b) {
  asm volatile("s_waitcnt vmcnt(0)" ::: "memory");
  __syncthreads();
  if (threadIdx.x == 0) {
    unsigned* bar = b.bar;
    __builtin_amdgcn_s_waitcnt(0);
    unsigned nloc = b.st[0], nx = b.st[1];
    if (nloc == 0u) { xcd_barrier_complete(bar, b.x, nloc, nx); b.st[0] = nloc; b.st[1] = nx; }
    const unsigned old = xb_add(&bar[XB_XSUB(b.x)], 1u);
    const unsigned gen = old / nloc;
    if (old + 1u == (gen + 1u) * nloc) {
      __builtin_amdgcn_fence(__ATOMIC_RELEASE, "agent");
      asm volatile("s_waitcnt vmcnt(0)" ::: "memory");
      const unsigned og = xb_add(&bar[XB_TOP], 1u);
      const unsigned tg = og / nx;
      if (og + 1u == (tg + 1u) * nx) xb_add(&bar[XB_TOPGEN], 1u);
      else XB_SPIN(xb_ld(&bar[XB_TOPGEN]) == tg, bar);
      __builtin_amdgcn_fence(__ATOMIC_ACQUIRE, "agent");
      xb_add(&bar[XB_XGEN(b.x)], 1u);
      asm volatile("s_waitcnt vmcnt(0)" ::: "memory");
    } else {
      XB_SPIN(xb_ld(&bar[XB_XGEN(b.x)]) == gen, bar);
      __builtin_amdgcn_fence(__ATOMIC_ACQUIRE, "agent");
      asm volatile("s_waitcnt vmcnt(0)" ::: "memory");
    }
  }
  __syncthreads();
}


template <int ROWS> struct LdDirect {
  static constexpr int NR = ROWS * 8 / NT_;
  struct Regs { uint4 v[NR]; };
  const u16* base; long ld;
  DI Regs fetch(int kt, int tid) const { Regs r;
#pragma unroll
    for (int i = 0; i < NR; ++i) { int id = tid + NT_ * i; int row = id >> 3, kc = id & 7;
      r.v[i] = *(const uint4*)(base + (long)row * ld + kt * 64 + kc * 8); }
    return r;
  }
  DI void commit(char* s, const Regs& r, int, int tid) const {
#pragma unroll
    for (int i = 0; i < NR; ++i) { int id = tid + NT_ * i; int row = id >> 3, kc = id & 7;
      *(uint4*)(s + row * PITCH + kc * 16) = r.v[i]; }
  }
};
template <int ROWS> struct LdScaled {
  static constexpr int NR = ROWS * 8 / NT_;
  struct Regs { uint4 v[NR]; };
  const u16* base; long ld; const float* g; const float* rstd_s;
  DI Regs fetch(int kt, int tid) const { Regs r;
#pragma unroll
    for (int i = 0; i < NR; ++i) { int id = tid + NT_ * i; int row = id >> 3, kc = id & 7;
      r.v[i] = *(const uint4*)(base + (long)row * ld + kt * 64 + kc * 8); }
    return r;
  }
  DI void commit(char* s, const Regs& r, int kt, int tid) const {
#pragma unroll
    for (int i = 0; i < NR; ++i) { int id = tid + NT_ * i; int row = id >> 3, kc = id & 7;
      float f[8]; unpack8(r.v[i], f);
      const float rs = rstd_s[row];
      const float4 g0 = *(const float4*)(g + kt * 64 + kc * 8), g1 = *(const float4*)(g + kt * 64 + kc * 8 + 4);
      uint4 o;
      o.x = pk2(f[0] * rs * g0.x, f[1] * rs * g0.y); o.y = pk2(f[2] * rs * g0.z, f[3] * rs * g0.w);
      o.z = pk2(f[4] * rs * g1.x, f[5] * rs * g1.y); o.w = pk2(f[6] * rs * g1.z, f[7] * rs * g1.w);
      *(uint4*)(s + row * PITCH + kc * 16) = o; }
  }
};
template <int BN> struct LdTrans {
  static constexpr int NC = BN / 8;
  static constexpr int NR = 32 * NC / NT_;
  struct Regs { uint4 v[2 * NR]; };
  const u16* base; long strideK;
  DI Regs fetch(int kt, int tid) const { Regs r;
#pragma unroll
    for (int i = 0; i < NR; ++i) { int id = tid + NT_ * i; int nc = id % NC, k2 = id / NC;
      r.v[2 * i] = *(const uint4*)(base + (long)(kt * 64 + 2 * k2) * strideK + nc * 8);
      r.v[2 * i + 1] = *(const uint4*)(base + (long)(kt * 64 + 2 * k2 + 1) * strideK + nc * 8); }
    return r;
  }
  DI void commit(char* s, const Regs& r, int, int tid) const {
#pragma unroll
    for (int i = 0; i < NR; ++i) { int id = tid + NT_ * i; int nc = id % NC, k = 2 * (id / NC);
      const int off = (((k >> 3) ^ (nc & 7)) << 4) + (k & 7) * 2;
      char* d = s + (nc * 8) * PITCH + off;
      const unsigned a[4] = {r.v[2 * i].x, r.v[2 * i].y, r.v[2 * i].z, r.v[2 * i].w};
      const unsigned c[4] = {r.v[2 * i + 1].x, r.v[2 * i + 1].y, r.v[2 * i + 1].z, r.v[2 * i + 1].w};
#pragma unroll
      for (int e = 0; e < 8; ++e) {
        const unsigned lo = (e & 1) ? (a[e >> 1] >> 16) : (a[e >> 1] & 0xffffu);
        const unsigned hi = (e & 1) ? (c[e >> 1] & 0xffff0000u) : (c[e >> 1] << 16);
        *(unsigned*)(d + e * PITCH) = lo | hi; } }
  }
};
struct LdLN {
  static constexpr int NR = 1;
  struct Regs { uint4 v[1]; };
  const u16* base; const float* g;
  DI Regs fetch(int kt, int tid) const { Regs r; int id = tid; int nc = id & 7, k = id >> 3;
    r.v[0] = *(const uint4*)(base + (long)(kt * 64 + k) * NP + nc * 8); return r; }
  DI void commit(char* s, const Regs& r, int, int tid) const {
    int id = tid; int nc = id & 7, k = id >> 3;
    float f[8]; unpack8(r.v[0], f);
    float sm = 0.f;
#pragma unroll
    for (int e = 0; e < 8; ++e) sm += f[e];
    sm += __shfl_xor(sm, 1); sm += __shfl_xor(sm, 2); sm += __shfl_xor(sm, 4);
    const float mean = sm * (1.f / 64.f);
    float sq = 0.f;
#pragma unroll
    for (int e = 0; e < 8; ++e) { f[e] -= mean; sq += f[e] * f[e]; }
    sq += __shfl_xor(sq, 1); sq += __shfl_xor(sq, 2); sq += __shfl_xor(sq, 4);
    const float rs = rsqrtf(sq * (1.f / 64.f) + EPS);
    const int off = (((k >> 3) ^ (nc & 7)) << 4) + (k & 7) * 2;
    char* d = s + (nc * 8) * PITCH + off;
#pragma unroll
    for (int e = 0; e < 8; ++e) *(u16*)(d + e * PITCH) = f2bf(f[e] * rs * g[nc * 8 + e]);
  }
};

template <int WM, int WN, bool SWAP, bool SWZB>
DI void gemm_compute(f32x16 (&acc)[WM][WN], const char* a_s, const char* b_s, int brow0, int h) {
#pragma unroll
  for (int ks = 0; ks < 4; ++ks) {
    bf16x8 af[WM], bfr[WN];
#pragma unroll
    for (int i = 0; i < WM; ++i) af[i] = *(const bf16x8*)(a_s + i * 32 * PITCH + (ks * 2 + h) * 16);
#pragma unroll
    for (int j = 0; j < WN; ++j) {
      const int row = brow0 + j * 32;
      const int ch = SWZB ? ((ks * 2 + h) ^ ((row >> 3) & 7)) : (ks * 2 + h);
      bfr[j] = *(const bf16x8*)(b_s + j * 32 * PITCH + ch * 16);
    }
#pragma unroll
    for (int i = 0; i < WM; ++i)
#pragma unroll
      for (int j = 0; j < WN; ++j)
        acc[i][j] = SWAP ? mfma(bfr[j], af[i], acc[i][j]) : mfma(af[i], bfr[j], acc[i][j]);
  }
}
struct LdLN4 {
  static constexpr int NR = 4;
  struct Regs { uint4 v[4]; };
  const u16* base; const float* g;
  DI Regs fetch(int kt, int tid) const { Regs r;
    const int nc = tid & 7, kq = (tid >> 3) & 15, ci = tid >> 7;
#pragma unroll
    for (int j = 0; j < 4; ++j) r.v[j] = *(const uint4*)(base + (long)(ci * 128 + kt * 64 + 4 * kq + j) * NP + nc * 8);
    return r; }
  DI void commit(char* s, const Regs& r, int, int tid) const {
    const int nc = tid & 7, kq = (tid >> 3) & 15, ci = tid >> 7;
    float gg[8];
#pragma unroll
    for (int e = 0; e < 8; ++e) gg[e] = g[nc * 8 + e];
    float f[4][8];
#pragma unroll
    for (int j = 0; j < 4; ++j) {
      unpack8(r.v[j], f[j]);
      float sm = 0.f;
#pragma unroll
      for (int e = 0; e < 8; ++e) sm += f[j][e];
      sm += __shfl_xor(sm, 1); sm += __shfl_xor(sm, 2); sm += __shfl_xor(sm, 4);
      const float mean = sm * (1.f / 64.f);
      float sq = 0.f;
#pragma unroll
      for (int e = 0; e < 8; ++e) { f[j][e] -= mean; sq += f[j][e] * f[j][e]; }
      sq += __shfl_xor(sq, 1); sq += __shfl_xor(sq, 2); sq += __shfl_xor(sq, 4);
      const float rs = rsqrtf(sq * (1.f / 64.f) + EPS);
#pragma unroll
      for (int e = 0; e < 8; ++e) f[j][e] *= rs * gg[e];
    }
    const int k = 4 * kq;
    const int off = (((k >> 3) ^ (nc & 7)) << 4) + (k & 7) * 2;
    char* d = s + (ci * 64 + nc * 8) * PITCH + off;
#pragma unroll
    for (int e = 0; e < 8; ++e) { uint2 o; o.x = pk2(f[0][e], f[1][e]); o.y = pk2(f[2][e], f[3][e]); *(uint2*)(d + e * PITCH) = o; }
  }
};
template <class LA, class LB> struct GemmPre { typename LA::Regs a0, a1; typename LB::Regs b0, b1; };
template <class LA, class LB>
DI GemmPre<LA, LB> gemm_prefetch(const LA& la, const LB& lb, int nkt) {
  const int tid = ltid();
  GemmPre<LA, LB> pre;
  const int k1 = nkt > 1 ? 1 : 0;
  pre.a0 = la.fetch(0, tid); pre.b0 = lb.fetch(0, tid);
  pre.a1 = la.fetch(k1, tid); pre.b1 = lb.fetch(k1, tid);
  return pre;
}
template <int WGM, int WM, int WN, bool SWAP, bool SWZB, class LA, class LB, class EPI>
DI GemmPre<LA, LB> gemm_tile(const LA& la, const LB& lb, const EPI& epi, int nkt, char* lds, const GemmPre<LA, LB>& pre, const LA& lan, const LB& lbn) {
  constexpr int WGN = 8 / WGM;
  constexpr int BM = WGM * WM * 32, BN = WGN * WN * 32;
  constexpr int ASZ = BM * PITCH, BSZ = BN * PITCH;
  char* As = lds; char* Bs = lds + 2 * ASZ;
  const int tid = ltid(), w = tid >> 6, lane = tid & 63, r = lane & 31, h = lane >> 5;
  const int wm = w / WGN, wn = w % WGN;
  f32x16 acc[WM][WN];
#pragma unroll
  for (int i = 0; i < WM; ++i)
#pragma unroll
    for (int j = 0; j < WN; ++j)
#pragma unroll
      for (int e = 0; e < 16; ++e) acc[i][j][e] = 0.f;
  typename LA::Regs ra0 = pre.a0, ra1 = pre.a1; typename LB::Regs rb0 = pre.b0, rb1 = pre.b1;
  la.commit(As, ra0, 0, tid); lb.commit(Bs, rb0, 0, tid);
  __syncthreads();
  const int a_off = (wm * WM * 32 + r) * PITCH, b_off = (wn * WN * 32 + r) * PITCH;
  const int k1n = nkt > 1 ? 1 : 0;
#define GEMM_COMPUTE(cur) gemm_compute<WM, WN, SWAP, SWZB>(acc, As + (cur) * ASZ + a_off, Bs + (cur) * BSZ + b_off, wn * WN * 32 + r, h)
  if (nkt == 1) {
    ra0 = lan.fetch(0, tid); rb0 = lbn.fetch(0, tid);
    GEMM_COMPUTE(0);
    ra1 = ra0; rb1 = rb0;
    __syncthreads();
  } else {
    for (int kt = 0; kt < nkt; kt += 2) {
      const bool more = kt + 2 < nkt;
      if (more) { ra0 = la.fetch(kt + 2, tid); rb0 = lb.fetch(kt + 2, tid); }
      else      { ra0 = lan.fetch(0, tid);     rb0 = lbn.fetch(0, tid); }
      GEMM_COMPUTE(0);
      la.commit(As + ASZ, ra1, kt + 1, tid); lb.commit(Bs + BSZ, rb1, kt + 1, tid);
      __syncthreads();
      if (more) { ra1 = la.fetch(kt + 3, tid); rb1 = lb.fetch(kt + 3, tid); }
      else      { ra1 = lan.fetch(k1n, tid);   rb1 = lbn.fetch(k1n, tid); }
      GEMM_COMPUTE(1);
      if (more) { la.commit(As, ra0, kt + 2, tid); lb.commit(Bs, rb0, kt + 2, tid); }
      __syncthreads();
    }
  }
#undef GEMM_COMPUTE
  epi(acc, wm * WM * 32, wn * WN * 32, r, h);
  GemmPre<LA, LB> nx; nx.a0 = ra0; nx.a1 = ra1; nx.b0 = rb0; nx.b1 = rb1;
  return nx;
}
template <int WGM, int WM, int WN, bool SWAP, bool SWZB, class LA, class LB, class MKL, class SET, class EPI>
DI void gemm_loop(int first, int count, int step, const MKL& mkl, const SET& set, const EPI& epi, int nkt, char* lds) {
  if (first >= count) return;
  LA la; LB lb; mkl(first, la, lb);
  GemmPre<LA, LB> pre = gemm_prefetch(la, lb, nkt);
  for (int idx = first; idx < count; idx += step) {
    const int nx = (idx + step < count) ? idx + step : idx;
    LA lan; LB lbn; mkl(nx, lan, lbn);
    set(idx);
    pre = gemm_tile<WGM, WM, WN, SWAP, SWZB>(la, lb, epi, nkt, lds, pre, lan, lbn);
    la = lan; lb = lbn;
  }
}

template <class LA, class LB> struct GemmPre3 { typename LA::Regs a[3]; typename LB::Regs b[3]; };
template <int NKT, int WGM, int WM, int WN, bool SWAP, bool SWZB, class LA, class LB, class MKL, class SET, class EPI>
DI void gemm_loop3(int first, int count, int step, const MKL& mkl, const SET& set, const EPI& epi, char* lds) {
  static_assert(NKT >= 4, "needs at least 4 k-slabs");
  constexpr int WGN = 8 / WGM;
  constexpr int BM = WGM * WM * 32, BN = WGN * WN * 32;
  constexpr int ASZ = BM * PITCH, BSZ = BN * PITCH;
  if (first >= count) return;
  char* As = lds; char* Bs = lds + 2 * ASZ;
  LA la; LB lb; mkl(first, la, lb);
  typename LA::Regs ra0, ra1, ra2; typename LB::Regs rb0, rb1, rb2;
  { const int tid = ltid();
    ra0 = la.fetch(0, tid); rb0 = lb.fetch(0, tid); ra1 = la.fetch(1, tid); rb1 = lb.fetch(1, tid); ra2 = la.fetch(2, tid); rb2 = lb.fetch(2, tid); }
  for (int idx = first; idx < count; idx += step) {
    const int nx = (idx + step < count) ? idx + step : idx;
    LA lan; LB lbn; mkl(nx, lan, lbn);
    set(idx);
    const int tid = ltid(), w = tid >> 6, lane = tid & 63, r = lane & 31, h = lane >> 5;
    const int wm = w / WGN, wn = w % WGN;
    f32x16 acc[WM][WN];
#pragma unroll
    for (int i = 0; i < WM; ++i)
#pragma unroll
      for (int j = 0; j < WN; ++j)
#pragma unroll
        for (int e = 0; e < 16; ++e) acc[i][j][e] = 0.f;
    la.commit(As, ra0, 0, tid); lb.commit(Bs, rb0, 0, tid);
    __syncthreads();
    const int a_off = (wm * WM * 32 + r) * PITCH, b_off = (wn * WN * 32 + r) * PITCH;
#define G3_FETCH(RA, RB, kk) do { if ((kk) < NKT) { RA = la.fetch((kk), tid); RB = lb.fetch((kk), tid); } else { RA = lan.fetch((kk) - NKT, tid); RB = lbn.fetch((kk) - NKT, tid); } } while (0)
#define G3_TRIP(kt, RA, RB, RAn, RBn) do { \
      G3_FETCH(RA, RB, (kt) + 3); \
      gemm_compute<WM, WN, SWAP, SWZB>(acc, As + ((kt) & 1) * ASZ + a_off, Bs + ((kt) & 1) * BSZ + b_off, wn * WN * 32 + r, h); \
      if ((kt) + 1 < NKT) { la.commit(As + (((kt) + 1) & 1) * ASZ, RAn, (kt) + 1, tid); lb.commit(Bs + (((kt) + 1) & 1) * BSZ, RBn, (kt) + 1, tid); } \
      __syncthreads(); } while (0)
#pragma unroll
    for (int k3 = 0; k3 < NKT; k3 += 3) {
      G3_TRIP(k3, ra0, rb0, ra1, rb1);
      if (k3 + 1 < NKT) G3_TRIP(k3 + 1, ra1, rb1, ra2, rb2);
      if (k3 + 2 < NKT) G3_TRIP(k3 + 2, ra2, rb2, ra0, rb0);
    }
#undef G3_TRIP
#undef G3_FETCH
    epi(acc, wm * WM * 32, wn * WN * 32, r, h);
    if (NKT % 3 == 1) { typename LA::Regs ta = ra0; typename LB::Regs tb = rb0; ra0 = ra1; rb0 = rb1; ra1 = ra2; rb1 = rb2; ra2 = ta; rb2 = tb; }
    if (NKT % 3 == 2) { typename LA::Regs ta = ra2; typename LB::Regs tb = rb2; ra2 = ra1; rb2 = rb1; ra1 = ra0; rb1 = rb0; ra0 = ta; rb0 = tb; }
    la = lan; lb = lbn;
  }
}

DI void transpose_cvt_tile(const float* src, u16* dst, int K, int N, int kt, int nt, int remap, float* tile, const float* kgain = nullptr) {
  const int tid = ltid();
#pragma unroll
  for (int i = 0; i < 8; ++i) {
    const int kk = i * 8 + (tid >> 6), nn = tid & 63;
    const int n = nt * 64 + nn;
    tile[kk * 65 + nn] = (n < N) ? src[(long)(kt * 64 + kk) * N + n] * (kgain ? kgain[kt * 64 + kk] : 1.f) : 0.f;
  }
  __syncthreads();
  {
    const int nl = tid >> 3, kc = (tid & 7) * 8;
    const int n = nt * 64 + nl;
    if (n < N) {
      int dn = n;
      if (remap) { const int hh = n >> 7, dd = n & 127; dn = (dd < 64) ? (hh * 64 + dd) : (512 + hh * 64 + dd - 64); }
      uint4 o;
      o.x = pk2(tile[(kc + 0) * 65 + nl], tile[(kc + 1) * 65 + nl]);
      o.y = pk2(tile[(kc + 2) * 65 + nl], tile[(kc + 3) * 65 + nl]);
      o.z = pk2(tile[(kc + 4) * 65 + nl], tile[(kc + 5) * 65 + nl]);
      o.w = pk2(tile[(kc + 6) * 65 + nl], tile[(kc + 7) * 65 + nl]);
      *(uint4*)(dst + (long)dn * K + kt * 64 + kc) = o;
    }
  }
  __syncthreads();
}

template <int ROWS, int CH, int SPB, bool HAS_U>
DI void staged_gate_store(const char* st, int lane, const u16* __restrict__ gate, const u16* __restrict__ uptr, long ldg, u16* __restrict__ out, long ldo) {
  constexpr int NQ = ROWS * CH / 64;
  uint4 gv[NQ], uv[NQ];
#pragma unroll
  for (int q = 0; q < NQ; ++q) {
    const int id = q * 64 + lane; const int row = id / CH, c = id % CH;
    gv[q] = *(const uint4*)(gate + (long)row * ldg + c * 8);
    if (HAS_U) uv[q] = *(const uint4*)(uptr + (long)row * ldg + c * 8);
  }
#pragma unroll
  for (int q = 0; q < NQ; ++q) {
    const int id = q * 64 + lane; const int row = id / CH, c = id % CH;
    const float4 a = *(const float4*)(st + row * SPB + c * 32), b = *(const float4*)(st + row * SPB + c * 32 + 16);
    float g[8]; unpack8(gv[q], g);
    float u[8];
    if (HAS_U) unpack8(uv[q], u); else {
#pragma unroll
      for (int e = 0; e < 8; ++e) u[e] = 1.f; }
    uint4 o;
    o.x = pk2(a.x * u[0] * silu(g[0]), a.y * u[1] * silu(g[1])); o.y = pk2(a.z * u[2] * silu(g[2]), a.w * u[3] * silu(g[3]));
    o.z = pk2(b.x * u[4] * silu(g[4]), b.y * u[5] * silu(g[5])); o.w = pk2(b.z * u[6] * silu(g[6]), b.w * u[7] * silu(g[7]));
    *(uint4*)(out + (long)row * ldo + c * 8) = o;
  }
}

constexpr int AT_KP = 208, AT_KSZ = 64 * AT_KP, AT_VP = 144, AT_VSZ = 64 * AT_VP;
DI void attn_qk(f32x16& p0, f32x16& p1, const char* ks, const bf16x8 (&qf)[6], int r, int h, float negB) {
#pragma unroll
  for (int e = 0; e < 16; ++e) { p0[e] = negB; p1[e] = negB; }
#pragma unroll
  for (int s = 0; s < 6; ++s) {
    const bf16x8 k0 = *(const bf16x8*)(ks + r * AT_KP + (2 * s + h) * 16);
    const bf16x8 k1 = *(const bf16x8*)(ks + (32 + r) * AT_KP + (2 * s + h) * 16);
    p0 = mfma(k0, qf[s], p0); p1 = mfma(k1, qf[s], p1);
  }
}
DI void attn_pv(f32x16& o0, f32x16& o1, const f32x16& p0, const f32x16& p1, const char* vs, int r, int h) {
#pragma unroll
  for (int kb = 0; kb < 2; ++kb) {
#pragma unroll
    for (int sp = 0; sp < 2; ++sp) {
      uint4 pw;
      if (kb == 0) { pw.x = pk2(p0[8 * sp + 0], p0[8 * sp + 1]); pw.y = pk2(p0[8 * sp + 2], p0[8 * sp + 3]);
                     pw.z = pk2(p0[8 * sp + 4], p0[8 * sp + 5]); pw.w = pk2(p0[8 * sp + 6], p0[8 * sp + 7]); }
      else         { pw.x = pk2(p1[8 * sp + 0], p1[8 * sp + 1]); pw.y = pk2(p1[8 * sp + 2], p1[8 * sp + 3]);
                     pw.z = pk2(p1[8 * sp + 4], p1[8 * sp + 5]); pw.w = pk2(p1[8 * sp + 6], p1[8 * sp + 7]); }
      const bf16x8 pf = __builtin_bit_cast(bf16x8, pw);
      const int keyoff = 32 * kb + 16 * sp + 4 * h;
      {
        const char* vr = vs + r * AT_VP + ((keyoff * 2) ^ ((r & 16) >> 1));
        const uint2 lo = *(const uint2*)vr, hi = *(const uint2*)(vr + 16);
        uint4 a4 = make_uint4(lo.x, lo.y, hi.x, hi.y);
        o0 = mfma(__builtin_bit_cast(bf16x8, a4), pf, o0);
      }
      {
        const char* vr = vs + (32 + r) * AT_VP + ((keyoff * 2) ^ ((r & 16) >> 1));
        const uint2 lo = *(const uint2*)vr, hi = *(const uint2*)(vr + 16);
        uint4 a4 = make_uint4(lo.x, lo.y, hi.x, hi.y);
        o1 = mfma(__builtin_bit_cast(bf16x8, a4), pf, o1);
      }
    }
  }
}
DI void attn_item(const u16* __restrict__ Qp, const u16* __restrict__ Kp, const u16* __restrict__ VTp, int q0, int nkeys,
                  const u16* __restrict__ gatep, u16* __restrict__ mixp, float negB, char* lds) {
  const int tid = ltid(), w = tid >> 6, lane = tid & 63, r = lane & 31, h = lane >> 5;
  char* Kb0 = lds; char* Vb0 = lds + 2 * AT_KSZ;
  bf16x8 qf[6];
  {
    const u16* qrow = Qp + (long)(q0 + w * 32 + r) * 96 + h * 8;
#pragma unroll
    for (int s = 0; s < 6; ++s) qf[s] = *(const bf16x8*)(qrow + s * 16);
  }
  f32x16 o0, o1;
#pragma unroll
  for (int e = 0; e < 16; ++e) { o0[e] = 0.f; o1[e] = 0.f; }
  float lsum = 0.f;
  const int NT = nkeys >> 6;
  uint4 rkA0, rkA1, rvA, rkB0, rkB1, rvB;
  rkA1 = make_uint4(0, 0, 0, 0); rkB1 = make_uint4(0, 0, 0, 0);
  const int krow0 = tid / 12, kc0 = tid % 12, krow1 = (tid + 512) / 12, kc1 = (tid + 512) % 12;
  const int vrow = tid >> 3, vc = tid & 7;
  const bool klo = tid < 256;
#define AT_FETCH_K(S, t) do { const u16* kt_ = Kp + (long)(t) * 64 * 96; rk##S##0 = *(const uint4*)(kt_ + tid * 8); \
    if (klo) rk##S##1 = *(const uint4*)(kt_ + (tid + 512) * 8); } while (0)
#define AT_FETCH_V(S, t) do { rv##S = *(const uint4*)(VTp + (long)vrow * KPOS + (t) * 64 + vc * 8); } while (0)
#define AT_COMMIT_K(S, buf) do { char* ks_ = Kb0 + (buf) * AT_KSZ; *(uint4*)(ks_ + krow0 * AT_KP + kc0 * 16) = rk##S##0; \
    if (klo) *(uint4*)(ks_ + krow1 * AT_KP + kc1 * 16) = rk##S##1; } while (0)
#define AT_COMMIT_V(S, buf) do { *(uint4*)(Vb0 + (buf) * AT_VSZ + vrow * AT_VP + vc * 16) = (vrow & 16) ? make_uint4(rv##S.z, rv##S.w, rv##S.x, rv##S.y) : rv##S; } while (0)
#define AT_TRIP(t, FS, CS) do { \
    { const int tk_ = ((t) + 3 < NT) ? (t) + 3 : NT - 1, tv_ = ((t) + 2 < NT) ? (t) + 2 : NT - 1; AT_FETCH_K(FS, tk_); AT_FETCH_V(FS, tv_); } \
    f32x16 n0, n1; \
    attn_qk(n0, n1, Kb0 + (((t) + 1) & 1) * AT_KSZ, qf, r, h, negB); \
    const char* vs = Vb0 + ((t) & 1) * AT_VSZ; \
    float rs = 0.f; \
    _Pragma("unroll") for (int e = 0; e < 16; ++e) { p0[e] = __builtin_amdgcn_exp2f(p0[e]); rs += p0[e]; } \
    _Pragma("unroll") for (int e = 0; e < 16; ++e) { p1[e] = __builtin_amdgcn_exp2f(p1[e]); rs += p1[e]; } \
    lsum += rs; \
    attn_pv(o0, o1, p0, p1, vs, r, h); \
    AT_COMMIT_K(CS, (t) & 1); AT_COMMIT_V(CS, ((t) + 1) & 1); \
    __syncthreads(); \
    p0 = n0; p1 = n1; } while (0)
  AT_FETCH_K(A, 0); AT_FETCH_V(A, 0); AT_FETCH_K(B, 1);
  AT_COMMIT_K(A, 0); AT_COMMIT_V(A, 0); AT_COMMIT_K(B, 1);
  AT_FETCH_K(B, 2); AT_FETCH_V(B, 1);
  __syncthreads();
  f32x16 p0, p1;
  attn_qk(p0, p1, Kb0, qf, r, h, negB);
  for (int t = 0; t < NT; t += 2) {
    AT_TRIP(t, A, B);
    AT_TRIP(t + 1, B, A);
  }
#undef AT_TRIP
#undef AT_FETCH_K
#undef AT_FETCH_V
#undef AT_COMMIT_K
#undef AT_COMMIT_V
  lsum += __shfl_xor(lsum, 32);
  const float inv = 1.f / lsum;
  char* stg = lds + w * (32 * 272);
#pragma unroll
  for (int db = 0; db < 2; ++db)
#pragma unroll
    for (int g4 = 0; g4 < 4; ++g4) {
      const int dv = db * 32 + 8 * g4 + 4 * h;
      float4 v;
      if (db == 0) v = make_float4(o0[4 * g4] * inv, o0[4 * g4 + 1] * inv, o0[4 * g4 + 2] * inv, o0[4 * g4 + 3] * inv);
      else         v = make_float4(o1[4 * g4] * inv, o1[4 * g4 + 1] * inv, o1[4 * g4 + 2] * inv, o1[4 * g4 + 3] * inv);
      *(float4*)(stg + r * 272 + dv * 4) = v;
    }
  __syncthreads();
  staged_gate_store<32, 8, 272, false>(stg, lane, gatep + (long)(w * 32) * NP, nullptr, NP, mixp + (long)(w * 32) * 1024, 1024);
  __syncthreads();
}

DI void attn_item64(const u16* __restrict__ Qp, const u16* __restrict__ Kp, const u16* __restrict__ VTp, int q0, int nkeys,
                    const u16* __restrict__ gatep, u16* __restrict__ mixp, char* lds) {
  const int tid = ltid(), w = tid >> 6, lane = tid & 63, r = lane & 31, h = lane >> 5;
  char* Kb0 = lds; char* Vb0 = lds + 2 * AT_KSZ;
  char* qbl = lds + 2 * AT_KSZ + 2 * AT_VSZ + w * (32 * AT_KP) + r * AT_KP + h * 16;
  bf16x8 qa[6];
  {
    const u16* qrow = Qp + (long)(q0 + w * 64 + r) * 96 + h * 8;
#pragma unroll
    for (int s = 0; s < 6; ++s) { qa[s] = *(const bf16x8*)(qrow + s * 16); *(bf16x8*)(qbl + s * 32) = *(const bf16x8*)(qrow + 32 * 96 + s * 16); }
  }
  f32x16 oa0, oa1, ob0, ob1;
#pragma unroll
  for (int e = 0; e < 16; ++e) { oa0[e] = 0.f; oa1[e] = 0.f; ob0[e] = 0.f; ob1[e] = 0.f; }
  float lsa = 0.f, lsb = 0.f;
  const int NT = nkeys >> 6;
  uint2 rkA0, rkA1, rkA2, rkB0, rkB1, rkB2; uint4 rvA, rvB;
  const int kso = (tid >> 3) * AT_KP + (tid & 7) * 24;
  const int vrow = tid >> 3, vc = tid & 7;
#define AT_FETCH_K(S, t) do { const uint2* kt_ = (const uint2*)(Kp + (long)(t) * 64 * 96) + tid * 3; rk##S##0 = kt_[0]; rk##S##1 = kt_[1]; rk##S##2 = kt_[2]; } while (0)
#define AT_FETCH_V(S, t) do { rv##S = *(const uint4*)(VTp + (long)vrow * KPOS + (t) * 64 + vc * 8); } while (0)
#define AT_COMMIT_K(S, buf) do { char* ks_ = Kb0 + (buf) * AT_KSZ + kso; *(uint2*)ks_ = rk##S##0; *(uint2*)(ks_ + 8) = rk##S##1; *(uint2*)(ks_ + 16) = rk##S##2; } while (0)
#define AT_COMMIT_V(S, buf) do { *(uint4*)(Vb0 + (buf) * AT_VSZ + vrow * AT_VP + vc * 16) = (vrow & 16) ? make_uint4(rv##S.z, rv##S.w, rv##S.x, rv##S.y) : rv##S; } while (0)
#define AT_QK_HALF(sa, sb, ks, kb) do { \
    _Pragma("unroll") for (int e = 0; e < 16; ++e) { sa[e] = 0.f; sb[e] = 0.f; } \
    _Pragma("unroll") for (int s_ = 0; s_ < 6; ++s_) { \
      const bf16x8 kf_ = *(const bf16x8*)((ks) + ((kb) * 32 + r) * AT_KP + (2 * s_ + h) * 16); \
      const bf16x8 qf_ = *(const bf16x8*)(qbl + s_ * 32); \
      sa = mfma(kf_, qa[s_], sa); sb = mfma(kf_, qf_, sb); } } while (0)
#define AT_EXP(sx, ls) do { float rs_ = 0.f; \
    _Pragma("unroll") for (int e = 0; e < 16; ++e) { sx[e] = __builtin_amdgcn_exp2f(sx[e]); rs_ += sx[e]; } ls += rs_; } while (0)
#define AT_PV_HALF(pa, pb, vs, kb) do { \
    _Pragma("unroll") for (int sp_ = 0; sp_ < 2; ++sp_) { \
      uint4 wa_, wb_; \
      wa_.x = pk2(pa[8 * sp_ + 0], pa[8 * sp_ + 1]); wa_.y = pk2(pa[8 * sp_ + 2], pa[8 * sp_ + 3]); \
      wa_.z = pk2(pa[8 * sp_ + 4], pa[8 * sp_ + 5]); wa_.w = pk2(pa[8 * sp_ + 6], pa[8 * sp_ + 7]); \
      wb_.x = pk2(pb[8 * sp_ + 0], pb[8 * sp_ + 1]); wb_.y = pk2(pb[8 * sp_ + 2], pb[8 * sp_ + 3]); \
      wb_.z = pk2(pb[8 * sp_ + 4], pb[8 * sp_ + 5]); wb_.w = pk2(pb[8 * sp_ + 6], pb[8 * sp_ + 7]); \
      const bf16x8 fa_ = __builtin_bit_cast(bf16x8, wa_), fb_ = __builtin_bit_cast(bf16x8, wb_); \
      const int keyoff_ = 32 * (kb) + 16 * sp_ + 4 * h; \
      { const char* vr_ = (vs) + r * AT_VP + ((keyoff_ * 2) ^ ((r & 16) >> 1)); \
        const uint2 lo_ = *(const uint2*)vr_, hi_ = *(const uint2*)(vr_ + 16); \
        const bf16x8 vf_ = __builtin_bit_cast(bf16x8, make_uint4(lo_.x, lo_.y, hi_.x, hi_.y)); \
        oa0 = mfma(vf_, fa_, oa0); ob0 = mfma(vf_, fb_, ob0); } \
      { const char* vr_ = (vs) + (32 + r) * AT_VP + ((keyoff_ * 2) ^ ((r & 16) >> 1)); \
        const uint2 lo_ = *(const uint2*)vr_, hi_ = *(const uint2*)(vr_ + 16); \
        const bf16x8 vf_ = __builtin_bit_cast(bf16x8, make_uint4(lo_.x, lo_.y, hi_.x, hi_.y)); \
        oa1 = mfma(vf_, fa_, oa1); ob1 = mfma(vf_, fb_, ob1); } } } while (0)
#define AT_TRIP64(t, FS, CS) do { \
    { const int tn_ = ((t) + 2 < NT) ? (t) + 2 : NT - 1; AT_FETCH_K(FS, tn_); AT_FETCH_V(FS, tn_); } \
    const char* ks = Kb0 + ((t) & 1) * AT_KSZ; const char* vs = Vb0 + ((t) & 1) * AT_VSZ; \
    { f32x16 sa0, sb0; \
      AT_QK_HALF(sa0, sb0, ks, 0); \
      AT_EXP(sa0, lsa); AT_EXP(sb0, lsb); \
      AT_PV_HALF(sa0, sb0, vs, 0); } \
    __builtin_amdgcn_sched_barrier(0); \
    { f32x16 sa1, sb1; \
      AT_QK_HALF(sa1, sb1, ks, 1); \
      AT_EXP(sa1, lsa); AT_EXP(sb1, lsb); \
      AT_PV_HALF(sa1, sb1, vs, 1); } \
    __builtin_amdgcn_sched_barrier(0); \
    AT_COMMIT_K(CS, ((t) + 1) & 1); AT_COMMIT_V(CS, ((t) + 1) & 1); \
    __syncthreads(); } while (0)
  AT_FETCH_K(A, 0); AT_FETCH_V(A, 0);
  AT_COMMIT_K(A, 0); AT_COMMIT_V(A, 0);
  AT_FETCH_K(B, 1); AT_FETCH_V(B, 1);
  __syncthreads();
  for (int t = 0; t < NT; t += 2) {
    AT_TRIP64(t, A, B);
    AT_TRIP64(t + 1, B, A);
  }
#undef AT_TRIP64
#undef AT_PV_HALF
#undef AT_EXP
#undef AT_QK_HALF
#undef AT_FETCH_K
#undef AT_FETCH_V
#undef AT_COMMIT_K
#undef AT_COMMIT_V
  lsa += __shfl_xor(lsa, 32); lsb += __shfl_xor(lsb, 32);
  const float ia = 1.f / lsa, ib = 1.f / lsb;
  char* stg = lds + w * (32 * 272);
#pragma unroll
  for (int blk = 0; blk < 2; ++blk) {
#pragma unroll
    for (int db = 0; db < 2; ++db)
#pragma unroll
      for (int g4 = 0; g4 < 4; ++g4) {
        const int dv = db * 32 + 8 * g4 + 4 * h;
        float4 v;
        if (blk == 0) { if (db == 0) v = make_float4(oa0[4 * g4] * ia, oa0[4 * g4 + 1] * ia, oa0[4 * g4 + 2] * ia, oa0[4 * g4 + 3] * ia);
                        else         v = make_float4(oa1[4 * g4] * ia, oa1[4 * g4 + 1] * ia, oa1[4 * g4 + 2] * ia, oa1[4 * g4 + 3] * ia); }
        else          { if (db == 0) v = make_float4(ob0[4 * g4] * ib, ob0[4 * g4 + 1] * ib, ob0[4 * g4 + 2] * ib, ob0[4 * g4 + 3] * ib);
                        else         v = make_float4(ob1[4 * g4] * ib, ob1[4 * g4 + 1] * ib, ob1[4 * g4 + 2] * ib, ob1[4 * g4 + 3] * ib); }
        *(float4*)(stg + r * 272 + dv * 4) = v;
      }
    __syncthreads();
    staged_gate_store<32, 8, 272, false>(stg, lane, gatep + (long)(w * 64 + blk * 32) * NP, nullptr, NP, mixp + (long)(w * 64 + blk * 32) * 1024, 1024);
    __syncthreads();
  }
}


__global__ void __launch_bounds__(NT_) fwd_megakernel(Params p) {
  extern __shared__ __attribute__((aligned(16))) char lds[];
  cg::grid_group grid = cg::this_grid();
  const int tid = threadIdx.x, bid = blockIdx.x, nblk = gridDim.x;
  __shared__ uint4 xb_words;
  if (tid == 0) xb_words = make_uint4(0u, 0u, 0u, 0u);
  __syncthreads();
  const XcdBarrier xb = xcd_barrier_post(p.bar, (volatile LAS unsigned*)&xb_words);
  const long gtid = (long)bid * NT_ + tid, gnth = (long)nblk * NT_;

  {
    float* tile = (float*)lds;
    constexpr int T_WIN = 16 * 35, T_WOUT = 16 * 16, T_WUQ = 4 * 12, T_WUKV = 2 * 16;
    constexpr int T_L = T_WIN + T_WOUT + T_WUQ + T_WUKV;
    struct TP { const float* src; u16* dst; const float* kg; int K, N, kt, nt, remap; };
    auto tparams = [&](int it) {
      TP q; const int l = it / T_L; int t = it % T_L;
      if (t < T_WIN) { q.src = p.w_in + (long)l * 1024 * INW; q.dst = p.win_t + (long)l * NP * 1024; q.K = 1024; q.N = INW; q.kt = t / 35; q.nt = t % 35; q.remap = 0; q.kg = nullptr; }
      else if ((t -= T_WIN) < T_WOUT) { q.src = p.w_out + (long)l * 1024 * 1024; q.dst = p.wout_t + (long)l * 1024 * 1024; q.K = 1024; q.N = 1024; q.kt = t / 16; q.nt = t % 16; q.remap = 0; q.kg = nullptr; }
      else if ((t -= T_WOUT) < T_WUQ) { q.src = p.w_uq + (long)l * 256 * 768; q.dst = p.wuq_t + (long)l * 768 * 256; q.K = 256; q.N = 768; q.kt = t / 12; q.nt = t % 12; q.remap = 0; q.kg = p.q_a_g + l * 256; }
      else { t -= T_WUQ; q.src = p.w_ukv + (long)l * 128 * 1024; q.dst = p.wukv_t + (long)l * 1024 * 128; q.K = 128; q.N = 1024; q.kt = t / 16; q.nt = t % 16; q.remap = 1; q.kg = p.kv_a_g + l * 128; }
      return q;
    };
    float pv[8];
    auto tload = [&](const TP& q) {
#pragma unroll
      for (int i = 0; i < 8; ++i) {
        const int kk = i * 8 + (tid >> 6), nn = tid & 63;
        const int n = q.nt * 64 + nn;
        pv[i] = (n < q.N) ? q.src[(long)(q.kt * 64 + kk) * q.N + n] * (q.kg ? q.kg[q.kt * 64 + kk] : 1.f) : 0.f;
      }
    };
    if (bid < T_L * DEPTH) { const TP q0 = tparams(bid); tload(q0); }
    for (int it = bid; it < T_L * DEPTH; it += nblk) {
      const TP q = tparams(it);
#pragma unroll
      for (int i = 0; i < 8; ++i) tile[(i * 8 + (tid >> 6)) * 65 + (tid & 63)] = pv[i];
      __syncthreads();
      if (it + nblk < T_L * DEPTH) { const TP qn = tparams(it + nblk); tload(qn); }
      {
        const int nl = tid >> 3, kc = (tid & 7) * 8;
        const int n = q.nt * 64 + nl;
        if (n < q.N) {
          int dn = n;
          if (q.remap) { const int hh = n >> 7, dd = n & 127; dn = (dd < 64) ? (hh * 64 + dd) : (512 + hh * 64 + dd - 64); }
          uint4 o;
          o.x = pk2(tile[(kc + 0) * 65 + nl], tile[(kc + 1) * 65 + nl]);
          o.y = pk2(tile[(kc + 2) * 65 + nl], tile[(kc + 3) * 65 + nl]);
          o.z = pk2(tile[(kc + 4) * 65 + nl], tile[(kc + 5) * 65 + nl]);
          o.w = pk2(tile[(kc + 6) * 65 + nl], tile[(kc + 7) * 65 + nl]);
          *(uint4*)(q.dst + (long)dn * q.K + q.kt * 64 + kc) = o;
        }
      }
      __syncthreads();
    }
    for (long i = gtid; i < (long)DEPTH * (NP - INW) * 1024; i += gnth) {
      const int l = (int)(i / ((NP - INW) * 1024)); const long rem = i % ((NP - INW) * 1024);
      p.win_t[((long)l * NP + INW) * 1024 + rem] = 0;
    }
    for (long i = gtid; i < (long)DEPTH * 4 * 128 * 128; i += gnth) p.gws_b[i] = f2bf(p.g_ws[i]);
    for (long i = gtid; i < 128 * 64; i += gnth) {
      const int rho = (int)(i >> 6), n1 = (int)(i & 63);
      const int blk = rho >> 5, k1 = (blk >> 1) * 32 + (rho & 31), part = blk & 1;
      const int mm = (k1 * n1) & 63;
      p.t1[i] = f2bf(part == 0 ? cospif(mm * (1.f / 32.f)) : -sinpif(mm * (1.f / 32.f)));
    }
    for (long i = gtid; i < 128 * 128; i += gnth) {
      const int rho = (int)(i >> 7), kk = (int)(i & 127);
      const int rio = rho >> 6, k2 = rho & 63, n2 = kk >> 1, rii = kk & 1;
      const int mm = (n2 * k2) & 63;
      const float c = cospif(mm * (1.f / 32.f)), s = sinpif(mm * (1.f / 32.f));
      p.t2[i] = f2bf(rio == 0 ? (rii == 0 ? c : s) : (rii == 0 ? -s : c));
    }
    for (long i = gtid; i < 512 * 256; i += gnth) {
      const int rho = (int)(i >> 8), n = (int)(i & 255);
      const int ri = rho >> 8, k = rho & 255;
      const int mm = (k * n) & 255;
      p.t256[i] = f2bf(ri == 0 ? cospif(mm * (1.f / 128.f)) : -sinpif(mm * (1.f / 128.f)));
    }
    for (long i = gtid; i < 4096; i += gnth) {
      p.tw[2 * i] = cospif((float)i * (1.f / 2048.f)); p.tw[2 * i + 1] = sinpif((float)i * (1.f / 2048.f));
    }
    for (long i = gtid; i < 64 * 8; i += gnth) {
      const int pos = (int)(i >> 3), jj = (int)(i & 7);
      const float ang = (float)pos * exp2f(-(float)jj * 1.6609640474436813f);
      p.rope[2 * i] = __cosf(ang); p.rope[2 * i + 1] = __sinf(ang);
    }
    for (long i = gtid; i < (long)DEPTH * 256 * 512; i += gnth) {
      const int n = (int)(i & 255), kidx = (int)((i >> 8) & 511), l = (int)(i >> 17);
      const int g = kidx >> 7, j = kidx & 127, jj = j & 63;
      const float* wf = p.w_fmix + (long)l * 256 * 256 + (long)(g * 64) * 256 + n;
      float acc = 0.f;
      for (int c0 = 0; c0 < 64; c0 += 16) {
        float wv[16];
#pragma unroll
        for (int u = 0; u < 16; ++u) wv[u] = wf[(long)(c0 + u) * 256];
#pragma unroll
        for (int u = 0; u < 16; ++u) {
          const int mm = (jj * (c0 + u)) & 63;
          const float coef = (j < 64) ? cospif(mm * (1.f / 32.f)) : sinpif(mm * (1.f / 32.f));
          acc += coef * wv[u];
        }
      }
      p.mf_t[((long)l * 256 + n) * 512 + kidx] = f2bf(acc);
    }
    {
      float* sl = (float*)lds;
      float* red = sl + 9 * 1024;
      __syncthreads();
      for (int i = tid; i < 9 * 1024; i += NT_) {
        const int rr = i >> 10, kk = i & 1023;
        const float v = (rr < 8) ? p.c[rr * 1024 + kk] : p.c_ctx[kk];
        sl[i] = silu(v);
      }
      __syncthreads();
      for (int it = bid; it < DEPTH * 96; it += nblk) {
        const int l = it / 96, cgp = it % 96;
        const int cj = tid & 31, ksl = tid >> 5;
        const float* wm = p.w_mod + (long)l * 1024 * 3072 + cgp * 32 + cj;
        float a[9];
#pragma unroll
        for (int rr = 0; rr < 9; ++rr) a[rr] = 0.f;
        for (int k0 = ksl * 64; k0 < ksl * 64 + 64; k0 += 16) {
          float wv[16];
#pragma unroll
          for (int u = 0; u < 16; ++u) wv[u] = wm[(long)(k0 + u) * 3072];
#pragma unroll
          for (int u = 0; u < 16; ++u)
#pragma unroll
            for (int rr = 0; rr < 9; ++rr) a[rr] += sl[rr * 1024 + k0 + u] * wv[u];
        }
#pragma unroll
        for (int rr = 0; rr < 9; ++rr) red[(ksl * 9 + rr) * 32 + cj] = a[rr];
        __syncthreads();
        if (tid < 288) {
          const int rr = tid >> 5, c2 = tid & 31;
          float s = 0.f;
          for (int q = 0; q < 16; ++q) s += red[(q * 9 + rr) * 32 + c2];
          const int col = cgp * 32 + c2;
          p.mod[((long)l * 9 + rr) * 3072 + col] = s + p.b_mod[l * 3072 + col];
        }
        __syncthreads();
      }
    }
  }
  grid.sync();

  for (int l = 0; l < DEPTH; ++l) {
    const int tid = ltid();
    const float* modl = p.mod + (long)l * 9 * 3072;
    {
      const float* ng = p.norm_g + l * 1024;
      const int lane = tid & 63, wv = tid >> 6;
      for (int row = bid * 8 + wv; row < MT; row += nblk * 8) {
        const float* src; int mr;
        if (row < MX) { src = (l == 0 ? p.x : p.out) + (long)row * 1024; mr = row >> 12; }
        else { src = (l == 0 ? p.ctx : p.yw) + (long)(row - MX) * 1024; mr = 8; }
        const float* md = modl + mr * 3072;
        float4 v[4]; float ss = 0.f;
#pragma unroll
        for (int i = 0; i < 4; ++i) { v[i] = *(const float4*)(src + i * 256 + lane * 4);
          ss += v[i].x * v[i].x + v[i].y * v[i].y + v[i].z * v[i].z + v[i].w * v[i].w; }
#pragma unroll
        for (int o = 1; o < 64; o <<= 1) ss += __shfl_xor(ss, o);
        const float rs = rsqrtf(ss * (1.f / 1024.f) + EPS);
#pragma unroll
        for (int i = 0; i < 4; ++i) {
          const int k0 = i * 256 + lane * 4;
          const float4 g = *(const float4*)(ng + k0), sh = *(const float4*)(md + k0), sc = *(const float4*)(md + 1024 + k0);
          uint2 o;
          o.x = pk2(v[i].x * rs * g.x * (1.f + sc.x) + sh.x, v[i].y * rs * g.y * (1.f + sc.y) + sh.y);
          o.y = pk2(v[i].z * rs * g.z * (1.f + sc.z) + sh.z, v[i].w * rs * g.w * (1.f + sc.w) + sh.w);
          *(uint2*)(p.hmix + (long)row * 1024 + k0) = o;
        }
      }
    }
    xcd_barrier(xb);

    {
      const u16* wt = p.win_t + (long)l * NP * 1024;
      u16* P = p.p;
      int m0 = 0, n0 = 0;
      auto epi = [&](auto& acc, int mw, int nw, int r, int h) {
        constexpr int WM_ = sizeof(acc) / sizeof(acc[0]), WN_ = sizeof(acc[0]) / sizeof(acc[0][0]);
        constexpr int SP = WN_ * 64 + 16;
        constexpr int CH = WN_ * 4;
        const int wv = ltid() >> 6, lane = h * 32 + r;
        char* st = lds + wv * (WM_ * 32 * SP);
        if (n0 + nw >= C_CQ && n0 + nw < C_KROPE) {
#pragma unroll
          for (int i = 0; i < WM_; ++i)
#pragma unroll
            for (int j = 0; j < WN_; ++j) {
              float ss = 0.f;
#pragma unroll
              for (int e = 0; e < 16; ++e) ss += acc[i][j][e] * acc[i][j][e];
              ss += __shfl_xor(ss, 32);
              if (h == 0) p.stats[(long)(m0 + mw + i * 32 + r) * 16 + ((n0 + nw + j * 32 - C_CQ) >> 5)] = ss;
            }
        }
#pragma unroll
        for (int i = 0; i < WM_; ++i)
#pragma unroll
          for (int j = 0; j < WN_; ++j)
#pragma unroll
            for (int g4 = 0; g4 < 4; ++g4) {
              uint2 o;
              o.x = pk2(acc[i][j][4 * g4], acc[i][j][4 * g4 + 1]); o.y = pk2(acc[i][j][4 * g4 + 2], acc[i][j][4 * g4 + 3]);
              *(uint2*)(st + (i * 32 + r) * SP + (j * 32 + 8 * g4 + 4 * h) * 2) = o;
            }
        __syncthreads();
#pragma unroll
        for (int q = 0; q < WM_ * 32 * CH / 64; ++q) {
          const int id = q * 64 + lane; const int row = id / CH, c = id % CH;
          const uint4 v = *(const uint4*)(st + row * SP + c * 16);
          *(uint4*)(P + (long)(m0 + mw + row) * NP + n0 + nw + c * 8) = v;
        }
        __syncthreads();
      };
      {
        auto mkl = [&](int j, LdDirect<256>& la, LdDirect<128>& lb) {
          const int mt = (j / 18) * 8 + (bid & 7), nt = j % 18;
          la.base = p.hmix + (long)mt * 256 * 1024; la.ld = 1024; lb.base = wt + (long)nt * 128 * 1024; lb.ld = 1024; };
        auto set = [&](int j) { m0 = ((j / 18) * 8 + (bid & 7)) * 256; n0 = (j % 18) * 128; };
        gemm_loop3<16, 4, 2, 2, true, false, LdDirect<256>, LdDirect<128>>(bid >> 3, 16 * 18, nblk >> 3, mkl, set, epi, lds);
      }
      {
        const int nty = (l == DEPTH - 1) ? 3 : 36, nt0 = (l == DEPTH - 1) ? 24 : 0;
        auto mkl = [&](int it, LdDirect<128>& la, LdDirect<64>& lb) {
          const int mt = it / nty, nt = nt0 + it % nty;
          la.base = p.hmix + (long)(MX + mt * 128) * 1024; la.ld = 1024; lb.base = wt + (long)nt * 64 * 1024; lb.ld = 1024; };
        auto set = [&](int it) { m0 = MX + (it / nty) * 128; n0 = (nt0 + it % nty) * 64; };
        gemm_loop<4, 1, 1, true, false, LdDirect<128>, LdDirect<64>>(bid, 16 * nty, nblk, mkl, set, epi, 16, lds);
      }
    }
    xcd_barrier(xb);

    {
      constexpr int nKN = 136 * 4, nV = 136 * 4, nF1 = 1024;
      const int nQ = (l == DEPTH - 1) ? 256 * 4 : 272 * 4, nFy = (l == DEPTH - 1) ? 0 : 64, nG = (l == DEPTH - 1) ? 256 : 272;
      float* rstd_s = (float*)(lds + RSTD_OFF);
#define FIRST(off) ((bid + nblk - ((off) % nblk)) % nblk)
      {
        int m0 = 0, n0 = 0;
        auto mkl = [&](int it, LdDirect<128>& la, LdDirect<192>& lb) {
          const int mt = it >> 2, nt = it & 3;
          la.base = p.p + (long)mt * 128 * NP + C_CQ; la.ld = NP;
          lb.base = p.wuq_t + ((long)l * 768 + nt * 192) * 256; lb.ld = 256; };
        auto set = [&](int it) { m0 = (it >> 2) * 128; n0 = (it & 3) * 192; };
        const float* qg = p.q_norm_g + l * 96;
        u16* Qb = p.q; const float* ROPE = p.rope;
        auto epi = [&](f32x16 (&acc)[1][3], int mw, int nw, int r, int h) {
          const int head = (n0 + nw) / 96;
          const float QS = 0.10206207261596575f * 1.4426950408889634f;
          const int m = m0 + mw + r;
          float ss = 0.f;
#pragma unroll
          for (int j = 0; j < 3; ++j)
#pragma unroll
            for (int e = 0; e < 16; ++e) ss += acc[0][j][e] * acc[0][j][e];
          ss += __shfl_xor(ss, 32);
          const float4 sa = *(const float4*)(p.stats + (long)m * 16), sb = *(const float4*)(p.stats + (long)m * 16 + 4);
          const float msq = (sa.x + sa.y + sa.z + sa.w + sb.x + sb.y + sb.z + sb.w) * (1.f / 256.f) + EPS;
          const float rs = rsqrtf(ss * (1.f / 96.f) + EPS * msq);
          int b, pos; bool isx; int irow = 0, icol = 0;
          if (m < MX) { b = m >> 12; const int n = m & 4095; pos = CTX + n; isx = true; irow = n >> 6; icol = n & 63; }
          else { const int my = m - MX; b = my >> 8; pos = my & 255; isx = false; }
          float2 tr[4], tc[4];
#pragma unroll
          for (int e = 0; e < 4; ++e) { tr[e] = *(const float2*)(ROPE + (irow * 8 + 4 * h + e) * 2); tc[e] = *(const float2*)(ROPE + (icol * 8 + 4 * h + e) * 2); }
          const int wv = ltid() >> 6;
          char* stg = lds + wv * (32 * 208);
          u16* qd = (u16*)(stg + r * 208);
#pragma unroll
          for (int j = 0; j < 2; ++j)
#pragma unroll
            for (int g4 = 0; g4 < 4; ++g4) {
              const int f0 = j * 32 + 8 * g4 + 4 * h;
              const float4 g = *(const float4*)(qg + f0);
              uint2 o;
              o.x = pk2(acc[0][j][4 * g4] * rs * g.x * QS, acc[0][j][4 * g4 + 1] * rs * g.y * QS);
              o.y = pk2(acc[0][j][4 * g4 + 2] * rs * g.z * QS, acc[0][j][4 * g4 + 3] * rs * g.w * QS);
              *(uint2*)(qd + f0) = o;
            }
          float x1[4], x2[4], x3[4], x4[4];
          {
            const float4 g1 = *(const float4*)(qg + 64 + 4 * h), g2 = *(const float4*)(qg + 72 + 4 * h);
            const float4 g3 = *(const float4*)(qg + 80 + 4 * h), g4v = *(const float4*)(qg + 88 + 4 * h);
            const float s = rs * QS;
            x1[0] = acc[0][2][0] * s * g1.x; x1[1] = acc[0][2][1] * s * g1.y; x1[2] = acc[0][2][2] * s * g1.z; x1[3] = acc[0][2][3] * s * g1.w;
            x2[0] = acc[0][2][4] * s * g2.x; x2[1] = acc[0][2][5] * s * g2.y; x2[2] = acc[0][2][6] * s * g2.z; x2[3] = acc[0][2][7] * s * g2.w;
            x3[0] = acc[0][2][8] * s * g3.x; x3[1] = acc[0][2][9] * s * g3.y; x3[2] = acc[0][2][10] * s * g3.z; x3[3] = acc[0][2][11] * s * g3.w;
            x4[0] = acc[0][2][12] * s * g4v.x; x4[1] = acc[0][2][13] * s * g4v.y; x4[2] = acc[0][2][14] * s * g4v.z; x4[3] = acc[0][2][15] * s * g4v.w;
          }
          if (isx) {
#pragma unroll
            for (int e = 0; e < 4; ++e) {
              const float cr = tr[e].x, sr = tr[e].y, cc = tc[e].x, sc = tc[e].y;
              const float a1 = x1[e] * cr - x2[e] * sr, a2 = x2[e] * cr + x1[e] * sr;
              const float a3 = x3[e] * cc - x4[e] * sc, a4 = x4[e] * cc + x3[e] * sc;
              x1[e] = a1; x2[e] = a2; x3[e] = a3; x4[e] = a4;
            }
          }
          uint2 o;
          o.x = pk2(x1[0], x1[1]); o.y = pk2(x1[2], x1[3]); *(uint2*)(qd + 64 + 4 * h) = o;
          o.x = pk2(x2[0], x2[1]); o.y = pk2(x2[2], x2[3]); *(uint2*)(qd + 72 + 4 * h) = o;
          o.x = pk2(x3[0], x3[1]); o.y = pk2(x3[2], x3[3]); *(uint2*)(qd + 80 + 4 * h) = o;
          o.x = pk2(x4[0], x4[1]); o.y = pk2(x4[2], x4[3]); *(uint2*)(qd + 88 + 4 * h) = o;
          __syncthreads();
          {
            const int m_0 = m0 + mw;
            int b0, pos0;
            if (m_0 < MX) { b0 = m_0 >> 12; pos0 = CTX + (m_0 & 4095); } else { const int my = m_0 - MX; b0 = my >> 8; pos0 = my & 255; }
            u16* dst = Qb + ((long)(b0 * 8 + head) * KPOS + pos0) * 96;
            const int lane = h * 32 + r;
#pragma unroll
            for (int q = 0; q < 6; ++q) {
              const int id = q * 64 + lane; const int row = id / 12, c = id % 12;
              *(uint4*)(dst + id * 8) = *(const uint4*)(stg + row * 208 + c * 16);
            }
          }
          __syncthreads();
        };
        gemm_loop<4, 1, 3, true, false, LdDirect<128>, LdDirect<192>>(FIRST(0), nQ, nblk, mkl, set, epi, 4, lds);
      }
      {
        int m0 = 0, n0 = 0;
        auto set = [&](int it) { m0 = (it >> 2) * 256; n0 = (it & 3) * 128; };
        {
          auto mkl = [&](int it, LdDirect<256>& la, LdDirect<128>& lb) {
            const int mt = it >> 2, nt = it & 3;
            la.base = p.p + (long)mt * 256 * NP + C_CKV; la.ld = NP;
            lb.base = p.wukv_t + ((long)l * 1024 + nt * 128) * 128; lb.ld = 128; };
          const float* kg = p.k_norm_g + l * 96;
          u16* Kb = p.k; const u16* P = p.p; const float* ROPE = p.rope;
          auto epi = [&](f32x16 (&acc)[2][2], int mw, int nw, int r, int h) {
            const int head = (n0 + nw) >> 6;
#pragma unroll
            for (int i = 0; i < 2; ++i) {
              const int m = m0 + mw + i * 32 + r;
              float kr[16];
              { const u16* kp = P + (long)m * NP + C_KROPE + 16 * h;
                unpack8(*(const uint4*)kp, kr); unpack8(*(const uint4*)(kp + 8), kr + 8); }
              int b, pos; bool isx; int ipos = 0;
              if (m < MX) { b = m >> 12; const int n = m & 4095; pos = CTX + n; isx = true; ipos = h ? (n & 63) : (n >> 6); }
              else { const int my = m - MX; b = my >> 8; pos = my & 255; isx = false; }
              float2 tr[8];
#pragma unroll
              for (int e = 0; e < 8; ++e) tr[e] = *(const float2*)(ROPE + (ipos * 8 + e) * 2);
              const float4 sk = *(const float4*)(p.stats + (long)m * 16 + 8);
              const float rkv2 = 1.f / ((sk.x + sk.y + sk.z + sk.w) * (1.f / 128.f) + EPS);
              float ssr = 0.f, ssn = 0.f;
#pragma unroll
              for (int e = 0; e < 16; ++e) ssr += kr[e] * kr[e];
#pragma unroll
              for (int j = 0; j < 2; ++j)
#pragma unroll
                for (int e = 0; e < 16; ++e) ssn += acc[i][j][e] * acc[i][j][e];
              float ss = ssr + ssn * rkv2;
              ss += __shfl_xor(ss, 32);
              const float rs = rsqrtf(ss * (1.f / 96.f) + EPS);
              const float rsn = rs * sqrtf(rkv2);
              u16* kd = (u16*)(lds + (ltid() >> 6) * (64 * 208) + (i * 32 + r) * 208);
#pragma unroll
              for (int j = 0; j < 2; ++j)
#pragma unroll
                for (int g4 = 0; g4 < 4; ++g4) {
                  const int f0 = j * 32 + 8 * g4 + 4 * h;
                  const float4 g = *(const float4*)(kg + f0);
                  uint2 o;
                  o.x = pk2(acc[i][j][4 * g4] * rsn * g.x, acc[i][j][4 * g4 + 1] * rsn * g.y);
                  o.y = pk2(acc[i][j][4 * g4 + 2] * rsn * g.z, acc[i][j][4 * g4 + 3] * rsn * g.w);
                  *(uint2*)(kd + f0) = o;
                }
              float oa[8], ob[8];
#pragma unroll
              for (int e = 0; e < 8; ++e) {
                const float xa = kr[e] * rs * kg[64 + 16 * h + e], xb = kr[8 + e] * rs * kg[64 + 16 * h + 8 + e];
                if (isx) { const float cs = tr[e].x, sn = tr[e].y; oa[e] = xa * cs - xb * sn; ob[e] = xb * cs + xa * sn; }
                else { oa[e] = xa; ob[e] = xb; }
              }
              uint4 o;
              o.x = pk2(oa[0], oa[1]); o.y = pk2(oa[2], oa[3]); o.z = pk2(oa[4], oa[5]); o.w = pk2(oa[6], oa[7]);
              *(uint4*)(kd + 64 + 16 * h) = o;
              o.x = pk2(ob[0], ob[1]); o.y = pk2(ob[2], ob[3]); o.z = pk2(ob[4], ob[5]); o.w = pk2(ob[6], ob[7]);
              *(uint4*)(kd + 64 + 16 * h + 8) = o;
            }
            __syncthreads();
            {
              const char* stg = lds + (ltid() >> 6) * (64 * 208);
              const int m_0 = m0 + mw;
              int b0, pos0;
              if (m_0 < MX) { b0 = m_0 >> 12; pos0 = CTX + (m_0 & 4095); } else { const int my = m_0 - MX; b0 = my >> 8; pos0 = my & 255; }
              u16* dst = Kb + ((long)(b0 * 8 + head) * KPOS + pos0) * 96;
              const int lane = h * 32 + r;
#pragma unroll
              for (int q = 0; q < 12; ++q) {
                const int id = q * 64 + lane; const int row = id / 12, c = id % 12;
                *(uint4*)(dst + id * 8) = *(const uint4*)(stg + row * 208 + c * 16);
              }
            }
            __syncthreads();
          };
          gemm_loop<4, 2, 2, true, false, LdDirect<256>, LdDirect<128>>(FIRST(64), nKN, nblk, mkl, set, epi, 2, lds);
        }
        {
          auto mkl = [&](int it, LdDirect<256>& la, LdDirect<128>& lb) {
            const int mt = it >> 2, nt = it & 3;
            la.base = p.p + (long)mt * 256 * NP + C_CKV; la.ld = NP;
            lb.base = p.wukv_t + ((long)l * 1024 + 512 + nt * 128) * 128; lb.ld = 128; };
          u16* VT = p.vt;
          auto epi = [&](f32x16 (&acc)[2][2], int mw, int nw, int r, int h) {
            char* stg = lds + (ltid() >> 6) * (64 * 144);
            const int m_0 = m0 + mw;
#pragma unroll
            for (int i = 0; i < 2; ++i)
#pragma unroll
              for (int g4 = 0; g4 < 4; ++g4) {
                const int tl = i * 32 + 8 * g4 + 4 * h;
                float rv[4];
#pragma unroll
                for (int e = 0; e < 4; ++e) { const float4 sk = *(const float4*)(p.stats + (long)(m_0 + tl + e) * 16 + 8);
                  rv[e] = rsqrtf((sk.x + sk.y + sk.z + sk.w) * (1.f / 128.f) + EPS); }
#pragma unroll
                for (int j = 0; j < 2; ++j) {
                  uint2 o;
                  o.x = pk2(acc[i][j][4 * g4] * rv[0], acc[i][j][4 * g4 + 1] * rv[1]); o.y = pk2(acc[i][j][4 * g4 + 2] * rv[2], acc[i][j][4 * g4 + 3] * rv[3]);
                  *(uint2*)(stg + (j * 32 + r) * 144 + tl * 2) = o;
                }
              }
            __syncthreads();
            {
              int b0, pos0;
              if (m_0 < MX) { b0 = m_0 >> 12; pos0 = CTX + (m_0 & 4095); } else { const int my = m_0 - MX; b0 = my >> 8; pos0 = my & 255; }
              const int head = (n0 + nw) >> 6;
              u16* dst = VT + ((long)(b0 * 8 + head) * 64) * KPOS + pos0;
              const int lane = h * 32 + r;
#pragma unroll
              for (int q = 0; q < 8; ++q) {
                const int id = q * 64 + lane; const int dv = id >> 3, c = id & 7;
                *(uint4*)(dst + (long)dv * KPOS + c * 8) = *(const uint4*)(stg + dv * 144 + c * 16);
              }
            }
            __syncthreads();
          };
          gemm_loop<4, 2, 2, false, false, LdDirect<256>, LdDirect<128>>(FIRST(96), nV, nblk, mkl, set, epi, 2, lds);
        }
      }
      {
        int half = 0, n2 = 0, b = 0;
        auto mkl = [&](int it, LdDirect<128>& la, LdTrans<128>& lb) {
          const int half_ = it & 1, n2_ = (it >> 1) & 63, b_ = it >> 7;
          la.base = p.t1; la.ld = 64;
          lb.base = p.p + (long)(b_ * 4096 + n2_) * NP + C_FIN + half_ * 128; lb.strideK = 64L * NP; };
        auto set = [&](int it) { half = it & 1; n2 = (it >> 1) & 63; b = it >> 7; };
        u16* A1 = p.a1; const float* TW = p.tw;
        auto epi = [&](f32x16 (&acc)[2][1], int mw, int nw, int r, int h) {
          const int gc = half * 128 + nw + r;
          float2 t[16];
#pragma unroll
          for (int e = 0; e < 16; ++e) t[e] = *(const float2*)(TW + 2 * (n2 * ((mw >> 1) + crow(e, h))));
#pragma unroll
          for (int e = 0; e < 16; ++e) {
            const int k1 = (mw >> 1) + crow(e, h);
            const float re = acc[0][0][e], im = acc[1][0][e];
            const float re2 = re * t[e].x + im * t[e].y, im2 = im * t[e].x - re * t[e].y;
            const long o = ((((long)b * 64 + k1) * 64 + n2) * 2) * 256 + gc;
            A1[o] = f2bf(re2); A1[o + 256] = f2bf(im2);
          }
        };
        gemm_loop<2, 2, 1, false, true, LdDirect<128>, LdTrans<128>>(FIRST(0), nF1, nblk, mkl, set, epi, 1, lds);
      }
      {
        int half = 0, mt = 0, b = 0;
        auto mkl = [&](int it, LdDirect<128>& la, LdTrans<128>& lb) {
          const int half_ = it & 1, mt_ = (it >> 1) & 3, b_ = it >> 3;
          la.base = p.t256 + (long)mt_ * 128 * 256; la.ld = 256;
          lb.base = p.p + (long)(MX + b_ * 256) * NP + C_FIN + half_ * 128; lb.strideK = (long)NP; };
        auto set = [&](int it) { half = it & 1; mt = (it >> 1) & 3; b = it >> 3; };
        u16* YF = p.yf;
        auto epi = [&](f32x16 (&acc)[1][2], int mw, int nw, int r, int h) {
#pragma unroll
          for (int j = 0; j < 2; ++j) {
            const int gc = half * 128 + nw + j * 32 + r; const int g = gc >> 6, c2 = gc & 63;
#pragma unroll
            for (int e = 0; e < 16; ++e) {
              const int rho = mt * 128 + mw + crow(e, h); const int ri = rho >> 8, k = rho & 255;
              YF[(long)(MX + b * 256 + k) * 512 + g * 128 + ri * 64 + c2] = f2bf(acc[0][j][e]);
            }
          }
        };
        gemm_loop<4, 1, 2, false, true, LdDirect<128>, LdTrans<128>>(FIRST(128), nFy, nblk, mkl, set, epi, 4, lds);
      }
      {
        int hd = 0, row0 = 0;
        auto mkl = [&](int it, LdDirect<128>& la, LdLN4& lb) {
          const int hd_ = it & 3, qd_ = it >> 2;
          la.base = p.gws_b + (long)(l * 4 + hd_) * 128 * 128; la.ld = 128;
          lb.base = p.p + (long)qd_ * 512 * NP + C_GV + hd_ * 64; lb.g = p.g_ln_g + l * 64; };
        auto set = [&](int it) { hd = it & 3; row0 = (it >> 2) * 512; };
        const u16* P = p.p; u16* MIX = p.hmix;
        auto epi = [&](f32x16 (&acc)[1][4], int mw, int nw, int r, int h) {
          const float bias = p.g_bs[(l * 4 + hd) * 128 + mw + r];
          char* stg = lds + (ltid() >> 6) * (32 * 272);
#pragma unroll
          for (int jj = 0; jj < 2; ++jj) {
#pragma unroll
            for (int j2 = 0; j2 < 2; ++j2)
#pragma unroll
              for (int g4 = 0; g4 < 4; ++g4)
                *(float4*)(stg + r * 272 + (j2 * 32 + 8 * g4 + 4 * h) * 4) =
                    make_float4(acc[0][2 * jj + j2][4 * g4] + bias, acc[0][2 * jj + j2][4 * g4 + 1] + bias, acc[0][2 * jj + j2][4 * g4 + 2] + bias, acc[0][2 * jj + j2][4 * g4 + 3] + bias);
            __syncthreads();
            const long row_w = row0 + ((nw >> 6) + jj) * 128 + mw;
            staged_gate_store<32, 8, 272, true>(stg, h * 32 + r, P + row_w * NP + C_GGATE + hd * 64, P + row_w * NP + C_GU + hd * 64, NP,
                                               MIX + row_w * 1024 + 256 + hd * 64, 1024);
            __syncthreads();
          }
        };
        gemm_loop<4, 1, 4, true, true, LdDirect<128>, LdLN4>(FIRST(192), nG, nblk, mkl, set, epi, 2, lds);
      }
    }
    xcd_barrier(xb);

    {
      {
        int half = 0, k1 = 0, b = 0;
        auto mkl = [&](int it, LdDirect<128>& la, LdTrans<128>& lb) {
          const int half_ = it & 1, k1_ = (it >> 1) & 63, b_ = it >> 7;
          la.base = p.t2; la.ld = 128;
          lb.base = p.a1 + (((long)b_ * 64 + k1_) * 64 * 2) * 256 + half_ * 128; lb.strideK = 256L; };
        auto set = [&](int it) { half = it & 1; k1 = (it >> 1) & 63; b = it >> 7; };
        u16* YF = p.yf;
        auto epi = [&](f32x16 (&acc)[1][2], int mw, int nw, int r, int h) {
#pragma unroll
          for (int j = 0; j < 2; ++j) {
            const int gc = half * 128 + nw + j * 32 + r; const int g = gc >> 6, c2 = gc & 63;
#pragma unroll
            for (int e = 0; e < 16; ++e) {
              const int rho = mw + crow(e, h); const int ri = rho >> 6, k2 = rho & 63;
              YF[(long)(b * 4096 + k1 + 64 * k2) * 512 + g * 128 + ri * 64 + c2] = f2bf(acc[0][j][e]);
            }
          }
        };
        gemm_loop<4, 1, 2, false, true, LdDirect<128>, LdTrans<128>>(bid, 1024, nblk, mkl, set, epi, 2, lds);
      }
    {
      const u16* mf = p.mf_t + (long)l * 256 * 512;
      int m0 = 0, n0 = 0;
      auto mkl = [&](int it, LdDirect<256>& la, LdDirect<128>& lb) {
        const int mt = it >> 1, nt = it & 1;
        la.base = p.yf + (long)mt * 256 * 512; la.ld = 512; lb.base = mf + (long)nt * 128 * 512; lb.ld = 512; };
      auto set = [&](int it) { m0 = (it >> 1) * 256; n0 = (it & 1) * 128; };
      const u16* P = p.p; u16* MIX = p.hmix;
      auto epi = [&](f32x16 (&acc)[2][2], int mw, int nw, int r, int h) {
        const float sc = (m0 < MX) ? (1.f / 512.f) : (1.f / 128.f);
#pragma unroll
        for (int i = 0; i < 2; ++i) {
          u16 gv[2][16];
#pragma unroll
          for (int j = 0; j < 2; ++j)
#pragma unroll
            for (int e = 0; e < 16; ++e)
              gv[j][e] = P[(long)(m0 + mw + i * 32 + crow(e, h)) * NP + C_FGATE + n0 + nw + j * 32 + r];
#pragma unroll
          for (int j = 0; j < 2; ++j)
#pragma unroll
            for (int e = 0; e < 16; ++e)
              MIX[(long)(m0 + mw + i * 32 + crow(e, h)) * 1024 + n0 + nw + j * 32 + r] = f2bf(acc[i][j][e] * sc * silu(bf2f(gv[j][e])));
        }
      };
      gemm_loop<4, 2, 2, false, false, LdDirect<256>, LdDirect<128>>(128 * 2 + ((bid + nblk - 200) % nblk), (l == DEPTH - 1) ? 128 * 2 : 136 * 2, nblk, mkl, set, epi, 8, lds);
    }
      float negB;
      {
        float gq = 0.f, gk = 0.f;
        for (int i = 0; i < 96; ++i) { gq = fmaxf(gq, fabsf(p.q_norm_g[l * 96 + i])); gk = fmaxf(gk, fabsf(p.k_norm_g[l * 96 + i])); }
        negB = -(96.f * gq * gk * (0.10206207261596575f * 1.4426950408889634f) * 1.02f + 0.5f);
      }
      for (int it = bid; it < 512; it += nblk) {
        const int rnd = it / nblk; const int lb_ = it % nblk;
        int bh, qb;
        if (nblk == 256) { const int xcd = lb_ & 7, slot = lb_ >> 3; bh = rnd * 32 + xcd * 4 + (slot >> 3); qb = slot & 7; }
        else { bh = it >> 3; qb = it & 7; }
        const int b = bh >> 3, hd = bh & 7;
        const long bhoff = (long)(b * 8 + hd);
        const long row_base = (long)b * 4096 + qb * 512;
        attn_item64(p.q + bhoff * KPOS * 96, p.k + bhoff * KPOS * 96, p.vt + bhoff * 64 * KPOS, CTX + qb * 512, KPOS,
                    p.p + row_base * NP + C_AGATE + hd * 64, p.hmix + row_base * 1024 + 512 + hd * 64, lds);
      }
      if (l < DEPTH - 1) {
        for (int bh = (bid + nblk - 64) % nblk; bh < 64; bh += nblk) {
          const int b = bh >> 3, hd = bh & 7;
          const long bhoff = (long)(b * 8 + hd);
          const long row_base = (long)MX + b * 256;
          attn_item(p.q + bhoff * KPOS * 96, p.k + bhoff * KPOS * 96, p.vt + bhoff * 64 * KPOS, 0, CTX,
                    p.p + row_base * NP + C_AGATE + hd * 64, p.hmix + row_base * 1024 + 512 + hd * 64, negB, lds);
        }
      }
    }
    xcd_barrier(xb);

    {
      const u16* mf = p.mf_t + (long)l * 256 * 512;
      int m0 = 0, n0 = 0;
      auto mkl = [&](int it, LdDirect<256>& la, LdDirect<128>& lb) {
        const int mt = it >> 1, nt = it & 1;
        la.base = p.yf + (long)mt * 256 * 512; la.ld = 512; lb.base = mf + (long)nt * 128 * 512; lb.ld = 512; };
      auto set = [&](int it) { m0 = (it >> 1) * 256; n0 = (it & 1) * 128; };
      const u16* P = p.p; u16* MIX = p.hmix;
      auto epi = [&](f32x16 (&acc)[2][2], int mw, int nw, int r, int h) {
        const float sc = (m0 < MX) ? (1.f / 512.f) : (1.f / 128.f);
#pragma unroll
        for (int i = 0; i < 2; ++i) {
          u16 gv[2][16];
#pragma unroll
          for (int j = 0; j < 2; ++j)
#pragma unroll
            for (int e = 0; e < 16; ++e)
              gv[j][e] = P[(long)(m0 + mw + i * 32 + crow(e, h)) * NP + C_FGATE + n0 + nw + j * 32 + r];
#pragma unroll
          for (int j = 0; j < 2; ++j)
#pragma unroll
            for (int e = 0; e < 16; ++e)
              MIX[(long)(m0 + mw + i * 32 + crow(e, h)) * 1024 + n0 + nw + j * 32 + r] = f2bf(acc[i][j][e] * sc * silu(bf2f(gv[j][e])));
        }
      };
      gemm_loop<4, 2, 2, false, false, LdDirect<256>, LdDirect<128>>(bid, 128 * 2, nblk, mkl, set, epi, 8, lds);
    }
    xcd_barrier(xb);

    {
      const u16* wt = p.wout_t + (long)l * 1024 * 1024;
      int m0 = 0, n0 = 0;
      auto epi = [&](auto& acc, int mw, int nw, int r, int h) {
        constexpr int WM_ = sizeof(acc) / sizeof(acc[0]), WN_ = sizeof(acc[0]) / sizeof(acc[0][0]);
        const bool isx = m0 < MX;
        const float* __restrict__ src = isx ? (l == 0 ? p.x : p.out) + (long)m0 * 1024 : (l == 0 ? p.ctx : p.yw) + (long)(m0 - MX) * 1024;
        float* __restrict__ dst = isx ? p.out + (long)m0 * 1024 : p.yw + (long)(m0 - MX) * 1024;
        const float* gp = modl + (isx ? (m0 >> 12) : 8) * 3072 + 2048;
#pragma unroll
        for (int i = 0; i < WM_; ++i) {
          float old[WN_][16];
#pragma unroll
          for (int j = 0; j < WN_; ++j)
#pragma unroll
            for (int e = 0; e < 16; ++e)
              old[j][e] = src[(long)(mw + i * 32 + crow(e, h)) * 1024 + n0 + nw + j * 32 + r];
#pragma unroll
          for (int j = 0; j < WN_; ++j) {
            const float gt = gp[n0 + nw + j * 32 + r];
#pragma unroll
            for (int e = 0; e < 16; ++e)
              dst[(long)(mw + i * 32 + crow(e, h)) * 1024 + n0 + nw + j * 32 + r] = old[j][e] + gt * acc[i][j][e];
          }
        }
      };
      {
        auto mkl = [&](int j, LdDirect<256>& la, LdDirect<128>& lb) {
          const int mt = (j >> 3) * 8 + (bid & 7), nt = j & 7;
          la.base = p.hmix + (long)mt * 256 * 1024; la.ld = 1024; lb.base = wt + (long)nt * 128 * 1024; lb.ld = 1024; };
        auto set = [&](int j) { m0 = ((j >> 3) * 8 + (bid & 7)) * 256; n0 = (j & 7) * 128; };
        gemm_loop3<16, 4, 2, 2, false, false, LdDirect<256>, LdDirect<128>>(bid >> 3, 16 * 8, nblk >> 3, mkl, set, epi, lds);
      }
      if (l < DEPTH - 1) {
        auto mkl = [&](int it, LdDirect<128>& la, LdDirect<64>& lb) {
          const int mt = it >> 4, nt = it & 15;
          la.base = p.hmix + (long)(MX + mt * 128) * 1024; la.ld = 1024; lb.base = wt + (long)nt * 64 * 1024; lb.ld = 1024; };
        auto set = [&](int it) { m0 = MX + (it >> 4) * 128; n0 = (it & 15) * 64; };
        gemm_loop<4, 1, 1, false, false, LdDirect<128>, LdDirect<64>>(bid, 16 * 16, nblk, mkl, set, epi, 16, lds);
      }
    }
    if (l < DEPTH - 1) xcd_barrier(xb);
  }
}

static inline size_t al256(size_t x) { return (x + 255) / 256 * 256; }

extern "C" void kernel_launch(void* const* d_in, const int* in_sizes, int n_in,
                              void* d_out, int out_size, void* d_ws, size_t ws_size,
                              hipStream_t stream) {
  static int grid_blocks = 0;
  if (!grid_blocks) {
    int dev = 0, cus = 0, per_cu = 0;
    (void)hipGetDevice(&dev);
    (void)hipDeviceGetAttribute(&cus, hipDeviceAttributeMultiprocessorCount, dev);
    (void)hipFuncSetAttribute((const void*)fwd_megakernel, hipFuncAttributeMaxDynamicSharedMemorySize, LDS_BYTES);
    (void)hipOccupancyMaxActiveBlocksPerMultiprocessor(&per_cu, fwd_megakernel, NT_, LDS_BYTES);
    if (per_cu < 1) { fprintf(stderr, "occupancy query returned %d\n", per_cu); per_cu = 1; }
    grid_blocks = cus;
  }
  Params p{};
  p.x = (const float*)d_in[0]; p.c = (const float*)d_in[1]; p.ctx = (const float*)d_in[2]; p.c_ctx = (const float*)d_in[3];
  p.w_mod = (const float*)d_in[4]; p.b_mod = (const float*)d_in[5]; p.norm_g = (const float*)d_in[6]; p.w_in = (const float*)d_in[7];
  p.w_fmix = (const float*)d_in[8]; p.g_ln_g = (const float*)d_in[9]; p.g_ws = (const float*)d_in[10]; p.g_bs = (const float*)d_in[11];
  p.q_a_g = (const float*)d_in[12]; p.w_uq = (const float*)d_in[13]; p.kv_a_g = (const float*)d_in[14]; p.w_ukv = (const float*)d_in[15];
  p.q_norm_g = (const float*)d_in[16]; p.k_norm_g = (const float*)d_in[17]; p.w_out = (const float*)d_in[18];
  p.out = (float*)d_out;
  char* ws = (char*)d_ws; size_t off = 0;
  auto take = [&](size_t bytes) { char* r = ws + off; off = al256(off + bytes); return r; };
  p.bar = (unsigned*)take((size_t)XCD_BAR_WORDS * 4);
  p.yw = (float*)take((size_t)MY * 1024 * 4);
  p.mod = (float*)take((size_t)DEPTH * 9 * 3072 * 4);
  p.tw = (float*)take(4096 * 2 * 4);
  p.rope = (float*)take(64 * 8 * 2 * 4);
  p.stats = (float*)take((size_t)MT * 16 * 4);
  p.win_t = (u16*)take((size_t)DEPTH * NP * 1024 * 2);
  p.wout_t = (u16*)take((size_t)DEPTH * 1024 * 1024 * 2);
  p.wuq_t = (u16*)take((size_t)DEPTH * 768 * 256 * 2);
  p.wukv_t = (u16*)take((size_t)DEPTH * 1024 * 128 * 2);
  p.gws_b = (u16*)take((size_t)DEPTH * 4 * 128 * 128 * 2);
  p.mf_t = (u16*)take((size_t)DEPTH * 256 * 512 * 2);
  p.t1 = (u16*)take(128 * 64 * 2);
  p.t2 = (u16*)take(128 * 128 * 2);
  p.t256 = (u16*)take(512 * 256 * 2);
  p.hmix = (u16*)take((size_t)MT * 1024 * 2);
  p.p = (u16*)take((size_t)MT * NP * 2);
  p.q = (u16*)take((size_t)NB * 8 * KPOS * 96 * 2);
  p.k = (u16*)take((size_t)NB * 8 * KPOS * 96 * 2);
  p.vt = (u16*)take((size_t)NB * 8 * 64 * KPOS * 2);
  p.a1 = (u16*)take((size_t)NB * 64 * 64 * 2 * 256 * 2);
  p.yf = (u16*)take((size_t)MT * 512 * 2);
  if (off > ws_size) { fprintf(stderr, "workspace too small: need %zu have %zu\n", off, ws_size); return; }
  (void)hipMemsetAsync(p.bar, 0, (size_t)XCD_BAR_WORDS * 4, stream);
  void* args[] = {&p};
  hipError_t e = hipLaunchCooperativeKernel((void*)fwd_megakernel, dim3(grid_blocks), dim3(NT_), args, LDS_BYTES, stream);
  if (e != hipSuccess) fprintf(stderr, "cooperative launch failed: %s (grid %d)\n", hipGetErrorString(e), grid_blocks);
}
```

```cpp
#include <hip/hip_runtime.h>
#include <hip/hip_cooperative_groups.h>
#include <cstdio>
#include <cstdint>
namespace cg = cooperative_groups;

typedef unsigned short u16;
typedef __attribute__((ext_vector_type(8))) short bf16x8;
typedef __attribute__((ext_vector_type(16))) float f32x16;
typedef __attribute__((ext_vector_type(2))) __bf16 bf2_t;
typedef __attribute__((ext_vector_type(2))) float f2_t;
#define DI __device__ __forceinline__

constexpr int NB = 8, SEQ = 4096, DEPTH = 4, CTX = 256;
constexpr int MX = NB * SEQ, MY = NB * CTX, MT = MX + MY;
constexpr int NP = 2304, INW = 2208;
constexpr int C_FIN = 0, C_FGATE = 256, C_GU = 512, C_GV = 768, C_GGATE = 1024, C_CQ = 1280, C_CKV = 1536, C_KROPE = 1664, C_AGATE = 1696;
constexpr int KPOS = CTX + SEQ;
constexpr int NT_ = 512;
constexpr int PITCH = 144;
constexpr int LDS_BYTES = 131072;
constexpr int RSTD_OFF = 129024;
constexpr float EPS = 1e-6f;
constexpr float PI_F = 3.14159265358979323846f;

struct Params {
  const float *x, *c, *ctx, *c_ctx, *w_mod, *b_mod, *norm_g, *w_in, *w_fmix, *g_ln_g, *g_ws, *g_bs, *q_a_g, *w_uq, *kv_a_g, *w_ukv, *q_norm_g, *k_norm_g, *w_out;
  float* out;
  unsigned* bar;
  float *yw, *mod, *tw, *rope, *stats;
  u16 *win_t, *wout_t, *wuq_t, *wukv_t, *gws_b, *mf_t, *t1, *t2, *t256, *hmix, *p, *q, *k, *vt, *a1, *yf;
};

DI int ltid() { int t = threadIdx.x; asm volatile("" : "+v"(t)); return t; }
DI float bf2f(u16 v) { return __uint_as_float(((unsigned)v) << 16); }
DI unsigned pk2(float a, float b) { f2_t v = {a, b}; bf2_t r = __builtin_convertvector(v, bf2_t); return __builtin_bit_cast(unsigned, r); }
DI u16 f2bf(float a) { return (u16)(pk2(a, 0.f) & 0xffffu); }
DI float silu(float x) { return x / (1.f + __expf(-x)); }
DI int crow(int reg, int h) { return (reg & 3) + 8 * (reg >> 2) + 4 * h; }
DI float lo16(unsigned w) { return __uint_as_float(w << 16); }
DI float hi16(unsigned w) { return __uint_as_float(w & 0xffff0000u); }
DI f32x16 mfma(bf16x8 a, bf16x8 b, f32x16 c) { return __builtin_amdgcn_mfma_f32_32x32x16_bf16(a, b, c, 0, 0, 0); }
DI void unpack8(const uint4& v, float* f) {
  f[0] = lo16(v.x); f[1] = hi16(v.x); f[2] = lo16(v.y); f[3] = hi16(v.y);
  f[4] = lo16(v.z); f[5] = hi16(v.z); f[6] = lo16(v.w); f[7] = hi16(v.w);
}

#define XB_TMO      128
#define XB_XCNT(j)  (256  + 64 * (j))
#define XB_XSUB(j)  (1280 + 64 * (j))
#define XB_XGEN(j)  (2304 + 64 * (j))
#define XB_TOP      3328
#define XB_TOPGEN   3392
#define XCD_BAR_WORDS 3456
#define XB_SPIN_CAP (1u << 18)
#define LAS __attribute__((address_space(3)))
DI unsigned xb_ld(unsigned* p)              { return __hip_atomic_load(p, __ATOMIC_RELAXED, __HIP_MEMORY_SCOPE_AGENT); }
DI unsigned xb_add(unsigned* p, unsigned v) { return __hip_atomic_fetch_add(p, v, __ATOMIC_RELAXED, __HIP_MEMORY_SCOPE_AGENT); }
DI unsigned xb_xcc_id() { return (unsigned)__builtin_amdgcn_s_getreg((3 << 11) | 20) & 0xFu; }
#define XB_SPIN(cond, bar) do { unsigned _sp = 0; while (cond) { __builtin_amdgcn_s_sleep(1); \
    if ((++_sp & 255u) == 0u) { if (xb_ld(&(bar)[XB_TMO])) break; if (_sp > XB_SPIN_CAP) { atomicAdd(&(bar)[XB_TMO], 1u); break; } } } } while (0)
struct XcdBarrier { unsigned* bar; unsigned x; volatile LAS unsigned* st; };
DI XcdBarrier xcd_barrier_post(unsigned* bar, volatile LAS unsigned* st) {
  XcdBarrier b; b.bar = bar; b.x = xb_xcc_id(); b.st = st;
  if (threadIdx.x == 0) (void)xb_add(&bar[XB_XCNT(b.x)], 1u);
  return b;
}
DI void xcd_barrier_complete(unsigned* bar, unsigned x, unsigned& nloc, unsigned& nx) {
  const unsigned G = gridDim.x * gridDim.y * gridDim.z;
  unsigned sum, cnt, mine, sp = 0u;
  for (;;) {
    sum = 0u; cnt = 0u; mine = 0u;
#pragma unroll
    for (unsigned j = 0; j < 16; ++j) { const unsigned c = xb_ld(&bar[XB_XCNT(j)]); sum += c; cnt += (c > 0u) ? 1u : 0u; mine = (j == x) ? c : mine; }
    if (sum == G) break;
    __builtin_amdgcn_s_sleep(1);
    if ((++sp & 255u) == 0u) { if (xb_ld(&bar[XB_TMO])) break; if (sp > XB_SPIN_CAP) { atomicAdd(&bar[XB_TMO], 1u); break; } }
  }
  nloc = mine > 0u ? mine : 1u; nx = cnt > 0u ? cnt : 1u;
}
DI void xcd_barrier(const XcdBarrier& b) {
  asm volatile("s_waitcnt vmcnt(0)" ::: "memory");
  __syncthreads();
  if (threadIdx.x == 0) {
    unsigned* bar = b.bar;
    __builtin_amdgcn_s_waitcnt(0);
    unsigned nloc = b.st[0], nx = b.st[1];
    if (nloc == 0u) { xcd_barrier_complete(bar, b.x, nloc, nx); b.st[0] = nloc; b.st[1] = nx; }
    const unsigned old = xb_add(&bar[XB_XSUB(b.x)], 1u);
    const unsigned gen = old / nloc;
    if (old + 1u == (gen + 1u) * nloc) {
      __builtin_amdgcn_fence(__ATOMIC_RELEASE, "agent");
      asm volatile("s_waitcnt vmcnt(0)" ::: "memory");
      const unsigned og = xb_add(&bar[XB_TOP], 1u);
      const unsigned tg = og / nx;
      if (og + 1u == (tg + 1u) * nx) xb_add(&bar[XB_TOPGEN], 1u);
      else XB_SPIN(xb_ld(&bar[XB_TOPGEN]) == tg, bar);
      __builtin_amdgcn_fence(__ATOMIC_ACQUIRE, "agent");
      xb_add(&bar[XB_XGEN(b.x)], 1u);
      asm volatile("s_waitcnt vmcnt(0)" ::: "memory");
    } else {
      XB_SPIN(xb_ld(&bar[XB_XGEN(b.x)]) == gen, bar);
      __builtin_amdgcn_fence(__ATOMIC_ACQUIRE, "agent");
      asm volatile("s_waitcnt vmcnt(0)" ::: "memory");
    }
  }
  __syncthreads();
}


template <int ROWS> struct LdDirect {
  static constexpr int NR = ROWS * 8 / NT_;
  struct Regs { uint4 v[NR]; };
  const u16* base; long ld;
  DI Regs fetch(int kt, int tid) const { Regs r;
#pragma unroll
    for (int i = 0; i < NR; ++i) { int id = tid + NT_ * i; int row = id >> 3, kc = id & 7;
      r.v[i] = *(const uint4*)(base + (long)row * ld + kt * 64 + kc * 8); }
    return r;
  }
  DI void commit(char* s, const Regs& r, int, int tid) const {
#pragma unroll
    for (int i = 0; i < NR; ++i) { int id = tid + NT_ * i; int row = id >> 3, kc = id & 7;
      *(uint4*)(s + row * PITCH + kc * 16) = r.v[i]; }
  }
};
template <int ROWS> struct LdScaled {
  static constexpr int NR = ROWS * 8 / NT_;
  struct Regs { uint4 v[NR]; };
  const u16* base; long ld; const float* g; const float* rstd_s;
  DI Regs fetch(int kt, int tid) const { Regs r;
#pragma unroll
    for (int i = 0; i < NR; ++i) { int id = tid + NT_ * i; int row = id >> 3, kc = id & 7;
      r.v[i] = *(const uint4*)(base + (long)row * ld + kt * 64 + kc * 8); }
    return r;
  }
  DI void commit(char* s, const Regs& r, int kt, int tid) const {
#pragma unroll
    for (int i = 0; i < NR; ++i) { int id = tid + NT_ * i; int row = id >> 3, kc = id & 7;
      float f[8]; unpack8(r.v[i], f);
      const float rs = rstd_s[row];
      const float4 g0 = *(const float4*)(g + kt * 64 + kc * 8), g1 = *(const float4*)(g + kt * 64 + kc * 8 + 4);
      uint4 o;
      o.x = pk2(f[0] * rs * g0.x, f[1] * rs * g0.y); o.y = pk2(f[2] * rs * g0.z, f[3] * rs * g0.w);
      o.z = pk2(f[4] * rs * g1.x, f[5] * rs * g1.y); o.w = pk2(f[6] * rs * g1.z, f[7] * rs * g1.w);
      *(uint4*)(s + row * PITCH + kc * 16) = o; }
  }
};
template <int BN> struct LdTrans {
  static constexpr int NC = BN / 8;
  static constexpr int NR = 32 * NC / NT_;
  struct Regs { uint4 v[2 * NR]; };
  const u16* base; long strideK;
  DI Regs fetch(int kt, int tid) const { Regs r;
#pragma unroll
    for (int i = 0; i < NR; ++i) { int id = tid + NT_ * i; int nc = id % NC, k2 = id / NC;
      r.v[2 * i] = *(const uint4*)(base + (long)(kt * 64 + 2 * k2) * strideK + nc * 8);
      r.v[2 * i + 1] = *(const uint4*)(base + (long)(kt * 64 + 2 * k2 + 1) * strideK + nc * 8); }
    return r;
  }
  DI void commit(char* s, const Regs& r, int, int tid) const {
#pragma unroll
    for (int i = 0; i < NR; ++i) { int id = tid + NT_ * i; int nc = id % NC, k = 2 * (id / NC);
      const int off = (((k >> 3) ^ (nc & 7)) << 4) + (k & 7) * 2;
      char* d = s + (nc * 8) * PITCH + off;
      const unsigned a[4] = {r.v[2 * i].x, r.v[2 * i].y, r.v[2 * i].z, r.v[2 * i].w};
      const unsigned c[4] = {r.v[2 * i + 1].x, r.v[2 * i + 1].y, r.v[2 * i + 1].z, r.v[2 * i + 1].w};
#pragma unroll
      for (int e = 0; e < 8; ++e) {
        const unsigned lo = (e & 1) ? (a[e >> 1] >> 16) : (a[e >> 1] & 0xffffu);
        const unsigned hi = (e & 1) ? (c[e >> 1] & 0xffff0000u) : (c[e >> 1] << 16);
        *(unsigned*)(d + e * PITCH) = lo | hi; } }
  }
};
struct LdLN {
  static constexpr int NR = 1;
  struct Regs { uint4 v[1]; };
  const u16* base; const float* g;
  DI Regs fetch(int kt, int tid) const { Regs r; int id = tid; int nc = id & 7, k = id >> 3;
    r.v[0] = *(const uint4*)(base + (long)(kt * 64 + k) * NP + nc * 8); return r; }
  DI void commit(char* s, const Regs& r, int, int tid) const {
    int id = tid; int nc = id & 7, k = id >> 3;
    float f[8]; unpack8(r.v[0], f);
    float sm = 0.f;
#pragma unroll
    for (int e = 0; e < 8; ++e) sm += f[e];
    sm += __shfl_xor(sm, 1); sm += __shfl_xor(sm, 2); sm += __shfl_xor(sm, 4);
    const float mean = sm * (1.f / 64.f);
    float sq = 0.f;
#pragma unroll
    for (int e = 0; e < 8; ++e) { f[e] -= mean; sq += f[e] * f[e]; }
    sq += __shfl_xor(sq, 1); sq += __shfl_xor(sq, 2); sq += __shfl_xor(sq, 4);
    const float rs = rsqrtf(sq * (1.f / 64.f) + EPS);
    const int off = (((k >> 3) ^ (nc & 7)) << 4) + (k & 7) * 2;
    char* d = s + (nc * 8) * PITCH + off;
#pragma unroll
    for (int e = 0; e < 8; ++e) *(u16*)(d + e * PITCH) = f2bf(f[e] * rs * g[nc * 8 + e]);
  }
};

template <int WM, int WN, bool SWAP, bool SWZB>
DI void gemm_compute(f32x16 (&acc)[WM][WN], const char* a_s, const char* b_s, int brow0, int h) {
#pragma unroll
  for (int ks = 0; ks < 4; ++ks) {
    bf16x8 af[WM], bfr[WN];
#pragma unroll
    for (int i = 0; i < WM; ++i) af[i] = *(const bf16x8*)(a_s + i * 32 * PITCH + (ks * 2 + h) * 16);
#pragma unroll
    for (int j = 0; j < WN; ++j) {
      const int row = brow0 + j * 32;
      const int ch = SWZB ? ((ks * 2 + h) ^ ((row >> 3) & 7)) : (ks * 2 + h);
      bfr[j] = *(const bf16x8*)(b_s + j * 32 * PITCH + ch * 16);
    }
#pragma unroll
    for (int i = 0; i < WM; ++i)
#pragma unroll
      for (int j = 0; j < WN; ++j)
        acc[i][j] = SWAP ? mfma(bfr[j], af[i], acc[i][j]) : mfma(af[i], bfr[j], acc[i][j]);
  }
}
struct LdLN4 {
  static constexpr int NR = 4;
  struct Regs { uint4 v[4]; };
  const u16* base; const float* g;
  DI Regs fetch(int kt, int tid) const { Regs r;
    const int nc = tid & 7, kq = (tid >> 3) & 15, ci = tid >> 7;
#pragma unroll
    for (int j = 0; j < 4; ++j) r.v[j] = *(const uint4*)(base + (long)(ci * 128 + kt * 64 + 4 * kq + j) * NP + nc * 8);
    return r; }
  DI void commit(char* s, const Regs& r, int, int tid) const {
    const int nc = tid & 7, kq = (tid >> 3) & 15, ci = tid >> 7;
    float gg[8];
#pragma unroll
    for (int e = 0; e < 8; ++e) gg[e] = g[nc * 8 + e];
    float f[4][8];
#pragma unroll
    for (int j = 0; j < 4; ++j) {
      unpack8(r.v[j], f[j]);
      float sm = 0.f;
#pragma unroll
      for (int e = 0; e < 8; ++e) sm += f[j][e];
      sm += __shfl_xor(sm, 1); sm += __shfl_xor(sm, 2); sm += __shfl_xor(sm, 4);
      const float mean = sm * (1.f / 64.f);
      float sq = 0.f;
#pragma unroll
      for (int e = 0; e < 8; ++e) { f[j][e] -= mean; sq += f[j][e] * f[j][e]; }
      sq += __shfl_xor(sq, 1); sq += __shfl_xor(sq, 2); sq += __shfl_xor(sq, 4);
      const float rs = rsqrtf(sq * (1.f / 64.f) + EPS);
#pragma unroll
      for (int e = 0; e < 8; ++e) f[j][e] *= rs * gg[e];
    }
    const int k = 4 * kq;
    const int off = (((k >> 3) ^ (nc & 7)) << 4) + (k & 7) * 2;
    char* d = s + (ci * 64 + nc * 8) * PITCH + off;
#pragma unroll
    for (int e = 0; e < 8; ++e) { uint2 o; o.x = pk2(f[0][e], f[1][e]); o.y = pk2(f[2][e], f[3][e]); *(uint2*)(d + e * PITCH) = o; }
  }
};
template <class LA, class LB> struct GemmPre { typename LA::Regs a0, a1; typename LB::Regs b0, b1; };
template <class LA, class LB>
DI GemmPre<LA, LB> gemm_prefetch(const LA& la, const LB& lb, int nkt) {
  const int tid = ltid();
  GemmPre<LA, LB> pre;
  const int k1 = nkt > 1 ? 1 : 0;
  pre.a0 = la.fetch(0, tid); pre.b0 = lb.fetch(0, tid);
  pre.a1 = la.fetch(k1, tid); pre.b1 = lb.fetch(k1, tid);
  return pre;
}
template <int WGM, int WM, int WN, bool SWAP, bool SWZB, class LA, class LB, class EPI>
DI GemmPre<LA, LB> gemm_tile(const LA& la, const LB& lb, const EPI& epi, int nkt, char* lds, const GemmPre<LA, LB>& pre, const LA& lan, const LB& lbn) {
  constexpr int WGN = 8 / WGM;
  constexpr int BM = WGM * WM * 32, BN = WGN * WN * 32;
  constexpr int ASZ = BM * PITCH, BSZ = BN * PITCH;
  char* As = lds; char* Bs = lds + 2 * ASZ;
  const int tid = ltid(), w = tid >> 6, lane = tid & 63, r = lane & 31, h = lane >> 5;
  const int wm = w / WGN, wn = w % WGN;
  f32x16 acc[WM][WN];
#pragma unroll
  for (int i = 0; i < WM; ++i)
#pragma unroll
    for (int j = 0; j < WN; ++j)
#pragma unroll
      for (int e = 0; e < 16; ++e) acc[i][j][e] = 0.f;
  typename LA::Regs ra0 = pre.a0, ra1 = pre.a1; typename LB::Regs rb0 = pre.b0, rb1 = pre.b1;
  la.commit(As, ra0, 0, tid); lb.commit(Bs, rb0, 0, tid);
  __syncthreads();
  const int a_off = (wm * WM * 32 + r) * PITCH, b_off = (wn * WN * 32 + r) * PITCH;
  const int k1n = nkt > 1 ? 1 : 0;
#define GEMM_COMPUTE(cur) gemm_compute<WM, WN, SWAP, SWZB>(acc, As + (cur) * ASZ + a_off, Bs + (cur) * BSZ + b_off, wn * WN * 32 + r, h)
  if (nkt == 1) {
    ra0 = lan.fetch(0, tid); rb0 = lbn.fetch(0, tid);
    GEMM_COMPUTE(0);
    ra1 = ra0; rb1 = rb0;
    __syncthreads();
  } else {
    for (int kt = 0; kt < nkt; kt += 2) {
      const bool more = kt + 2 < nkt;
      if (more) { ra0 = la.fetch(kt + 2, tid); rb0 = lb.fetch(kt + 2, tid); }
      else      { ra0 = lan.fetch(0, tid);     rb0 = lbn.fetch(0, tid); }
      GEMM_COMPUTE(0);
      la.commit(As + ASZ, ra1, kt + 1, tid); lb.commit(Bs + BSZ, rb1, kt + 1, tid);
      __syncthreads();
      if (more) { ra1 = la.fetch(kt + 3, tid); rb1 = lb.fetch(kt + 3, tid); }
      else      { ra1 = lan.fetch(k1n, tid);   rb1 = lbn.fetch(k1n, tid); }
      GEMM_COMPUTE(1);
      if (more) { la.commit(As, ra0, kt + 2, tid); lb.commit(Bs, rb0, kt + 2, tid); }
      __syncthreads();
    }
  }
#undef GEMM_COMPUTE
  epi(acc, wm * WM * 32, wn * WN * 32, r, h);
  GemmPre<LA, LB> nx; nx.a0 = ra0; nx.a1 = ra1; nx.b0 = rb0; nx.b1 = rb1;
  return nx;
}
template <int WGM, int WM, int WN, bool SWAP, bool SWZB, class LA, class LB, class MKL, class SET, class EPI>
DI void gemm_loop(int first, int count, int step, const MKL& mkl, const SET& set, const EPI& epi, int nkt, char* lds) {
  if (first >= count) return;
  LA la; LB lb; mkl(first, la, lb);
  GemmPre<LA, LB> pre = gemm_prefetch(la, lb, nkt);
  for (int idx = first; idx < count; idx += step) {
    const int nx = (idx + step < count) ? idx + step : idx;
    LA lan; LB lbn; mkl(nx, lan, lbn);
    set(idx);
    pre = gemm_tile<WGM, WM, WN, SWAP, SWZB>(la, lb, epi, nkt, lds, pre, lan, lbn);
    la = lan; lb = lbn;
  }
}

template <class LA, class LB> struct GemmPre3 { typename LA::Regs a[3]; typename LB::Regs b[3]; };
template <int NKT, int WGM, int WM, int WN, bool SWAP, bool SWZB, class LA, class LB, class MKL, class SET, class EPI>
DI void gemm_loop3(int first, int count, int step, const MKL& mkl, const SET& set, const EPI& epi, char* lds) {
  static_assert(NKT >= 4, "needs at least 4 k-slabs");
  constexpr int WGN = 8 / WGM;
  constexpr int BM = WGM * WM * 32, BN = WGN * WN * 32;
  constexpr int ASZ = BM * PITCH, BSZ = BN * PITCH;
  if (first >= count) return;
  char* As = lds; char* Bs = lds + 2 * ASZ;
  LA la; LB lb; mkl(first, la, lb);
  typename LA::Regs ra0, ra1, ra2; typename LB::Regs rb0, rb1, rb2;
  { const int tid = ltid();
    ra0 = la.fetch(0, tid); rb0 = lb.fetch(0, tid); ra1 = la.fetch(1, tid); rb1 = lb.fetch(1, tid); ra2 = la.fetch(2, tid); rb2 = lb.fetch(2, tid); }
  for (int idx = first; idx < count; idx += step) {
    const int nx = (idx + step < count) ? idx + step : idx;
    LA lan; LB lbn; mkl(nx, lan, lbn);
    set(idx);
    const int tid = ltid(), w = tid >> 6, lane = tid & 63, r = lane & 31, h = lane >> 5;
    const int wm = w / WGN, wn = w % WGN;
    f32x16 acc[WM][WN];
#pragma unroll
    for (int i = 0; i < WM; ++i)
#pragma unroll
      for (int j = 0; j < WN; ++j)
#pragma unroll
        for (int e = 0; e < 16; ++e) acc[i][j][e] = 0.f;
    la.commit(As, ra0, 0, tid); lb.commit(Bs, rb0, 0, tid);
    __syncthreads();
    const int a_off = (wm * WM * 32 + r) * PITCH, b_off = (wn * WN * 32 + r) * PITCH;
#define G3_FETCH(RA, RB, kk) do { if ((kk) < NKT) { RA = la.fetch((kk), tid); RB = lb.fetch((kk), tid); } else { RA = lan.fetch((kk) - NKT, tid); RB = lbn.fetch((kk) - NKT, tid); } } while (0)
#define G3_TRIP(kt, RA, RB, RAn, RBn) do { \
      G3_FETCH(RA, RB, (kt) + 3); \
      gemm_compute<WM, WN, SWAP, SWZB>(acc, As + ((kt) & 1) * ASZ + a_off, Bs + ((kt) & 1) * BSZ + b_off, wn * WN * 32 + r, h); \
      if ((kt) + 1 < NKT) { la.commit(As + (((kt) + 1) & 1) * ASZ, RAn, (kt) + 1, tid); lb.commit(Bs + (((kt) + 1) & 1) * BSZ, RBn, (kt) + 1, tid); } \
      __syncthreads(); } while (0)
#pragma unroll
    for (int k3 = 0; k3 < NKT; k3 += 3) {
      G3_TRIP(k3, ra0, rb0, ra1, rb1);
      if (k3 + 1 < NKT) G3_TRIP(k3 + 1, ra1, rb1, ra2, rb2);
      if (k3 + 2 < NKT) G3_TRIP(k3 + 2, ra2, rb2, ra0, rb0);
    }
#undef G3_TRIP
#undef G3_FETCH
    epi(acc, wm * WM * 32, wn * WN * 32, r, h);
    if (NKT % 3 == 1) { typename LA::Regs ta = ra0; typename LB::Regs tb = rb0; ra0 = ra1; rb0 = rb1; ra1 = ra2; rb1 = rb2; ra2 = ta; rb2 = tb; }
    if (NKT % 3 == 2) { typename LA::Regs ta = ra2; typename LB::Regs tb = rb2; ra2 = ra1; rb2 = rb1; ra1 = ra0; rb1 = rb0; ra0 = ta; rb0 = tb; }
    la = lan; lb = lbn;
  }
}

DI void transpose_cvt_tile(const float* src, u16* dst, int K, int N, int kt, int nt, int remap, float* tile, const float* kgain = nullptr) {
  const int tid = ltid();
#pragma unroll
  for (int i = 0; i < 8; ++i) {
    const int kk = i * 8 + (tid >> 6), nn = tid & 63;
    const int n = nt * 64 + nn;
    tile[kk * 65 + nn] = (n < N) ? src[(long)(kt * 64 + kk) * N + n] * (kgain ? kgain[kt * 64 + kk] : 1.f) : 0.f;
  }
  __syncthreads();
  {
    const int nl = tid >> 3, kc = (tid & 7) * 8;
    const int n = nt * 64 + nl;
    if (n < N) {
      int dn = n;
      if (remap) { const int hh = n >> 7, dd = n & 127; dn = (dd < 64) ? (hh * 64 + dd) : (512 + hh * 64 + dd - 64); }
      uint4 o;
      o.x = pk2(tile[(kc + 0) * 65 + nl], tile[(kc + 1) * 65 + nl]);
      o.y = pk2(tile[(kc + 2) * 65 + nl], tile[(kc + 3) * 65 + nl]);
      o.z = pk2(tile[(kc + 4) * 65 + nl], tile[(kc + 5) * 65 + nl]);
      o.w = pk2(tile[(kc + 6) * 65 + nl], tile[(kc + 7) * 65 + nl]);
      *(uint4*)(dst + (long)dn * K + kt * 64 + kc) = o;
    }
  }
  __syncthreads();
}

template <int NQ> struct SgPre { uint4 g[NQ], u[NQ]; };
template <int ROWS, int CH, bool HAS_U>
DI SgPre<ROWS * CH / 64> staged_gate_fetch(int lane, const u16* __restrict__ gate, const u16* __restrict__ uptr, long ldg) {
  constexpr int NQ = ROWS * CH / 64;
  SgPre<NQ> q;
#pragma unroll
  for (int i = 0; i < NQ; ++i) {
    const int id = i * 64 + lane; const int row = id / CH, c = id % CH;
    q.g[i] = *(const uint4*)(gate + (long)row * ldg + c * 8);
    q.u[i] = HAS_U ? *(const uint4*)(uptr + (long)row * ldg + c * 8) : make_uint4(0, 0, 0, 0);
  }
  return q;
}
template <int ROWS, int CH, int SPB, bool HAS_U>
DI void staged_gate_finish(const char* st, int lane, const SgPre<ROWS * CH / 64>& pre, u16* __restrict__ out, long ldo) {
  constexpr int NQ = ROWS * CH / 64;
#pragma unroll
  for (int q = 0; q < NQ; ++q) {
    const int id = q * 64 + lane; const int row = id / CH, c = id % CH;
    const float4 a = *(const float4*)(st + row * SPB + c * 32), b = *(const float4*)(st + row * SPB + c * 32 + 16);
    float g[8]; unpack8(pre.g[q], g);
    float u[8];
    if (HAS_U) unpack8(pre.u[q], u); else {
#pragma unroll
      for (int e = 0; e < 8; ++e) u[e] = 1.f; }
    uint4 o;
    o.x = pk2(a.x * u[0] * silu(g[0]), a.y * u[1] * silu(g[1])); o.y = pk2(a.z * u[2] * silu(g[2]), a.w * u[3] * silu(g[3]));
    o.z = pk2(b.x * u[4] * silu(g[4]), b.y * u[5] * silu(g[5])); o.w = pk2(b.z * u[6] * silu(g[6]), b.w * u[7] * silu(g[7]));
    *(uint4*)(out + (long)row * ldo + c * 8) = o;
  }
}
template <int ROWS, int CH, int SPB, bool HAS_U>
DI void staged_gate_store(const char* st, int lane, const u16* __restrict__ gate, const u16* __restrict__ uptr, long ldg, u16* __restrict__ out, long ldo) {
  const SgPre<ROWS * CH / 64> pre = staged_gate_fetch<ROWS, CH, HAS_U>(lane, gate, uptr, ldg);
  staged_gate_finish<ROWS, CH, SPB, HAS_U>(st, lane, pre, out, ldo);
}

constexpr int AT_KP = 208, AT_KSZ = 64 * AT_KP, AT_VP = 144, AT_VSZ = 64 * AT_VP;
DI void attn_qk(f32x16& p0, f32x16& p1, const char* ks, const bf16x8 (&qf)[6], int r, int h, float negB) {
#pragma unroll
  for (int e = 0; e < 16; ++e) { p0[e] = negB; p1[e] = negB; }
#pragma unroll
  for (int s = 0; s < 6; ++s) {
    const bf16x8 k0 = *(const bf16x8*)(ks + r * AT_KP + (2 * s + h) * 16);
    const bf16x8 k1 = *(const bf16x8*)(ks + (32 + r) * AT_KP + (2 * s + h) * 16);
    p0 = mfma(k0, qf[s], p0); p1 = mfma(k1, qf[s], p1);
  }
}
DI void attn_pv(f32x16& o0, f32x16& o1, const f32x16& p0, const f32x16& p1, const char* vs, int r, int h) {
#pragma unroll
  for (int kb = 0; kb < 2; ++kb) {
#pragma unroll
    for (int sp = 0; sp < 2; ++sp) {
      uint4 pw;
      if (kb == 0) { pw.x = pk2(p0[8 * sp + 0], p0[8 * sp + 1]); pw.y = pk2(p0[8 * sp + 2], p0[8 * sp + 3]);
                     pw.z = pk2(p0[8 * sp + 4], p0[8 * sp + 5]); pw.w = pk2(p0[8 * sp + 6], p0[8 * sp + 7]); }
      else         { pw.x = pk2(p1[8 * sp + 0], p1[8 * sp + 1]); pw.y = pk2(p1[8 * sp + 2], p1[8 * sp + 3]);
                     pw.z = pk2(p1[8 * sp + 4], p1[8 * sp + 5]); pw.w = pk2(p1[8 * sp + 6], p1[8 * sp + 7]); }
      const bf16x8 pf = __builtin_bit_cast(bf16x8, pw);
      const int keyoff = 32 * kb + 16 * sp + 4 * h;
      {
        const char* vr = vs + r * AT_VP + ((keyoff * 2) ^ ((r & 16) >> 1));
        const uint2 lo = *(const uint2*)vr, hi = *(const uint2*)(vr + 16);
        uint4 a4 = make_uint4(lo.x, lo.y, hi.x, hi.y);
        o0 = mfma(__builtin_bit_cast(bf16x8, a4), pf, o0);
      }
      {
        const char* vr = vs + (32 + r) * AT_VP + ((keyoff * 2) ^ ((r & 16) >> 1));
        const uint2 lo = *(const uint2*)vr, hi = *(const uint2*)(vr + 16);
        uint4 a4 = make_uint4(lo.x, lo.y, hi.x, hi.y);
        o1 = mfma(__builtin_bit_cast(bf16x8, a4), pf, o1);
      }
    }
  }
}
DI void attn_item(const u16* __restrict__ Qp, const u16* __restrict__ Kp, const u16* __restrict__ VTp, int q0, int nkeys,
                  const u16* __restrict__ gatep, u16* __restrict__ mixp, float negB, char* lds) {
  const int tid = ltid(), w = tid >> 6, lane = tid & 63, r = lane & 31, h = lane >> 5;
  char* Kb0 = lds; char* Vb0 = lds + 2 * AT_KSZ;
  bf16x8 qf[6];
  {
    const u16* qrow = Qp + (long)(q0 + w * 32 + r) * 96 + h * 8;
#pragma unroll
    for (int s = 0; s < 6; ++s) qf[s] = *(const bf16x8*)(qrow + s * 16);
  }
  f32x16 o0, o1;
#pragma unroll
  for (int e = 0; e < 16; ++e) { o0[e] = 0.f; o1[e] = 0.f; }
  float lsum = 0.f;
  const int NT = nkeys >> 6;
  uint4 rkA0, rkA1, rvA, rkB0, rkB1, rvB;
  rkA1 = make_uint4(0, 0, 0, 0); rkB1 = make_uint4(0, 0, 0, 0);
  const int krow0 = tid / 12, kc0 = tid % 12, krow1 = (tid + 512) / 12, kc1 = (tid + 512) % 12;
  const int vrow = tid >> 3, vc = tid & 7;
  const bool klo = tid < 256;
#define AT_FETCH_K(S, t) do { const u16* kt_ = Kp + (long)(t) * 64 * 96; rk##S##0 = *(const uint4*)(kt_ + tid * 8); \
    if (klo) rk##S##1 = *(const uint4*)(kt_ + (tid + 512) * 8); } while (0)
#define AT_FETCH_V(S, t) do { rv##S = *(const uint4*)(VTp + (long)vrow * KPOS + (t) * 64 + vc * 8); } while (0)
#define AT_COMMIT_K(S, buf) do { char* ks_ = Kb0 + (buf) * AT_KSZ; *(uint4*)(ks_ + krow0 * AT_KP + kc0 * 16) = rk##S##0; \
    if (klo) *(uint4*)(ks_ + krow1 * AT_KP + kc1 * 16) = rk##S##1; } while (0)
#define AT_COMMIT_V(S, buf) do { *(uint4*)(Vb0 + (buf) * AT_VSZ + vrow * AT_VP + vc * 16) = (vrow & 16) ? make_uint4(rv##S.z, rv##S.w, rv##S.x, rv##S.y) : rv##S; } while (0)
#define AT_TRIP(t, FS, CS) do { \
    { const int tk_ = ((t) + 3 < NT) ? (t) + 3 : NT - 1, tv_ = ((t) + 2 < NT) ? (t) + 2 : NT - 1; AT_FETCH_K(FS, tk_); AT_FETCH_V(FS, tv_); } \
    f32x16 n0, n1; \
    attn_qk(n0, n1, Kb0 + (((t) + 1) & 1) * AT_KSZ, qf, r, h, negB); \
    const char* vs = Vb0 + ((t) & 1) * AT_VSZ; \
    float rs = 0.f; \
    _Pragma("unroll") for (int e = 0; e < 16; ++e) { p0[e] = __builtin_amdgcn_exp2f(p0[e]); rs += p0[e]; } \
    _Pragma("unroll") for (int e = 0; e < 16; ++e) { p1[e] = __builtin_amdgcn_exp2f(p1[e]); rs += p1[e]; } \
    lsum += rs; \
    attn_pv(o0, o1, p0, p1, vs, r, h); \
    AT_COMMIT_K(CS, (t) & 1); AT_COMMIT_V(CS, ((t) + 1) & 1); \
    __syncthreads(); \
    p0 = n0; p1 = n1; } while (0)
  AT_FETCH_K(A, 0); AT_FETCH_V(A, 0); AT_FETCH_K(B, 1);
  AT_COMMIT_K(A, 0); AT_COMMIT_V(A, 0); AT_COMMIT_K(B, 1);
  AT_FETCH_K(B, 2); AT_FETCH_V(B, 1);
  __syncthreads();
  f32x16 p0, p1;
  attn_qk(p0, p1, Kb0, qf, r, h, negB);
  for (int t = 0; t < NT; t += 2) {
    AT_TRIP(t, A, B);
    AT_TRIP(t + 1, B, A);
  }
#undef AT_TRIP
#undef AT_FETCH_K
#undef AT_FETCH_V
#undef AT_COMMIT_K
#undef AT_COMMIT_V
  lsum += __shfl_xor(lsum, 32);
  const float inv = 1.f / lsum;
  char* stg = lds + w * (32 * 272);
#pragma unroll
  for (int db = 0; db < 2; ++db)
#pragma unroll
    for (int g4 = 0; g4 < 4; ++g4) {
      const int dv = db * 32 + 8 * g4 + 4 * h;
      float4 v;
      if (db == 0) v = make_float4(o0[4 * g4] * inv, o0[4 * g4 + 1] * inv, o0[4 * g4 + 2] * inv, o0[4 * g4 + 3] * inv);
      else         v = make_float4(o1[4 * g4] * inv, o1[4 * g4 + 1] * inv, o1[4 * g4 + 2] * inv, o1[4 * g4 + 3] * inv);
      *(float4*)(stg + r * 272 + dv * 4) = v;
    }
  __syncthreads();
  staged_gate_store<32, 8, 272, false>(stg, lane, gatep + (long)(w * 32) * NP, nullptr, NP, mixp + (long)(w * 32) * 1024, 1024);
  __syncthreads();
}

DI void attn_item64(const u16* __restrict__ Qp, const u16* __restrict__ Kp, const u16* __restrict__ VTp, int q0, int nkeys,
                    const u16* __restrict__ gatep, u16* __restrict__ mixp, char* lds) {
  const int tid = ltid(), w = tid >> 6, lane = tid & 63, r = lane & 31, h = lane >> 5;
  char* Kb0 = lds; char* Vb0 = lds + 2 * AT_KSZ;
  char* qbl = lds + 2 * AT_KSZ + 2 * AT_VSZ + w * (32 * AT_KP) + r * AT_KP + h * 16;
  bf16x8 qa[6];
  {
    const u16* qrow = Qp + (long)(q0 + w * 64 + r) * 96 + h * 8;
#pragma unroll
    for (int s = 0; s < 6; ++s) { qa[s] = *(const bf16x8*)(qrow + s * 16); *(bf16x8*)(qbl + s * 32) = *(const bf16x8*)(qrow + 32 * 96 + s * 16); }
  }
  f32x16 oa0, oa1, ob0, ob1;
#pragma unroll
  for (int e = 0; e < 16; ++e) { oa0[e] = 0.f; oa1[e] = 0.f; ob0[e] = 0.f; ob1[e] = 0.f; }
  float lsa = 0.f, lsb = 0.f;
  const int NT = nkeys >> 6;
  uint2 rkA0, rkA1, rkA2, rkB0, rkB1, rkB2; uint4 rvA, rvB;
  const int kso = (tid >> 3) * AT_KP + (tid & 7) * 24;
  const int vrow = tid >> 3, vc = tid & 7;
#define AT_FETCH_K(S, t) do { const uint2* kt_ = (const uint2*)(Kp + (long)(t) * 64 * 96) + tid * 3; rk##S##0 = kt_[0]; rk##S##1 = kt_[1]; rk##S##2 = kt_[2]; } while (0)
#define AT_FETCH_V(S, t) do { rv##S = *(const uint4*)(VTp + (long)vrow * KPOS + (t) * 64 + vc * 8); } while (0)
#define AT_COMMIT_K(S, buf) do { char* ks_ = Kb0 + (buf) * AT_KSZ + kso; *(uint2*)ks_ = rk##S##0; *(uint2*)(ks_ + 8) = rk##S##1; *(uint2*)(ks_ + 16) = rk##S##2; } while (0)
#define AT_COMMIT_V(S, buf) do { *(uint4*)(Vb0 + (buf) * AT_VSZ + vrow * AT_VP + vc * 16) = (vrow & 16) ? make_uint4(rv##S.z, rv##S.w, rv##S.x, rv##S.y) : rv##S; } while (0)
#define AT_QK_HALF(sa, sb, ks, kb) do { \
    _Pragma("unroll") for (int e = 0; e < 16; ++e) { sa[e] = 0.f; sb[e] = 0.f; } \
    _Pragma("unroll") for (int s_ = 0; s_ < 6; ++s_) { \
      const bf16x8 kf_ = *(const bf16x8*)((ks) + ((kb) * 32 + r) * AT_KP + (2 * s_ + h) * 16); \
      const bf16x8 qf_ = *(const bf16x8*)(qbl + s_ * 32); \
      sa = mfma(kf_, qa[s_], sa); sb = mfma(kf_, qf_, sb); } } while (0)
#define AT_EXP(sx, ls) do { float rs_ = 0.f; \
    _Pragma("unroll") for (int e = 0; e < 16; ++e) { sx[e] = __builtin_amdgcn_exp2f(sx[e]); rs_ += sx[e]; } ls += rs_; } while (0)
#define AT_PV_HALF(pa, pb, vs, kb) do { \
    _Pragma("unroll") for (int sp_ = 0; sp_ < 2; ++sp_) { \
      uint4 wa_, wb_; \
      wa_.x = pk2(pa[8 * sp_ + 0], pa[8 * sp_ + 1]); wa_.y = pk2(pa[8 * sp_ + 2], pa[8 * sp_ + 3]); \
      wa_.z = pk2(pa[8 * sp_ + 4], pa[8 * sp_ + 5]); wa_.w = pk2(pa[8 * sp_ + 6], pa[8 * sp_ + 7]); \
      wb_.x = pk2(pb[8 * sp_ + 0], pb[8 * sp_ + 1]); wb_.y = pk2(pb[8 * sp_ + 2], pb[8 * sp_ + 3]); \
      wb_.z = pk2(pb[8 * sp_ + 4], pb[8 * sp_ + 5]); wb_.w = pk2(pb[8 * sp_ + 6], pb[8 * sp_ + 7]); \
      const bf16x8 fa_ = __builtin_bit_cast(bf16x8, wa_), fb_ = __builtin_bit_cast(bf16x8, wb_); \
      const int keyoff_ = 32 * (kb) + 16 * sp_ + 4 * h; \
      { const char* vr_ = (vs) + r * AT_VP + ((keyoff_ * 2) ^ ((r & 16) >> 1)); \
        const uint2 lo_ = *(const uint2*)vr_, hi_ = *(const uint2*)(vr_ + 16); \
        const bf16x8 vf_ = __builtin_bit_cast(bf16x8, make_uint4(lo_.x, lo_.y, hi_.x, hi_.y)); \
        oa0 = mfma(vf_, fa_, oa0); ob0 = mfma(vf_, fb_, ob0); } \
      { const char* vr_ = (vs) + (32 + r) * AT_VP + ((keyoff_ * 2) ^ ((r & 16) >> 1)); \
        const uint2 lo_ = *(const uint2*)vr_, hi_ = *(const uint2*)(vr_ + 16); \
        const bf16x8 vf_ = __builtin_bit_cast(bf16x8, make_uint4(lo_.x, lo_.y, hi_.x, hi_.y)); \
        oa1 = mfma(vf_, fa_, oa1); ob1 = mfma(vf_, fb_, ob1); } } } while (0)
#define AT_TRIP64(t, FS, CS) do { \
    { const int tn_ = ((t) + 2 < NT) ? (t) + 2 : NT - 1; AT_FETCH_K(FS, tn_); AT_FETCH_V(FS, tn_); } \
    const char* ks = Kb0 + ((t) & 1) * AT_KSZ; const char* vs = Vb0 + ((t) & 1) * AT_VSZ; \
    { f32x16 sa0, sb0; \
      AT_QK_HALF(sa0, sb0, ks, 0); \
      AT_EXP(sa0, lsa); AT_EXP(sb0, lsb); \
      AT_PV_HALF(sa0, sb0, vs, 0); } \
    __builtin_amdgcn_sched_barrier(0); \
    { f32x16 sa1, sb1; \
      AT_QK_HALF(sa1, sb1, ks, 1); \
      AT_EXP(sa1, lsa); AT_EXP(sb1, lsb); \
      AT_PV_HALF(sa1, sb1, vs, 1); } \
    __builtin_amdgcn_sched_barrier(0); \
    AT_COMMIT_K(CS, ((t) + 1) & 1); AT_COMMIT_V(CS, ((t) + 1) & 1); \
    __syncthreads(); } while (0)
  AT_FETCH_K(A, 0); AT_FETCH_V(A, 0);
  AT_COMMIT_K(A, 0); AT_COMMIT_V(A, 0);
  AT_FETCH_K(B, 1); AT_FETCH_V(B, 1);
  __syncthreads();
  for (int t = 0; t < NT; t += 2) {
    AT_TRIP64(t, A, B);
    AT_TRIP64(t + 1, B, A);
  }
#undef AT_TRIP64
#undef AT_PV_HALF
#undef AT_EXP
#undef AT_QK_HALF
#undef AT_FETCH_K
#undef AT_FETCH_V
#undef AT_COMMIT_K
#undef AT_COMMIT_V
  lsa += __shfl_xor(lsa, 32); lsb += __shfl_xor(lsb, 32);
  const float ia = 1.f / lsa, ib = 1.f / lsb;
  char* stg = lds + w * (32 * 272);
#pragma unroll
  for (int blk = 0; blk < 2; ++blk) {
#pragma unroll
    for (int db = 0; db < 2; ++db)
#pragma unroll
      for (int g4 = 0; g4 < 4; ++g4) {
        const int dv = db * 32 + 8 * g4 + 4 * h;
        float4 v;
        if (blk == 0) { if (db == 0) v = make_float4(oa0[4 * g4] * ia, oa0[4 * g4 + 1] * ia, oa0[4 * g4 + 2] * ia, oa0[4 * g4 + 3] * ia);
                        else         v = make_float4(oa1[4 * g4] * ia, oa1[4 * g4 + 1] * ia, oa1[4 * g4 + 2] * ia, oa1[4 * g4 + 3] * ia); }
        else          { if (db == 0) v = make_float4(ob0[4 * g4] * ib, ob0[4 * g4 + 1] * ib, ob0[4 * g4 + 2] * ib, ob0[4 * g4 + 3] * ib);
                        else         v = make_float4(ob1[4 * g4] * ib, ob1[4 * g4 + 1] * ib, ob1[4 * g4 + 2] * ib, ob1[4 * g4 + 3] * ib); }
        *(float4*)(stg + r * 272 + dv * 4) = v;
      }
    const SgPre<4> gpre = staged_gate_fetch<32, 8, false>(lane, gatep + (long)(w * 64 + blk * 32) * NP, nullptr, NP);
    __syncthreads();
    staged_gate_finish<32, 8, 272, false>(stg, lane, gpre, mixp + (long)(w * 64 + blk * 32) * 1024, 1024);
    __syncthreads();
  }
}


__global__ void __launch_bounds__(NT_) fwd_megakernel(Params p) {
  extern __shared__ __attribute__((aligned(16))) char lds[];
  cg::grid_group grid = cg::this_grid();
  const int tid = threadIdx.x, bid = blockIdx.x, nblk = gridDim.x;
  __shared__ uint4 xb_words;
  if (tid == 0) xb_words = make_uint4(0u, 0u, 0u, 0u);
  __syncthreads();
  const XcdBarrier xb = xcd_barrier_post(p.bar, (volatile LAS unsigned*)&xb_words);
  const long gtid = (long)bid * NT_ + tid, gnth = (long)nblk * NT_;

  {
    float* tile = (float*)lds;
    constexpr int T_WIN = 16 * 35, T_WOUT = 16 * 16, T_WUQ = 4 * 12, T_WUKV = 2 * 16;
    constexpr int T_L = T_WIN + T_WOUT + T_WUQ + T_WUKV;
    struct TP { const float* src; u16* dst; const float* kg; int K, N, kt, nt, remap; };
    auto tparams = [&](int it) {
      TP q; const int l = it / T_L; int t = it % T_L;
      if (t < T_WIN) { q.src = p.w_in + (long)l * 1024 * INW; q.dst = p.win_t + (long)l * NP * 1024; q.K = 1024; q.N = INW; q.kt = t / 35; q.nt = t % 35; q.remap = 0; q.kg = nullptr; }
      else if ((t -= T_WIN) < T_WOUT) { q.src = p.w_out + (long)l * 1024 * 1024; q.dst = p.wout_t + (long)l * 1024 * 1024; q.K = 1024; q.N = 1024; q.kt = t / 16; q.nt = t % 16; q.remap = 0; q.kg = nullptr; }
      else if ((t -= T_WOUT) < T_WUQ) { q.src = p.w_uq + (long)l * 256 * 768; q.dst = p.wuq_t + (long)l * 768 * 256; q.K = 256; q.N = 768; q.kt = t / 12; q.nt = t % 12; q.remap = 0; q.kg = p.q_a_g + l * 256; }
      else { t -= T_WUQ; q.src = p.w_ukv + (long)l * 128 * 1024; q.dst = p.wukv_t + (long)l * 1024 * 128; q.K = 128; q.N = 1024; q.kt = t / 16; q.nt = t % 16; q.remap = 1; q.kg = p.kv_a_g + l * 128; }
      return q;
    };
    float pv[8];
    auto tload = [&](const TP& q) {
#pragma unroll
      for (int i = 0; i < 8; ++i) {
        const int kk = i * 8 + (tid >> 6), nn = tid & 63;
        const int n = q.nt * 64 + nn;
        pv[i] = (n < q.N) ? q.src[(long)(q.kt * 64 + kk) * q.N + n] * (q.kg ? q.kg[q.kt * 64 + kk] : 1.f) : 0.f;
      }
    };
    if (bid < T_L * DEPTH) { const TP q0 = tparams(bid); tload(q0); }
    for (int it = bid; it < T_L * DEPTH; it += nblk) {
      const TP q = tparams(it);
#pragma unroll
      for (int i = 0; i < 8; ++i) tile[(i * 8 + (tid >> 6)) * 65 + (tid & 63)] = pv[i];
      __syncthreads();
      if (it + nblk < T_L * DEPTH) { const TP qn = tparams(it + nblk); tload(qn); }
      {
        const int nl = tid >> 3, kc = (tid & 7) * 8;
        const int n = q.nt * 64 + nl;
        if (n < q.N) {
          int dn = n;
          if (q.remap) { const int hh = n >> 7, dd = n & 127; dn = (dd < 64) ? (hh * 64 + dd) : (512 + hh * 64 + dd - 64); }
          uint4 o;
          o.x = pk2(tile[(kc + 0) * 65 + nl], tile[(kc + 1) * 65 + nl]);
          o.y = pk2(tile[(kc + 2) * 65 + nl], tile[(kc + 3) * 65 + nl]);
          o.z = pk2(tile[(kc + 4) * 65 + nl], tile[(kc + 5) * 65 + nl]);
          o.w = pk2(tile[(kc + 6) * 65 + nl], tile[(kc + 7) * 65 + nl]);
          *(uint4*)(q.dst + (long)dn * q.K + q.kt * 64 + kc) = o;
        }
      }
      __syncthreads();
    }
    for (long i = gtid; i < (long)DEPTH * (NP - INW) * 1024; i += gnth) {
      const int l = (int)(i / ((NP - INW) * 1024)); const long rem = i % ((NP - INW) * 1024);
      p.win_t[((long)l * NP + INW) * 1024 + rem] = 0;
    }
    for (long i = gtid; i < (long)DEPTH * 4 * 128 * 128; i += gnth) p.gws_b[i] = f2bf(p.g_ws[i]);
    for (long i = gtid; i < 128 * 64; i += gnth) {
      const int rho = (int)(i >> 6), n1 = (int)(i & 63);
      const int blk = rho >> 5, k1 = (blk >> 1) * 32 + (rho & 31), part = blk & 1;
      const int mm = (k1 * n1) & 63;
      p.t1[i] = f2bf(part == 0 ? cospif(mm * (1.f / 32.f)) : -sinpif(mm * (1.f / 32.f)));
    }
    for (long i = gtid; i < 128 * 128; i += gnth) {
      const int rho = (int)(i >> 7), kk = (int)(i & 127);
      const int rio = rho >> 6, k2 = rho & 63, n2 = kk >> 1, rii = kk & 1;
      const int mm = (n2 * k2) & 63;
      const float c = cospif(mm * (1.f / 32.f)), s = sinpif(mm * (1.f / 32.f));
      p.t2[i] = f2bf(rio == 0 ? (rii == 0 ? c : s) : (rii == 0 ? -s : c));
    }
    for (long i = gtid; i < 512 * 256; i += gnth) {
      const int rho = (int)(i >> 8), n = (int)(i & 255);
      const int ri = rho >> 8, k = rho & 255;
      const int mm = (k * n) & 255;
      p.t256[i] = f2bf(ri == 0 ? cospif(mm * (1.f / 128.f)) : -sinpif(mm * (1.f / 128.f)));
    }
    for (long i = gtid; i < 4096; i += gnth) {
      p.tw[2 * i] = cospif((float)i * (1.f / 2048.f)); p.tw[2 * i + 1] = sinpif((float)i * (1.f / 2048.f));
    }
    for (long i = gtid; i < 64 * 8; i += gnth) {
      const int pos = (int)(i >> 3), jj = (int)(i & 7);
      const float ang = (float)pos * exp2f(-(float)jj * 1.6609640474436813f);
      p.rope[2 * i] = __cosf(ang); p.rope[2 * i + 1] = __sinf(ang);
    }
    for (long i = gtid; i < (long)DEPTH * 256 * 512; i += gnth) {
      const int n = (int)(i & 255), kidx = (int)((i >> 8) & 511), l = (int)(i >> 17);
      const int g = kidx >> 7, j = kidx & 127, jj = j & 63;
      const float* wf = p.w_fmix + (long)l * 256 * 256 + (long)(g * 64) * 256 + n;
      float acc = 0.f;
      for (int c0 = 0; c0 < 64; c0 += 16) {
        float wv[16];
#pragma unroll
        for (int u = 0; u < 16; ++u) wv[u] = wf[(long)(c0 + u) * 256];
#pragma unroll
        for (int u = 0; u < 16; ++u) {
          const int mm = (jj * (c0 + u)) & 63;
          const float coef = (j < 64) ? cospif(mm * (1.f / 32.f)) : sinpif(mm * (1.f / 32.f));
          acc += coef * wv[u];
        }
      }
      p.mf_t[((long)l * 256 + n) * 512 + kidx] = f2bf(acc);
    }
    {
      float* sl = (float*)lds;
      float* red = sl + 9 * 1024;
      __syncthreads();
      for (int i = tid; i < 9 * 1024; i += NT_) {
        const int rr = i >> 10, kk = i & 1023;
        const float v = (rr < 8) ? p.c[rr * 1024 + kk] : p.c_ctx[kk];
        sl[i] = silu(v);
      }
      __syncthreads();
      for (int it = bid; it < DEPTH * 96; it += nblk) {
        const int l = it / 96, cgp = it % 96;
        const int cj = tid & 31, ksl = tid >> 5;
        const float* wm = p.w_mod + (long)l * 1024 * 3072 + cgp * 32 + cj;
        float a[9];
#pragma unroll
        for (int rr = 0; rr < 9; ++rr) a[rr] = 0.f;
        for (int k0 = ksl * 64; k0 < ksl * 64 + 64; k0 += 16) {
          float wv[16];
#pragma unroll
          for (int u = 0; u < 16; ++u) wv[u] = wm[(long)(k0 + u) * 3072];
#pragma unroll
          for (int u = 0; u < 16; ++u)
#pragma unroll
            for (int rr = 0; rr < 9; ++rr) a[rr] += sl[rr * 1024 + k0 + u] * wv[u];
        }
#pragma unroll
        for (int rr = 0; rr < 9; ++rr) red[(ksl * 9 + rr) * 32 + cj] = a[rr];
        __syncthreads();
        if (tid < 288) {
          const int rr = tid >> 5, c2 = tid & 31;
          float s = 0.f;
          for (int q = 0; q < 16; ++q) s += red[(q * 9 + rr) * 32 + c2];
          const int col = cgp * 32 + c2;
          p.mod[((long)l * 9 + rr) * 3072 + col] = s + p.b_mod[l * 3072 + col];
        }
        __syncthreads();
      }
    }
  }
  grid.sync();

  for (int l = 0; l < DEPTH; ++l) {
    const int tid = ltid();
    const float* modl = p.mod + (long)l * 9 * 3072;
    {
      const float* ng = p.norm_g + l * 1024;
      const int lane = tid & 63, wv = tid >> 6;
      float4 g4[4];
#pragma unroll
      for (int i = 0; i < 4; ++i) g4[i] = *(const float4*)(ng + i * 256 + lane * 4);
      const int rstep = nblk * 8;
      float4 v[4], sh[4], sc[4];
#define N_LOAD(row_, vv, shh, scc) do { \
        const int rw_ = (row_) < MT ? (row_) : MT - 1; \
        const float* src_; int mr_; \
        if (rw_ < MX) { src_ = (l == 0 ? p.x : p.out) + (long)rw_ * 1024; mr_ = rw_ >> 12; } \
        else { src_ = (l == 0 ? p.ctx : p.yw) + (long)(rw_ - MX) * 1024; mr_ = 8; } \
        const float* md_ = modl + mr_ * 3072; \
        _Pragma("unroll") for (int i = 0; i < 4; ++i) { const int k0_ = i * 256 + lane * 4; \
          vv[i] = *(const float4*)(src_ + k0_); shh[i] = *(const float4*)(md_ + k0_); scc[i] = *(const float4*)(md_ + 1024 + k0_); } } while (0)
      int row = bid * 8 + wv;
      N_LOAD(row, v, sh, sc);
      for (; row < MT; row += rstep) {
        float4 vn[4], shn[4], scn[4];
        N_LOAD(row + rstep, vn, shn, scn);
        float ss = 0.f;
#pragma unroll
        for (int i = 0; i < 4; ++i) ss += v[i].x * v[i].x + v[i].y * v[i].y + v[i].z * v[i].z + v[i].w * v[i].w;
#pragma unroll
        for (int o = 1; o < 64; o <<= 1) ss += __shfl_xor(ss, o);
        const float rs = rsqrtf(ss * (1.f / 1024.f) + EPS);
#pragma unroll
        for (int i = 0; i < 4; ++i) {
          const int k0 = i * 256 + lane * 4;
          uint2 o;
          o.x = pk2(v[i].x * rs * g4[i].x * (1.f + sc[i].x) + sh[i].x, v[i].y * rs * g4[i].y * (1.f + sc[i].y) + sh[i].y);
          o.y = pk2(v[i].z * rs * g4[i].z * (1.f + sc[i].z) + sh[i].z, v[i].w * rs * g4[i].w * (1.f + sc[i].w) + sh[i].w);
          *(uint2*)(p.hmix + (long)row * 1024 + k0) = o;
        }
#pragma unroll
        for (int i = 0; i < 4; ++i) { v[i] = vn[i]; sh[i] = shn[i]; sc[i] = scn[i]; }
      }
#undef N_LOAD
    }
    xcd_barrier(xb);

    {
      const u16* wt = p.win_t + (long)l * NP * 1024;
      u16* P = p.p;
      int m0 = 0, n0 = 0;
      auto epi = [&](auto& acc, int mw, int nw, int r, int h) {
        constexpr int WM_ = sizeof(acc) / sizeof(acc[0]), WN_ = sizeof(acc[0]) / sizeof(acc[0][0]);
        constexpr int SP = WN_ * 64 + 16;
        constexpr int CH = WN_ * 4;
        const int wv = ltid() >> 6, lane = h * 32 + r;
        char* st = lds + wv * (WM_ * 32 * SP);
        if (n0 + nw >= C_CQ && n0 + nw < C_KROPE) {
#pragma unroll
          for (int i = 0; i < WM_; ++i)
#pragma unroll
            for (int j = 0; j < WN_; ++j) {
              float ss = 0.f;
#pragma unroll
              for (int e = 0; e < 16; ++e) ss += acc[i][j][e] * acc[i][j][e];
              ss += __shfl_xor(ss, 32);
              if (h == 0) p.stats[(long)(m0 + mw + i * 32 + r) * 16 + ((n0 + nw + j * 32 - C_CQ) >> 5)] = ss;
            }
        }
#pragma unroll
        for (int i = 0; i < WM_; ++i)
#pragma unroll
          for (int j = 0; j < WN_; ++j)
#pragma unroll
            for (int g4 = 0; g4 < 4; ++g4) {
              uint2 o;
              o.x = pk2(acc[i][j][4 * g4], acc[i][j][4 * g4 + 1]); o.y = pk2(acc[i][j][4 * g4 + 2], acc[i][j][4 * g4 + 3]);
              *(uint2*)(st + (i * 32 + r) * SP + (j * 32 + 8 * g4 + 4 * h) * 2) = o;
            }
        __syncthreads();
#pragma unroll
        for (int q = 0; q < WM_ * 32 * CH / 64; ++q) {
          const int id = q * 64 + lane; const int row = id / CH, c = id % CH;
          const uint4 v = *(const uint4*)(st + row * SP + c * 16);
          *(uint4*)(P + (long)(m0 + mw + row) * NP + n0 + nw + c * 8) = v;
        }
        __syncthreads();
      };
      {
        auto mkl = [&](int j, LdDirect<256>& la, LdDirect<128>& lb) {
          const int mt = (j / 18) * 8 + (bid & 7), nt = j % 18;
          la.base = p.hmix + (long)mt * 256 * 1024; la.ld = 1024; lb.base = wt + (long)nt * 128 * 1024; lb.ld = 1024; };
        auto set = [&](int j) { m0 = ((j / 18) * 8 + (bid & 7)) * 256; n0 = (j % 18) * 128; };
        gemm_loop3<16, 4, 2, 2, true, false, LdDirect<256>, LdDirect<128>>(bid >> 3, 16 * 18, nblk >> 3, mkl, set, epi, lds);
      }
      {
        const int nty = (l == DEPTH - 1) ? 3 : 36, nt0 = (l == DEPTH - 1) ? 24 : 0;
        auto mkl = [&](int it, LdDirect<128>& la, LdDirect<64>& lb) {
          const int mt = it / nty, nt = nt0 + it % nty;
          la.base = p.hmix + (long)(MX + mt * 128) * 1024; la.ld = 1024; lb.base = wt + (long)nt * 64 * 1024; lb.ld = 1024; };
        auto set = [&](int it) { m0 = MX + (it / nty) * 128; n0 = (nt0 + it % nty) * 64; };
        gemm_loop<4, 1, 1, true, false, LdDirect<128>, LdDirect<64>>(bid, 16 * nty, nblk, mkl, set, epi, 16, lds);
      }
    }
    xcd_barrier(xb);

    {
      constexpr int nKN = 136 * 4, nV = 136 * 4, nF1 = 1024;
      const int nQ = (l == DEPTH - 1) ? 256 * 4 : 272 * 4, nFy = (l == DEPTH - 1) ? 0 : 64, nG = (l == DEPTH - 1) ? 256 : 272;
      float* rstd_s = (float*)(lds + RSTD_OFF);
#define FIRST(off) ((bid + nblk - ((off) % nblk)) % nblk)
      {
        int m0 = 0, n0 = 0;
        auto mkl = [&](int it, LdDirect<128>& la, LdDirect<192>& lb) {
          const int mt = it >> 2, nt = it & 3;
          la.base = p.p + (long)mt * 128 * NP + C_CQ; la.ld = NP;
          lb.base = p.wuq_t + ((long)l * 768 + nt * 192) * 256; lb.ld = 256; };
        auto set = [&](int it) { m0 = (it >> 2) * 128; n0 = (it & 3) * 192; };
        const float* qg = p.q_norm_g + l * 96;
        u16* Qb = p.q; const float* ROPE = p.rope;
        auto epi = [&](f32x16 (&acc)[1][3], int mw, int nw, int r, int h) {
          const int head = (n0 + nw) / 96;
          const float QS = 0.10206207261596575f * 1.4426950408889634f;
          const int m = m0 + mw + r;
          float ss = 0.f;
#pragma unroll
          for (int j = 0; j < 3; ++j)
#pragma unroll
            for (int e = 0; e < 16; ++e) ss += acc[0][j][e] * acc[0][j][e];
          ss += __shfl_xor(ss, 32);
          const float4 sa = *(const float4*)(p.stats + (long)m * 16), sb = *(const float4*)(p.stats + (long)m * 16 + 4);
          const float msq = (sa.x + sa.y + sa.z + sa.w + sb.x + sb.y + sb.z + sb.w) * (1.f / 256.f) + EPS;
          const float rs = rsqrtf(ss * (1.f / 96.f) + EPS * msq);
          int b, pos; bool isx; int irow = 0, icol = 0;
          if (m < MX) { b = m >> 12; const int n = m & 4095; pos = CTX + n; isx = true; irow = n >> 6; icol = n & 63; }
          else { const int my = m - MX; b = my >> 8; pos = my & 255; isx = false; }
          float2 tr[4], tc[4];
#pragma unroll
          for (int e = 0; e < 4; ++e) { tr[e] = *(const float2*)(ROPE + (irow * 8 + 4 * h + e) * 2); tc[e] = *(const float2*)(ROPE + (icol * 8 + 4 * h + e) * 2); }
          const int wv = ltid() >> 6;
          char* stg = lds + wv * (32 * 208);
          u16* qd = (u16*)(stg + r * 208);
#pragma unroll
          for (int j = 0; j < 2; ++j)
#pragma unroll
            for (int g4 = 0; g4 < 4; ++g4) {
              const int f0 = j * 32 + 8 * g4 + 4 * h;
              const float4 g = *(const float4*)(qg + f0);
              uint2 o;
              o.x = pk2(acc[0][j][4 * g4] * rs * g.x * QS, acc[0][j][4 * g4 + 1] * rs * g.y * QS);
              o.y = pk2(acc[0][j][4 * g4 + 2] * rs * g.z * QS, acc[0][j][4 * g4 + 3] * rs * g.w * QS);
              *(uint2*)(qd + f0) = o;
            }
          float x1[4], x2[4], x3[4], x4[4];
          {
            const float4 g1 = *(const float4*)(qg + 64 + 4 * h), g2 = *(const float4*)(qg + 72 + 4 * h);
            const float4 g3 = *(const float4*)(qg + 80 + 4 * h), g4v = *(const float4*)(qg + 88 + 4 * h);
            const float s = rs * QS;
            x1[0] = acc[0][2][0] * s * g1.x; x1[1] = acc[0][2][1] * s * g1.y; x1[2] = acc[0][2][2] * s * g1.z; x1[3] = acc[0][2][3] * s * g1.w;
            x2[0] = acc[0][2][4] * s * g2.x; x2[1] = acc[0][2][5] * s * g2.y; x2[2] = acc[0][2][6] * s * g2.z; x2[3] = acc[0][2][7] * s * g2.w;
            x3[0] = acc[0][2][8] * s * g3.x; x3[1] = acc[0][2][9] * s * g3.y; x3[2] = acc[0][2][10] * s * g3.z; x3[3] = acc[0][2][11] * s * g3.w;
            x4[0] = acc[0][2][12] * s * g4v.x; x4[1] = acc[0][2][13] * s * g4v.y; x4[2] = acc[0][2][14] * s * g4v.z; x4[3] = acc[0][2][15] * s * g4v.w;
          }
          if (isx) {
#pragma unroll
            for (int e = 0; e < 4; ++e) {
              const float cr = tr[e].x, sr = tr[e].y, cc = tc[e].x, sc = tc[e].y;
              const float a1 = x1[e] * cr - x2[e] * sr, a2 = x2[e] * cr + x1[e] * sr;
              const float a3 = x3[e] * cc - x4[e] * sc, a4 = x4[e] * cc + x3[e] * sc;
              x1[e] = a1; x2[e] = a2; x3[e] = a3; x4[e] = a4;
            }
          }
          uint2 o;
          o.x = pk2(x1[0], x1[1]); o.y = pk2(x1[2], x1[3]); *(uint2*)(qd + 64 + 4 * h) = o;
          o.x = pk2(x2[0], x2[1]); o.y = pk2(x2[2], x2[3]); *(uint2*)(qd + 72 + 4 * h) = o;
          o.x = pk2(x3[0], x3[1]); o.y = pk2(x3[2], x3[3]); *(uint2*)(qd + 80 + 4 * h) = o;
          o.x = pk2(x4[0], x4[1]); o.y = pk2(x4[2], x4[3]); *(uint2*)(qd + 88 + 4 * h) = o;
          __syncthreads();
          {
            const int m_0 = m0 + mw;
            int b0, pos0;
            if (m_0 < MX) { b0 = m_0 >> 12; pos0 = CTX + (m_0 & 4095); } else { const int my = m_0 - MX; b0 = my >> 8; pos0 = my & 255; }
            u16* dst = Qb + ((long)(b0 * 8 + head) * KPOS + pos0) * 96;
            const int lane = h * 32 + r;
#pragma unroll
            for (int q = 0; q < 6; ++q) {
              const int id = q * 64 + lane; const int row = id / 12, c = id % 12;
              *(uint4*)(dst + id * 8) = *(const uint4*)(stg + row * 208 + c * 16);
            }
          }
          __syncthreads();
        };
        gemm_loop<4, 1, 3, true, false, LdDirect<128>, LdDirect<192>>(FIRST(0), nQ, nblk, mkl, set, epi, 4, lds);
      }
      {
        int m0 = 0, n0 = 0;
        auto set = [&](int it) { m0 = (it >> 2) * 256; n0 = (it & 3) * 128; };
        {
          auto mkl = [&](int it, LdDirect<256>& la, LdDirect<128>& lb) {
            const int mt = it >> 2, nt = it & 3;
            la.base = p.p + (long)mt * 256 * NP + C_CKV; la.ld = NP;
            lb.base = p.wukv_t + ((long)l * 1024 + nt * 128) * 128; lb.ld = 128; };
          const float* kg = p.k_norm_g + l * 96;
          u16* Kb = p.k; const u16* P = p.p; const float* ROPE = p.rope;
          auto epi = [&](f32x16 (&acc)[2][2], int mw, int nw, int r, int h) {
            const int head = (n0 + nw) >> 6;
#pragma unroll
            for (int i = 0; i < 2; ++i) {
              const int m = m0 + mw + i * 32 + r;
              float kr[16];
              { const u16* kp = P + (long)m * NP + C_KROPE + 16 * h;
                unpack8(*(const uint4*)kp, kr); unpack8(*(const uint4*)(kp + 8), kr + 8); }
              int b, pos; bool isx; int ipos = 0;
              if (m < MX) { b = m >> 12; const int n = m & 4095; pos = CTX + n; isx = true; ipos = h ? (n & 63) : (n >> 6); }
              else { const int my = m - MX; b = my >> 8; pos = my & 255; isx = false; }
              float2 tr[8];
#pragma unroll
              for (int e = 0; e < 8; ++e) tr[e] = *(const float2*)(ROPE + (ipos * 8 + e) * 2);
              const float4 sk = *(const float4*)(p.stats + (long)m * 16 + 8);
              const float rkv2 = 1.f / ((sk.x + sk.y + sk.z + sk.w) * (1.f / 128.f) + EPS);
              float ssr = 0.f, ssn = 0.f;
#pragma unroll
              for (int e = 0; e < 16; ++e) ssr += kr[e] * kr[e];
#pragma unroll
              for (int j = 0; j < 2; ++j)
#pragma unroll
                for (int e = 0; e < 16; ++e) ssn += acc[i][j][e] * acc[i][j][e];
              float ss = ssr + ssn * rkv2;
              ss += __shfl_xor(ss, 32);
              const float rs = rsqrtf(ss * (1.f / 96.f) + EPS);
              const float rsn = rs * sqrtf(rkv2);
              u16* kd = (u16*)(lds + (ltid() >> 6) * (64 * 208) + (i * 32 + r) * 208);
#pragma unroll
              for (int j = 0; j < 2; ++j)
#pragma unroll
                for (int g4 = 0; g4 < 4; ++g4) {
                  const int f0 = j * 32 + 8 * g4 + 4 * h;
                  const float4 g = *(const float4*)(kg + f0);
                  uint2 o;
                  o.x = pk2(acc[i][j][4 * g4] * rsn * g.x, acc[i][j][4 * g4 + 1] * rsn * g.y);
                  o.y = pk2(acc[i][j][4 * g4 + 2] * rsn * g.z, acc[i][j][4 * g4 + 3] * rsn * g.w);
                  *(uint2*)(kd + f0) = o;
                }
              float oa[8], ob[8];
#pragma unroll
              for (int e = 0; e < 8; ++e) {
                const float xa = kr[e] * rs * kg[64 + 16 * h + e], xb = kr[8 + e] * rs * kg[64 + 16 * h + 8 + e];
                if (isx) { const float cs = tr[e].x, sn = tr[e].y; oa[e] = xa * cs - xb * sn; ob[e] = xb * cs + xa * sn; }
                else { oa[e] = xa; ob[e] = xb; }
              }
              uint4 o;
              o.x = pk2(oa[0], oa[1]); o.y = pk2(oa[2], oa[3]); o.z = pk2(oa[4], oa[5]); o.w = pk2(oa[6], oa[7]);
              *(uint4*)(kd + 64 + 16 * h) = o;
              o.x = pk2(ob[0], ob[1]); o.y = pk2(ob[2], ob[3]); o.z = pk2(ob[4], ob[5]); o.w = pk2(ob[6], ob[7]);
              *(uint4*)(kd + 64 + 16 * h + 8) = o;
            }
            __syncthreads();
            {
              const char* stg = lds + (ltid() >> 6) * (64 * 208);
              const int m_0 = m0 + mw;
              int b0, pos0;
              if (m_0 < MX) { b0 = m_0 >> 12; pos0 = CTX + (m_0 & 4095); } else { const int my = m_0 - MX; b0 = my >> 8; pos0 = my & 255; }
              u16* dst = Kb + ((long)(b0 * 8 + head) * KPOS + pos0) * 96;
              const int lane = h * 32 + r;
#pragma unroll
              for (int q = 0; q < 12; ++q) {
                const int id = q * 64 + lane; const int row = id / 12, c = id % 12;
                *(uint4*)(dst + id * 8) = *(const uint4*)(stg + row * 208 + c * 16);
              }
            }
            __syncthreads();
          };
          gemm_loop<4, 2, 2, true, false, LdDirect<256>, LdDirect<128>>(FIRST(64), nKN, nblk, mkl, set, epi, 2, lds);
        }
        {
          auto mkl = [&](int it, LdDirect<256>& la, LdDirect<128>& lb) {
            const int mt = it >> 2, nt = it & 3;
            la.base = p.p + (long)mt * 256 * NP + C_CKV; la.ld = NP;
            lb.base = p.wukv_t + ((long)l * 1024 + 512 + nt * 128) * 128; lb.ld = 128; };
          u16* VT = p.vt;
          auto epi = [&](f32x16 (&acc)[2][2], int mw, int nw, int r, int h) {
            char* stg = lds + (ltid() >> 6) * (64 * 144);
            const int m_0 = m0 + mw;
#pragma unroll
            for (int i = 0; i < 2; ++i)
#pragma unroll
              for (int g4 = 0; g4 < 4; ++g4) {
                const int tl = i * 32 + 8 * g4 + 4 * h;
                float rv[4];
#pragma unroll
                for (int e = 0; e < 4; ++e) { const float4 sk = *(const float4*)(p.stats + (long)(m_0 + tl + e) * 16 + 8);
                  rv[e] = rsqrtf((sk.x + sk.y + sk.z + sk.w) * (1.f / 128.f) + EPS); }
#pragma unroll
                for (int j = 0; j < 2; ++j) {
                  uint2 o;
                  o.x = pk2(acc[i][j][4 * g4] * rv[0], acc[i][j][4 * g4 + 1] * rv[1]); o.y = pk2(acc[i][j][4 * g4 + 2] * rv[2], acc[i][j][4 * g4 + 3] * rv[3]);
                  *(uint2*)(stg + (j * 32 + r) * 144 + tl * 2) = o;
                }
              }
            __syncthreads();
            {
              int b0, pos0;
              if (m_0 < MX) { b0 = m_0 >> 12; pos0 = CTX + (m_0 & 4095); } else { const int my = m_0 - MX; b0 = my >> 8; pos0 = my & 255; }
              const int head = (n0 + nw) >> 6;
              u16* dst = VT + ((long)(b0 * 8 + head) * 64) * KPOS + pos0;
              const int lane = h * 32 + r;
#pragma unroll
              for (int q = 0; q < 8; ++q) {
                const int id = q * 64 + lane; const int dv = id >> 3, c = id & 7;
                *(uint4*)(dst + (long)dv * KPOS + c * 8) = *(const uint4*)(stg + dv * 144 + c * 16);
              }
            }
            __syncthreads();
          };
          gemm_loop<4, 2, 2, false, false, LdDirect<256>, LdDirect<128>>(FIRST(96), nV, nblk, mkl, set, epi, 2, lds);
        }
      }
      {
        int half = 0, n2 = 0, b = 0;
        auto mkl = [&](int it, LdDirect<128>& la, LdTrans<128>& lb) {
          const int half_ = it & 1, n2_ = (it >> 1) & 63, b_ = it >> 7;
          la.base = p.t1; la.ld = 64;
          lb.base = p.p + (long)(b_ * 4096 + n2_) * NP + C_FIN + half_ * 128; lb.strideK = 64L * NP; };
        auto set = [&](int it) { half = it & 1; n2 = (it >> 1) & 63; b = it >> 7; };
        u16* A1 = p.a1; const float* TW = p.tw;
        auto epi = [&](f32x16 (&acc)[2][1], int mw, int nw, int r, int h) {
          const int gc = half * 128 + nw + r;
          float2 t[16];
#pragma unroll
          for (int e = 0; e < 16; ++e) { const float fr = (float)(n2 * ((mw >> 1) + crow(e, h))) * (1.f / 4096.f);
            t[e] = make_float2(__builtin_amdgcn_cosf(fr), __builtin_amdgcn_sinf(fr)); }
#pragma unroll
          for (int e = 0; e < 16; ++e) {
            const int k1 = (mw >> 1) + crow(e, h);
            const float re = acc[0][0][e], im = acc[1][0][e];
            const float re2 = re * t[e].x + im * t[e].y, im2 = im * t[e].x - re * t[e].y;
            const long o = ((((long)b * 64 + k1) * 64 + n2) * 2) * 256 + gc;
            A1[o] = f2bf(re2); A1[o + 256] = f2bf(im2);
          }
        };
        gemm_loop<2, 2, 1, false, true, LdDirect<128>, LdTrans<128>>(FIRST(0), nF1, nblk, mkl, set, epi, 1, lds);
      }
      {
        int half = 0, mt = 0, b = 0;
        auto mkl = [&](int it, LdDirect<128>& la, LdTrans<128>& lb) {
          const int half_ = it & 1, mt_ = (it >> 1) & 3, b_ = it >> 3;
          la.base = p.t256 + (long)mt_ * 128 * 256; la.ld = 256;
          lb.base = p.p + (long)(MX + b_ * 256) * NP + C_FIN + half_ * 128; lb.strideK = (long)NP; };
        auto set = [&](int it) { half = it & 1; mt = (it >> 1) & 3; b = it >> 3; };
        u16* YF = p.yf;
        auto epi = [&](f32x16 (&acc)[1][2], int mw, int nw, int r, int h) {
#pragma unroll
          for (int j = 0; j < 2; ++j) {
            const int gc = half * 128 + nw + j * 32 + r; const int g = gc >> 6, c2 = gc & 63;
#pragma unroll
            for (int e = 0; e < 16; ++e) {
              const int rho = mt * 128 + mw + crow(e, h); const int ri = rho >> 8, k = rho & 255;
              YF[(long)(MX + b * 256 + k) * 512 + g * 128 + ri * 64 + c2] = f2bf(acc[0][j][e]);
            }
          }
        };
        gemm_loop<4, 1, 2, false, true, LdDirect<128>, LdTrans<128>>(FIRST(128), nFy, nblk, mkl, set, epi, 4, lds);
      }
      {
        int hd = 0, row0 = 0;
        auto mkl = [&](int it, LdDirect<128>& la, LdLN4& lb) {
          const int hd_ = it & 3, qd_ = it >> 2;
          la.base = p.gws_b + (long)(l * 4 + hd_) * 128 * 128; la.ld = 128;
          lb.base = p.p + (long)qd_ * 512 * NP + C_GV + hd_ * 64; lb.g = p.g_ln_g + l * 64; };
        auto set = [&](int it) { hd = it & 3; row0 = (it >> 2) * 512; };
        const u16* P = p.p; u16* MIX = p.hmix;
        auto epi = [&](f32x16 (&acc)[1][4], int mw, int nw, int r, int h) {
          const float bias = p.g_bs[(l * 4 + hd) * 128 + mw + r];
          char* stg = lds + (ltid() >> 6) * (32 * 272);
#pragma unroll
          for (int jj = 0; jj < 2; ++jj) {
#pragma unroll
            for (int j2 = 0; j2 < 2; ++j2)
#pragma unroll
              for (int g4 = 0; g4 < 4; ++g4)
                *(float4*)(stg + r * 272 + (j2 * 32 + 8 * g4 + 4 * h) * 4) =
                    make_float4(acc[0][2 * jj + j2][4 * g4] + bias, acc[0][2 * jj + j2][4 * g4 + 1] + bias, acc[0][2 * jj + j2][4 * g4 + 2] + bias, acc[0][2 * jj + j2][4 * g4 + 3] + bias);
            const long row_w = row0 + ((nw >> 6) + jj) * 128 + mw;
            const SgPre<4> gpre = staged_gate_fetch<32, 8, true>(h * 32 + r, P + row_w * NP + C_GGATE + hd * 64, P + row_w * NP + C_GU + hd * 64, NP);
            __syncthreads();
            staged_gate_finish<32, 8, 272, true>(stg, h * 32 + r, gpre, MIX + row_w * 1024 + 256 + hd * 64, 1024);
            __syncthreads();
          }
        };
        gemm_loop<4, 1, 4, true, true, LdDirect<128>, LdLN4>(FIRST(192), nG, nblk, mkl, set, epi, 2, lds);
      }
    }
    xcd_barrier(xb);

    {
      {
        int half = 0, k1 = 0, b = 0;
        auto mkl = [&](int it, LdDirect<128>& la, LdTrans<128>& lb) {
          const int half_ = it & 1, k1_ = (it >> 1) & 63, b_ = it >> 7;
          la.base = p.t2; la.ld = 128;
          lb.base = p.a1 + (((long)b_ * 64 + k1_) * 64 * 2) * 256 + half_ * 128; lb.strideK = 256L; };
        auto set = [&](int it) { half = it & 1; k1 = (it >> 1) & 63; b = it >> 7; };
        u16* YF = p.yf;
        auto epi = [&](f32x16 (&acc)[1][2], int mw, int nw, int r, int h) {
#pragma unroll
          for (int j = 0; j < 2; ++j) {
            const int gc = half * 128 + nw + j * 32 + r; const int g = gc >> 6, c2 = gc & 63;
#pragma unroll
            for (int e = 0; e < 16; ++e) {
              const int rho = mw + crow(e, h); const int ri = rho >> 6, k2 = rho & 63;
              YF[(long)(b * 4096 + k1 + 64 * k2) * 512 + g * 128 + ri * 64 + c2] = f2bf(acc[0][j][e]);
            }
          }
        };
        gemm_loop<4, 1, 2, false, true, LdDirect<128>, LdTrans<128>>(bid, 1024, nblk, mkl, set, epi, 2, lds);
      }
    {
      const u16* mf = p.mf_t + (long)l * 256 * 512;
      int m0 = 0, n0 = 0;
      auto mkl = [&](int it, LdDirect<256>& la, LdDirect<128>& lb) {
        const int mt = it >> 1, nt = it & 1;
        la.base = p.yf + (long)mt * 256 * 512; la.ld = 512; lb.base = mf + (long)nt * 128 * 512; lb.ld = 512; };
      auto set = [&](int it) { m0 = (it >> 1) * 256; n0 = (it & 1) * 128; };
      const u16* P = p.p; u16* MIX = p.hmix;
      auto epi = [&](f32x16 (&acc)[2][2], int mw, int nw, int r, int h) {
        const float sc = (m0 < MX) ? (1.f / 512.f) : (1.f / 128.f);
#pragma unroll
        for (int i = 0; i < 2; ++i) {
          u16 gv[2][16];
#pragma unroll
          for (int j = 0; j < 2; ++j)
#pragma unroll
            for (int e = 0; e < 16; ++e)
              gv[j][e] = P[(long)(m0 + mw + i * 32 + crow(e, h)) * NP + C_FGATE + n0 + nw + j * 32 + r];
#pragma unroll
          for (int j = 0; j < 2; ++j)
#pragma unroll
            for (int e = 0; e < 16; ++e)
              MIX[(long)(m0 + mw + i * 32 + crow(e, h)) * 1024 + n0 + nw + j * 32 + r] = f2bf(acc[i][j][e] * sc * silu(bf2f(gv[j][e])));
        }
      };
      gemm_loop<4, 2, 2, false, false, LdDirect<256>, LdDirect<128>>(128 * 2 + ((bid + nblk - 200) % nblk), (l == DEPTH - 1) ? 128 * 2 : 136 * 2, nblk, mkl, set, epi, 8, lds);
    }
      float negB;
      {
        float gq = 0.f, gk = 0.f;
        for (int i = 0; i < 96; ++i) { gq = fmaxf(gq, fabsf(p.q_norm_g[l * 96 + i])); gk = fmaxf(gk, fabsf(p.k_norm_g[l * 96 + i])); }
        negB = -(96.f * gq * gk * (0.10206207261596575f * 1.4426950408889634f) * 1.02f + 0.5f);
      }
      for (int it = bid; it < 512; it += nblk) {
        const int rnd = it / nblk; const int lb_ = it % nblk;
        int bh, qb;
        if (nblk == 256) { const int xcd = lb_ & 7, slot = lb_ >> 3; bh = rnd * 32 + xcd * 4 + (slot >> 3); qb = slot & 7; }
        else { bh = it >> 3; qb = it & 7; }
        const int b = bh >> 3, hd = bh & 7;
        const long bhoff = (long)(b * 8 + hd);
        const long row_base = (long)b * 4096 + qb * 512;
        attn_item64(p.q + bhoff * KPOS * 96, p.k + bhoff * KPOS * 96, p.vt + bhoff * 64 * KPOS, CTX + qb * 512, KPOS,
                    p.p + row_base * NP + C_AGATE + hd * 64, p.hmix + row_base * 1024 + 512 + hd * 64, lds);
      }
      if (l < DEPTH - 1) {
        for (int bh = (bid + nblk - 64) % nblk; bh < 64; bh += nblk) {
          const int b = bh >> 3, hd = bh & 7;
          const long bhoff = (long)(b * 8 + hd);
          const long row_base = (long)MX + b * 256;
          attn_item(p.q + bhoff * KPOS * 96, p.k + bhoff * KPOS * 96, p.vt + bhoff * 64 * KPOS, 0, CTX,
                    p.p + row_base * NP + C_AGATE + hd * 64, p.hmix + row_base * 1024 + 512 + hd * 64, negB, lds);
        }
      }
    }
    xcd_barrier(xb);

    {
      const u16* mf = p.mf_t + (long)l * 256 * 512;
      int m0 = 0, n0 = 0;
      auto mkl = [&](int it, LdDirect<256>& la, LdDirect<128>& lb) {
        const int mt = it >> 1, nt = it & 1;
        la.base = p.yf + (long)mt * 256 * 512; la.ld = 512; lb.base = mf + (long)nt * 128 * 512; lb.ld = 512; };
      auto set = [&](int it) { m0 = (it >> 1) * 256; n0 = (it & 1) * 128; };
      const u16* P = p.p; u16* MIX = p.hmix;
      auto epi = [&](f32x16 (&acc)[2][2], int mw, int nw, int r, int h) {
        const float sc = (m0 < MX) ? (1.f / 512.f) : (1.f / 128.f);
#pragma unroll
        for (int i = 0; i < 2; ++i) {
          u16 gv[2][16];
#pragma unroll
          for (int j = 0; j < 2; ++j)
#pragma unroll
            for (int e = 0; e < 16; ++e)
              gv[j][e] = P[(long)(m0 + mw + i * 32 + crow(e, h)) * NP + C_FGATE + n0 + nw + j * 32 + r];
#pragma unroll
          for (int j = 0; j < 2; ++j)
#pragma unroll
            for (int e = 0; e < 16; ++e)
              MIX[(long)(m0 + mw + i * 32 + crow(e, h)) * 1024 + n0 + nw + j * 32 + r] = f2bf(acc[i][j][e] * sc * silu(bf2f(gv[j][e])));
        }
      };
      gemm_loop<4, 2, 2, false, false, LdDirect<256>, LdDirect<128>>(bid, 128 * 2, nblk, mkl, set, epi, 8, lds);
    }
    xcd_barrier(xb);

    {
      const u16* wt = p.wout_t + (long)l * 1024 * 1024;
      int m0 = 0, n0 = 0;
      auto epi = [&](auto& acc, int mw, int nw, int r, int h) {
        constexpr int WM_ = sizeof(acc) / sizeof(acc[0]), WN_ = sizeof(acc[0]) / sizeof(acc[0][0]);
        const bool isx = m0 < MX;
        const float* __restrict__ src = isx ? (l == 0 ? p.x : p.out) + (long)m0 * 1024 : (l == 0 ? p.ctx : p.yw) + (long)(m0 - MX) * 1024;
        float* __restrict__ dst = isx ? p.out + (long)m0 * 1024 : p.yw + (long)(m0 - MX) * 1024;
        const float* gp = modl + (isx ? (m0 >> 12) : 8) * 3072 + 2048;
#pragma unroll
        for (int i = 0; i < WM_; ++i) {
          float old[WN_][16];
#pragma unroll
          for (int j = 0; j < WN_; ++j)
#pragma unroll
            for (int e = 0; e < 16; ++e)
              old[j][e] = src[(long)(mw + i * 32 + crow(e, h)) * 1024 + n0 + nw + j * 32 + r];
#pragma unroll
          for (int j = 0; j < WN_; ++j) {
            const float gt = gp[n0 + nw + j * 32 + r];
#pragma unroll
            for (int e = 0; e < 16; ++e)
              dst[(long)(mw + i * 32 + crow(e, h)) * 1024 + n0 + nw + j * 32 + r] = old[j][e] + gt * acc[i][j][e];
          }
        }
      };
      {
        auto mkl = [&](int j, LdDirect<256>& la, LdDirect<128>& lb) {
          const int mt = (j >> 3) * 8 + (bid & 7), nt = j & 7;
          la.base = p.hmix + (long)mt * 256 * 1024; la.ld = 1024; lb.base = wt + (long)nt * 128 * 1024; lb.ld = 1024; };
        auto set = [&](int j) { m0 = ((j >> 3) * 8 + (bid & 7)) * 256; n0 = (j & 7) * 128; };
        gemm_loop3<16, 4, 2, 2, false, false, LdDirect<256>, LdDirect<128>>(bid >> 3, 16 * 8, nblk >> 3, mkl, set, epi, lds);
      }
      if (l < DEPTH - 1) {
        auto mkl = [&](int it, LdDirect<128>& la, LdDirect<64>& lb) {
          const int mt = it >> 4, nt = it & 15;
          la.base = p.hmix + (long)(MX + mt * 128) * 1024; la.ld = 1024; lb.base = wt + (long)nt * 64 * 1024; lb.ld = 1024; };
        auto set = [&](int it) { m0 = MX + (it >> 4) * 128; n0 = (it & 15) * 64; };
        gemm_loop<4, 1, 1, false, false, LdDirect<128>, LdDirect<64>>(bid, 16 * 16, nblk, mkl, set, epi, 16, lds);
      }
    }
    if (l < DEPTH - 1) xcd_barrier(xb);
  }
}

static inline size_t al256(size_t x) { return (x + 255) / 256 * 256; }

extern "C" void kernel_launch(void* const* d_in, const int* in_sizes, int n_in,
                              void* d_out, int out_size, void* d_ws, size_t ws_size,
                              hipStream_t stream) {
  static int grid_blocks = 0;
  if (!grid_blocks) {
    int dev = 0, cus = 0, per_cu = 0;
    (void)hipGetDevice(&dev);
    (void)hipDeviceGetAttribute(&cus, hipDeviceAttributeMultiprocessorCount, dev);
    (void)hipFuncSetAttribute((const void*)fwd_megakernel, hipFuncAttributeMaxDynamicSharedMemorySize, LDS_BYTES);
    (void)hipOccupancyMaxActiveBlocksPerMultiprocessor(&per_cu, fwd_megakernel, NT_, LDS_BYTES);
    if (per_cu < 1) { fprintf(stderr, "occupancy query returned %d\n", per_cu); per_cu = 1; }
    grid_blocks = cus;
  }
  Params p{};
  p.x = (const float*)d_in[0]; p.c = (const float*)d_in[1]; p.ctx = (const float*)d_in[2]; p.c_ctx = (const float*)d_in[3];
  p.w_mod = (const float*)d_in[4]; p.b_mod = (const float*)d_in[5]; p.norm_g = (const float*)d_in[6]; p.w_in = (const float*)d_in[7];
  p.w_fmix = (const float*)d_in[8]; p.g_ln_g = (const float*)d_in[9]; p.g_ws = (const float*)d_in[10]; p.g_bs = (const float*)d_in[11];
  p.q_a_g = (const float*)d_in[12]; p.w_uq = (const float*)d_in[13]; p.kv_a_g = (const float*)d_in[14]; p.w_ukv = (const float*)d_in[15];
  p.q_norm_g = (const float*)d_in[16]; p.k_norm_g = (const float*)d_in[17]; p.w_out = (const float*)d_in[18];
  p.out = (float*)d_out;
  char* ws = (char*)d_ws; size_t off = 0;
  auto take = [&](size_t bytes) { char* r = ws + off; off = al256(off + bytes); return r; };
  p.bar = (unsigned*)take((size_t)XCD_BAR_WORDS * 4);
  p.yw = (float*)take((size_t)MY * 1024 * 4);
  p.mod = (float*)take((size_t)DEPTH * 9 * 3072 * 4);
  p.tw = (float*)take(4096 * 2 * 4);
  p.rope = (float*)take(64 * 8 * 2 * 4);
  p.stats = (float*)take((size_t)MT * 16 * 4);
  p.win_t = (u16*)take((size_t)DEPTH * NP * 1024 * 2);
  p.wout_t = (u16*)take((size_t)DEPTH * 1024 * 1024 * 2);
  p.wuq_t = (u16*)take((size_t)DEPTH * 768 * 256 * 2);
  p.wukv_t = (u16*)take((size_t)DEPTH * 1024 * 128 * 2);
  p.gws_b = (u16*)take((size_t)DEPTH * 4 * 128 * 128 * 2);
  p.mf_t = (u16*)take((size_t)DEPTH * 256 * 512 * 2);
  p.t1 = (u16*)take(128 * 64 * 2);
  p.t2 = (u16*)take(128 * 128 * 2);
  p.t256 = (u16*)take(512 * 256 * 2);
  p.hmix = (u16*)take((size_t)MT * 1024 * 2);
  p.p = (u16*)take((size_t)MT * NP * 2);
  p.q = (u16*)take((size_t)NB * 8 * KPOS * 96 * 2);
  p.k = (u16*)take((size_t)NB * 8 * KPOS * 96 * 2);
  p.vt = (u16*)take((size_t)NB * 8 * 64 * KPOS * 2);
  p.a1 = (u16*)take((size_t)NB * 64 * 64 * 2 * 256 * 2);
  p.yf = (u16*)take((size_t)MT * 512 * 2);
  if (off > ws_size) { fprintf(stderr, "workspace too small: need %zu have %zu\n", off, ws_size); return; }
  (void)hipMemsetAsync(p.bar, 0, (size_t)XCD_BAR_WORDS * 4, stream);
  void* args[] = {&p};
  hipError_t e = hipLaunchCooperativeKernel((void*)fwd_megakernel, dim3(grid_blocks), dim3(NT_), args, LDS_BYTES, stream);
  if (e != hipSuccess) fprintf(stderr, "cooperative launch failed: %s (grid %d)\n", hipGetErrorString(e), grid_blocks);
}
```

```cpp
#include <hip/hip_runtime.h>
#include <hip/hip_cooperative_groups.h>
#include <cstdio>
#include <cstdint>
namespace cg = cooperative_groups;

typedef unsigned short u16;
typedef __attribute__((ext_vector_type(8))) short bf16x8;
typedef __attribute__((ext_vector_type(16))) float f32x16;
typedef __attribute__((ext_vector_type(2))) __bf16 bf2_t;
typedef __attribute__((ext_vector_type(2))) float f2_t;
#define DI __device__ __forceinline__

constexpr int NB = 8, SEQ = 4096, DEPTH = 4, CTX = 256;
constexpr int MX = NB * SEQ, MY = NB * CTX, MT = MX + MY;
constexpr int NP = 2304, INW = 2208;
constexpr int C_FIN = 0, C_FGATE = 256, C_GU = 512, C_GV = 768, C_GGATE = 1024, C_CQ = 1280, C_CKV = 1536, C_KROPE = 1664, C_AGATE = 1696;
constexpr int KPOS = CTX + SEQ;
constexpr int NT_ = 512;
constexpr int PITCH = 144;
constexpr int LDS_BYTES = 131072;
constexpr int RSTD_OFF = 129024;
constexpr float EPS = 1e-6f;
constexpr float PI_F = 3.14159265358979323846f;

struct Params {
  const float *x, *c, *ctx, *c_ctx, *w_mod, *b_mod, *norm_g, *w_in, *w_fmix, *g_ln_g, *g_ws, *g_bs, *q_a_g, *w_uq, *kv_a_g, *w_ukv, *q_norm_g, *k_norm_g, *w_out;
  float* out;
  unsigned* bar;
  float *yw, *mod, *tw, *rope, *stats;
  u16 *win_t, *wout_t, *wuq_t, *wukv_t, *gws_b, *mf_t, *t1, *t2, *t256, *hmix, *p, *q, *k, *vt, *a1, *yf;
};

DI int ltid() { int t = threadIdx.x; asm volatile("" : "+v"(t)); return t; }
DI float bf2f(u16 v) { return __uint_as_float(((unsigned)v) << 16); }
DI unsigned pk2(float a, float b) { f2_t v = {a, b}; bf2_t r = __builtin_convertvector(v, bf2_t); return __builtin_bit_cast(unsigned, r); }
DI u16 f2bf(float a) { return (u16)(pk2(a, 0.f) & 0xffffu); }
DI float silu(float x) { return x / (1.f + __expf(-x)); }
DI int crow(int reg, int h) { return (reg & 3) + 8 * (reg >> 2) + 4 * h; }
DI float lo16(unsigned w) { return __uint_as_float(w << 16); }
DI float hi16(unsigned w) { return __uint_as_float(w & 0xffff0000u); }
DI f32x16 mfma(bf16x8 a, bf16x8 b, f32x16 c) { return __builtin_amdgcn_mfma_f32_32x32x16_bf16(a, b, c, 0, 0, 0); }
DI void unpack8(const uint4& v, float* f) {
  f[0] = lo16(v.x); f[1] = hi16(v.x); f[2] = lo16(v.y); f[3] = hi16(v.y);
  f[4] = lo16(v.z); f[5] = hi16(v.z); f[6] = lo16(v.w); f[7] = hi16(v.w);
}

#define XB_TMO      128
#define XB_XCNT(j)  (256  + 64 * (j))
#define XB_XSUB(j)  (1280 + 64 * (j))
#define XB_XGEN(j)  (2304 + 64 * (j))
#define XB_TOP      3328
#define XB_TOPGEN   3392
#define XCD_BAR_WORDS 3456
#define XB_SPIN_CAP (1u << 18)
#define LAS __attribute__((address_space(3)))
DI unsigned xb_ld(unsigned* p)              { return __hip_atomic_load(p, __ATOMIC_RELAXED, __HIP_MEMORY_SCOPE_AGENT); }
DI unsigned xb_add(unsigned* p, unsigned v) { return __hip_atomic_fetch_add(p, v, __ATOMIC_RELAXED, __HIP_MEMORY_SCOPE_AGENT); }
DI unsigned xb_xcc_id() { return (unsigned)__builtin_amdgcn_s_getreg((3 << 11) | 20) & 0xFu; }
#define XB_SPIN(cond, bar) do { unsigned _sp = 0; while (cond) { __builtin_amdgcn_s_sleep(1); \
    if ((++_sp & 255u) == 0u) { if (xb_ld(&(bar)[XB_TMO])) break; if (_sp > XB_SPIN_CAP) { atomicAdd(&(bar)[XB_TMO], 1u); break; } } } } while (0)
struct XcdBarrier { unsigned* bar; unsigned x; volatile LAS unsigned* st; };
DI XcdBarrier xcd_barrier_post(unsigned* bar, volatile LAS unsigned* st) {
  XcdBarrier b; b.bar = bar; b.x = xb_xcc_id(); b.st = st;
  if (threadIdx.x == 0) (void)xb_add(&bar[XB_XCNT(b.x)], 1u);
  return b;
}
DI void xcd_barrier_complete(unsigned* bar, unsigned x, unsigned& nloc, unsigned& nx) {
  const unsigned G = gridDim.x * gridDim.y * gridDim.z;
  unsigned sum, cnt, mine, sp = 0u;
  for (;;) {
    sum = 0u; cnt = 0u; mine = 0u;
#pragma unroll
    for (unsigned j = 0; j < 16; ++j) { const unsigned c = xb_ld(&bar[XB_XCNT(j)]); sum += c; cnt += (c > 0u) ? 1u : 0u; mine = (j == x) ? c : mine; }
    if (sum == G) break;
    __builtin_amdgcn_s_sleep(1);
    if ((++sp & 255u) == 0u) { if (xb_ld(&bar[XB_TMO])) break; if (sp > XB_SPIN_CAP) { atomicAdd(&bar[XB_TMO], 1u); break; } }
  }
  nloc = mine > 0u ? mine : 1u; nx = cnt > 0u ? cnt : 1u;
}
DI void xcd_barrier(const XcdBarrier& b) {
  asm volatile("s_waitcnt vmcnt(0)" ::: "memory");
  __syncthreads();
  if (threadIdx.x == 0) {
    unsigned* bar = b.bar;
    __builtin_amdgcn_s_waitcnt(0);
    unsigned nloc = b.st[0], nx = b.st[1];
    if (nloc == 0u) { xcd_barrier_complete(bar, b.x, nloc, nx); b.st[0] = nloc; b.st[1] = nx; }
    const unsigned old = xb_add(&bar[XB_XSUB(b.x)], 1u);
    const unsigned gen = old / nloc;
    if (old + 1u == (gen + 1u) * nloc) {
      __builtin_amdgcn_fence(__ATOMIC_RELEASE, "agent");
      asm volatile("s_waitcnt vmcnt(0)" ::: "memory");
      const unsigned og = xb_add(&bar[XB_TOP], 1u);
      const unsigned tg = og / nx;
      if (og + 1u == (tg + 1u) * nx) xb_add(&bar[XB_TOPGEN], 1u);
      else XB_SPIN(xb_ld(&bar[XB_TOPGEN]) == tg, bar);
      __builtin_amdgcn_fence(__ATOMIC_ACQUIRE, "agent");
      xb_add(&bar[XB_XGEN(b.x)], 1u);
      asm volatile("s_waitcnt vmcnt(0)" ::: "memory");
    } else {
      XB_SPIN(xb_ld(&bar[XB_XGEN(b.x)]) == gen, bar);
      __builtin_amdgcn_fence(__ATOMIC_ACQUIRE, "agent");
      asm volatile("s_waitcnt vmcnt(0)" ::: "memory");
    }
  }
  __syncthreads();
}


template <int ROWS> struct LdDirect {
  static constexpr int NR = ROWS * 8 / NT_;
  struct Regs { uint4 v[NR]; };
  const u16* base; long ld;
  DI Regs fetch(int kt, int tid) const { Regs r;
#pragma unroll
    for (int i = 0; i < NR; ++i) { int id = tid + NT_ * i; int row = id >> 3, kc = id & 7;
      r.v[i] = *(const uint4*)(base + (long)row * ld + kt * 64 + kc * 8); }
    return r;
  }
  DI void commit(char* s, const Regs& r, int, int tid) const {
#pragma unroll
    for (int i = 0; i < NR; ++i) { int id = tid + NT_ * i; int row = id >> 3, kc = id & 7;
      *(uint4*)(s + row * PITCH + kc * 16) = r.v[i]; }
  }
};
template <int ROWS> struct LdScaled {
  static constexpr int NR = ROWS * 8 / NT_;
  struct Regs { uint4 v[NR]; };
  const u16* base; long ld; const float* g; const float* rstd_s;
  DI Regs fetch(int kt, int tid) const { Regs r;
#pragma unroll
    for (int i = 0; i < NR; ++i) { int id = tid + NT_ * i; int row = id >> 3, kc = id & 7;
      r.v[i] = *(const uint4*)(base + (long)row * ld + kt * 64 + kc * 8); }
    return r;
  }
  DI void commit(char* s, const Regs& r, int kt, int tid) const {
#pragma unroll
    for (int i = 0; i < NR; ++i) { int id = tid + NT_ * i; int row = id >> 3, kc = id & 7;
      float f[8]; unpack8(r.v[i], f);
      const float rs = rstd_s[row];
      const float4 g0 = *(const float4*)(g + kt * 64 + kc * 8), g1 = *(const float4*)(g + kt * 64 + kc * 8 + 4);
      uint4 o;
      o.x = pk2(f[0] * rs * g0.x, f[1] * rs * g0.y); o.y = pk2(f[2] * rs * g0.z, f[3] * rs * g0.w);
      o.z = pk2(f[4] * rs * g1.x, f[5] * rs * g1.y); o.w = pk2(f[6] * rs * g1.z, f[7] * rs * g1.w);
      *(uint4*)(s + row * PITCH + kc * 16) = o; }
  }
};
template <int BN> struct LdTrans {
  static constexpr int NC = BN / 8;
  static constexpr int NR = 32 * NC / NT_;
  struct Regs { uint4 v[2 * NR]; };
  const u16* base; long strideK;
  DI Regs fetch(int kt, int tid) const { Regs r;
#pragma unroll
    for (int i = 0; i < NR; ++i) { int id = tid + NT_ * i; int nc = id % NC, k2 = id / NC;
      r.v[2 * i] = *(const uint4*)(base + (long)(kt * 64 + 2 * k2) * strideK + nc * 8);
      r.v[2 * i + 1] = *(const uint4*)(base + (long)(kt * 64 + 2 * k2 + 1) * strideK + nc * 8); }
    return r;
  }
  DI void commit(char* s, const Regs& r, int, int tid) const {
#pragma unroll
    for (int i = 0; i < NR; ++i) { int id = tid + NT_ * i; int nc = id % NC, k = 2 * (id / NC);
      const int off = (((k >> 3) ^ (nc & 7)) << 4) + (k & 7) * 2;
      char* d = s + (nc * 8) * PITCH + off;
      const unsigned a[4] = {r.v[2 * i].x, r.v[2 * i].y, r.v[2 * i].z, r.v[2 * i].w};
      const unsigned c[4] = {r.v[2 * i + 1].x, r.v[2 * i + 1].y, r.v[2 * i + 1].z, r.v[2 * i + 1].w};
#pragma unroll
      for (int e = 0; e < 8; ++e) {
        const unsigned lo = (e & 1) ? (a[e >> 1] >> 16) : (a[e >> 1] & 0xffffu);
        const unsigned hi = (e & 1) ? (c[e >> 1] & 0xffff0000u) : (c[e >> 1] << 16);
        *(unsigned*)(d + e * PITCH) = lo | hi; } }
  }
};
struct LdLN {
  static constexpr int NR = 1;
  struct Regs { uint4 v[1]; };
  const u16* base; const float* g;
  DI Regs fetch(int kt, int tid) const { Regs r; int id = tid; int nc = id & 7, k = id >> 3;
    r.v[0] = *(const uint4*)(base + (long)(kt * 64 + k) * NP + nc * 8); return r; }
  DI void commit(char* s, const Regs& r, int, int tid) const {
    int id = tid; int nc = id & 7, k = id >> 3;
    float f[8]; unpack8(r.v[0], f);
    float sm = 0.f;
#pragma unroll
    for (int e = 0; e < 8; ++e) sm += f[e];
    sm += __shfl_xor(sm, 1); sm += __shfl_xor(sm, 2); sm += __shfl_xor(sm, 4);
    const float mean = sm * (1.f / 64.f);
    float sq = 0.f;
#pragma unroll
    for (int e = 0; e < 8; ++e) { f[e] -= mean; sq += f[e] * f[e]; }
    sq += __shfl_xor(sq, 1); sq += __shfl_xor(sq, 2); sq += __shfl_xor(sq, 4);
    const float rs = rsqrtf(sq * (1.f / 64.f) + EPS);
    const int off = (((k >> 3) ^ (nc & 7)) << 4) + (k & 7) * 2;
    char* d = s + (nc * 8) * PITCH + off;
#pragma unroll
    for (int e = 0; e < 8; ++e) *(u16*)(d + e * PITCH) = f2bf(f[e] * rs * g[nc * 8 + e]);
  }
};

template <int WM, int WN, bool SWAP, bool SWZB>
DI void gemm_compute(f32x16 (&acc)[WM][WN], const char* a_s, const char* b_s, int brow0, int h) {
#pragma unroll
  for (int ks = 0; ks < 4; ++ks) {
    bf16x8 af[WM], bfr[WN];
#pragma unroll
    for (int i = 0; i < WM; ++i) af[i] = *(const bf16x8*)(a_s + i * 32 * PITCH + (ks * 2 + h) * 16);
#pragma unroll
    for (int j = 0; j < WN; ++j) {
      const int row = brow0 + j * 32;
      const int ch = SWZB ? ((ks * 2 + h) ^ ((row >> 3) & 7)) : (ks * 2 + h);
      bfr[j] = *(const bf16x8*)(b_s + j * 32 * PITCH + ch * 16);
    }
#pragma unroll
    for (int i = 0; i < WM; ++i)
#pragma unroll
      for (int j = 0; j < WN; ++j)
        acc[i][j] = SWAP ? mfma(bfr[j], af[i], acc[i][j]) : mfma(af[i], bfr[j], acc[i][j]);
  }
#pragma unroll
  for (int q = 0; q < 4 * WM * WN; ++q) {
    __builtin_amdgcn_sched_group_barrier(0x100, 1, 0);
    __builtin_amdgcn_sched_group_barrier(0x008, 1, 0);
  }
}
struct LdLN4 {
  static constexpr int NR = 4;
  struct Regs { uint4 v[4]; };
  const u16* base; const float* g;
  DI Regs fetch(int kt, int tid) const { Regs r;
    const int nc = tid & 7, kq = (tid >> 3) & 15, ci = tid >> 7;
#pragma unroll
    for (int j = 0; j < 4; ++j) r.v[j] = *(const uint4*)(base + (long)(ci * 128 + kt * 64 + 4 * kq + j) * NP + nc * 8);
    return r; }
  DI void commit(char* s, const Regs& r, int, int tid) const {
    const int nc = tid & 7, kq = (tid >> 3) & 15, ci = tid >> 7;
    float gg[8];
#pragma unroll
    for (int e = 0; e < 8; ++e) gg[e] = g[nc * 8 + e];
    float f[4][8];
#pragma unroll
    for (int j = 0; j < 4; ++j) {
      unpack8(r.v[j], f[j]);
      float sm = 0.f;
#pragma unroll
      for (int e = 0; e < 8; ++e) sm += f[j][e];
      sm += __shfl_xor(sm, 1); sm += __shfl_xor(sm, 2); sm += __shfl_xor(sm, 4);
      const float mean = sm * (1.f / 64.f);
      float sq = 0.f;
#pragma unroll
      for (int e = 0; e < 8; ++e) { f[j][e] -= mean; sq += f[j][e] * f[j][e]; }
      sq += __shfl_xor(sq, 1); sq += __shfl_xor(sq, 2); sq += __shfl_xor(sq, 4);
      const float rs = rsqrtf(sq * (1.f / 64.f) + EPS);
#pragma unroll
      for (int e = 0; e < 8; ++e) f[j][e] *= rs * gg[e];
    }
    const int k = 4 * kq;
    const int off = (((k >> 3) ^ (nc & 7)) << 4) + (k & 7) * 2;
    char* d = s + (ci * 64 + nc * 8) * PITCH + off;
#pragma unroll
    for (int e = 0; e < 8; ++e) { uint2 o; o.x = pk2(f[0][e], f[1][e]); o.y = pk2(f[2][e], f[3][e]); *(uint2*)(d + e * PITCH) = o; }
  }
};
template <class LA, class LB> struct GemmPre { typename LA::Regs a0, a1; typename LB::Regs b0, b1; };
template <class LA, class LB>
DI GemmPre<LA, LB> gemm_prefetch(const LA& la, const LB& lb, int nkt) {
  const int tid = ltid();
  GemmPre<LA, LB> pre;
  const int k1 = nkt > 1 ? 1 : 0;
  pre.a0 = la.fetch(0, tid); pre.b0 = lb.fetch(0, tid);
  pre.a1 = la.fetch(k1, tid); pre.b1 = lb.fetch(k1, tid);
  return pre;
}
template <int WGM, int WM, int WN, bool SWAP, bool SWZB, class LA, class LB, class EPI>
DI GemmPre<LA, LB> gemm_tile(const LA& la, const LB& lb, const EPI& epi, int nkt, char* lds, const GemmPre<LA, LB>& pre, const LA& lan, const LB& lbn) {
  constexpr int WGN = 8 / WGM;
  constexpr int BM = WGM * WM * 32, BN = WGN * WN * 32;
  constexpr int ASZ = BM * PITCH, BSZ = BN * PITCH;
  char* As = lds; char* Bs = lds + 2 * ASZ;
  const int tid = ltid(), w = tid >> 6, lane = tid & 63, r = lane & 31, h = lane >> 5;
  const int wm = w / WGN, wn = w % WGN;
  f32x16 acc[WM][WN];
#pragma unroll
  for (int i = 0; i < WM; ++i)
#pragma unroll
    for (int j = 0; j < WN; ++j)
#pragma unroll
      for (int e = 0; e < 16; ++e) acc[i][j][e] = 0.f;
  typename LA::Regs ra0 = pre.a0, ra1 = pre.a1; typename LB::Regs rb0 = pre.b0, rb1 = pre.b1;
  la.commit(As, ra0, 0, tid); lb.commit(Bs, rb0, 0, tid);
  __syncthreads();
  const int a_off = (wm * WM * 32 + r) * PITCH, b_off = (wn * WN * 32 + r) * PITCH;
  const int k1n = nkt > 1 ? 1 : 0;
#define GEMM_COMPUTE(cur) gemm_compute<WM, WN, SWAP, SWZB>(acc, As + (cur) * ASZ + a_off, Bs + (cur) * BSZ + b_off, wn * WN * 32 + r, h)
  if (nkt == 1) {
    ra0 = lan.fetch(0, tid); rb0 = lbn.fetch(0, tid);
    GEMM_COMPUTE(0);
    ra1 = ra0; rb1 = rb0;
    __syncthreads();
  } else {
    for (int kt = 0; kt < nkt; kt += 2) {
      const bool more = kt + 2 < nkt;
      if (more) { ra0 = la.fetch(kt + 2, tid); rb0 = lb.fetch(kt + 2, tid); }
      else      { ra0 = lan.fetch(0, tid);     rb0 = lbn.fetch(0, tid); }
      GEMM_COMPUTE(0);
      la.commit(As + ASZ, ra1, kt + 1, tid); lb.commit(Bs + BSZ, rb1, kt + 1, tid);
      __syncthreads();
      if (more) { ra1 = la.fetch(kt + 3, tid); rb1 = lb.fetch(kt + 3, tid); }
      else      { ra1 = lan.fetch(k1n, tid);   rb1 = lbn.fetch(k1n, tid); }
      GEMM_COMPUTE(1);
      if (more) { la.commit(As, ra0, kt + 2, tid); lb.commit(Bs, rb0, kt + 2, tid); }
      __syncthreads();
    }
  }
#undef GEMM_COMPUTE
  epi(acc, wm * WM * 32, wn * WN * 32, r, h);
  GemmPre<LA, LB> nx; nx.a0 = ra0; nx.a1 = ra1; nx.b0 = rb0; nx.b1 = rb1;
  return nx;
}
template <int WGM, int WM, int WN, bool SWAP, bool SWZB, class LA, class LB, class MKL, class SET, class EPI>
DI void gemm_loop(int first, int count, int step, const MKL& mkl, const SET& set, const EPI& epi, int nkt, char* lds) {
  if (first >= count) return;
  LA la; LB lb; mkl(first, la, lb);
  GemmPre<LA, LB> pre = gemm_prefetch(la, lb, nkt);
  for (int idx = first; idx < count; idx += step) {
    const int nx = (idx + step < count) ? idx + step : idx;
    LA lan; LB lbn; mkl(nx, lan, lbn);
    set(idx);
    pre = gemm_tile<WGM, WM, WN, SWAP, SWZB>(la, lb, epi, nkt, lds, pre, lan, lbn);
    la = lan; lb = lbn;
  }
}

template <class LA, class LB> struct GemmPre3 { typename LA::Regs a[3]; typename LB::Regs b[3]; };
template <int NKT, int WGM, int WM, int WN, bool SWAP, bool SWZB, class LA, class LB, class MKL, class SET, class EPI>
DI void gemm_loop3(int first, int count, int step, const MKL& mkl, const SET& set, const EPI& epi, char* lds) {
  static_assert(NKT >= 4, "needs at least 4 k-slabs");
  constexpr int WGN = 8 / WGM;
  constexpr int BM = WGM * WM * 32, BN = WGN * WN * 32;
  constexpr int ASZ = BM * PITCH, BSZ = BN * PITCH;
  if (first >= count) return;
  char* As = lds; char* Bs = lds + 2 * ASZ;
  LA la; LB lb; mkl(first, la, lb);
  typename LA::Regs ra0, ra1, ra2; typename LB::Regs rb0, rb1, rb2;
  { const int tid = ltid();
    ra0 = la.fetch(0, tid); rb0 = lb.fetch(0, tid); ra1 = la.fetch(1, tid); rb1 = lb.fetch(1, tid); ra2 = la.fetch(2, tid); rb2 = lb.fetch(2, tid); }
  for (int idx = first; idx < count; idx += step) {
    const int nx = (idx + step < count) ? idx + step : idx;
    LA lan; LB lbn; mkl(nx, lan, lbn);
    set(idx);
    const int tid = ltid(), w = tid >> 6, lane = tid & 63, r = lane & 31, h = lane >> 5;
    const int wm = w / WGN, wn = w % WGN;
    f32x16 acc[WM][WN];
#pragma unroll
    for (int i = 0; i < WM; ++i)
#pragma unroll
      for (int j = 0; j < WN; ++j)
#pragma unroll
        for (int e = 0; e < 16; ++e) acc[i][j][e] = 0.f;
    la.commit(As, ra0, 0, tid); lb.commit(Bs, rb0, 0, tid);
    __syncthreads();
    const int a_off = (wm * WM * 32 + r) * PITCH, b_off = (wn * WN * 32 + r) * PITCH;
#define G3_FETCH(RA, RB, kk) do { if ((kk) < NKT) { RA = la.fetch((kk), tid); RB = lb.fetch((kk), tid); } else { RA = lan.fetch((kk) - NKT, tid); RB = lbn.fetch((kk) - NKT, tid); } } while (0)
#define G3_TRIP(kt, RA, RB, RAn, RBn) do { \
      G3_FETCH(RA, RB, (kt) + 3); \
      gemm_compute<WM, WN, SWAP, SWZB>(acc, As + ((kt) & 1) * ASZ + a_off, Bs + ((kt) & 1) * BSZ + b_off, wn * WN * 32 + r, h); \
      if ((kt) + 1 < NKT) { la.commit(As + (((kt) + 1) & 1) * ASZ, RAn, (kt) + 1, tid); lb.commit(Bs + (((kt) + 1) & 1) * BSZ, RBn, (kt) + 1, tid); } \
      __syncthreads(); } while (0)
#pragma unroll
    for (int k3 = 0; k3 < NKT; k3 += 3) {
      G3_TRIP(k3, ra0, rb0, ra1, rb1);
      if (k3 + 1 < NKT) G3_TRIP(k3 + 1, ra1, rb1, ra2, rb2);
      if (k3 + 2 < NKT) G3_TRIP(k3 + 2, ra2, rb2, ra0, rb0);
    }
#undef G3_TRIP
#undef G3_FETCH
    epi(acc, wm * WM * 32, wn * WN * 32, r, h);
    if (NKT % 3 == 1) { typename LA::Regs ta = ra0; typename LB::Regs tb = rb0; ra0 = ra1; rb0 = rb1; ra1 = ra2; rb1 = rb2; ra2 = ta; rb2 = tb; }
    if (NKT % 3 == 2) { typename LA::Regs ta = ra2; typename LB::Regs tb = rb2; ra2 = ra1; rb2 = rb1; ra1 = ra0; rb1 = rb0; ra0 = ta; rb0 = tb; }
    la = lan; lb = lbn;
  }
}

DI void transpose_cvt_tile(const float* src, u16* dst, int K, int N, int kt, int nt, int remap, float* tile, const float* kgain = nullptr) {
  const int tid = ltid();
#pragma unroll
  for (int i = 0; i < 8; ++i) {
    const int kk = i * 8 + (tid >> 6), nn = tid & 63;
    const int n = nt * 64 + nn;
    tile[kk * 65 + nn] = (n < N) ? src[(long)(kt * 64 + kk) * N + n] * (kgain ? kgain[kt * 64 + kk] : 1.f) : 0.f;
  }
  __syncthreads();
  {
    const int nl = tid >> 3, kc = (tid & 7) * 8;
    const int n = nt * 64 + nl;
    if (n < N) {
      int dn = n;
      if (remap) { const int hh = n >> 7, dd = n & 127; dn = (dd < 64) ? (hh * 64 + dd) : (512 + hh * 64 + dd - 64); }
      uint4 o;
      o.x = pk2(tile[(kc + 0) * 65 + nl], tile[(kc + 1) * 65 + nl]);
      o.y = pk2(tile[(kc + 2) * 65 + nl], tile[(kc + 3) * 65 + nl]);
      o.z = pk2(tile[(kc + 4) * 65 + nl], tile[(kc + 5) * 65 + nl]);
      o.w = pk2(tile[(kc + 6) * 65 + nl], tile[(kc + 7) * 65 + nl]);
      *(uint4*)(dst + (long)dn * K + kt * 64 + kc) = o;
    }
  }
  __syncthreads();
}

template <int NQ> struct SgPre { uint4 g[NQ], u[NQ]; };
template <int ROWS, int CH, bool HAS_U>
DI SgPre<ROWS * CH / 64> staged_gate_fetch(int lane, const u16* __restrict__ gate, const u16* __restrict__ uptr, long ldg) {
  constexpr int NQ = ROWS * CH / 64;
  SgPre<NQ> q;
#pragma unroll
  for (int i = 0; i < NQ; ++i) {
    const int id = i * 64 + lane; const int row = id / CH, c = id % CH;
    q.g[i] = *(const uint4*)(gate + (long)row * ldg + c * 8);
    q.u[i] = HAS_U ? *(const uint4*)(uptr + (long)row * ldg + c * 8) : make_uint4(0, 0, 0, 0);
  }
  return q;
}
template <int ROWS, int CH, int SPB, bool HAS_U>
DI void staged_gate_finish(const char* st, int lane, const SgPre<ROWS * CH / 64>& pre, u16* __restrict__ out, long ldo) {
  constexpr int NQ = ROWS * CH / 64;
#pragma unroll
  for (int q = 0; q < NQ; ++q) {
    const int id = q * 64 + lane; const int row = id / CH, c = id % CH;
    const float4 a = *(const float4*)(st + row * SPB + c * 32), b = *(const float4*)(st + row * SPB + c * 32 + 16);
    float g[8]; unpack8(pre.g[q], g);
    float u[8];
    if (HAS_U) unpack8(pre.u[q], u); else {
#pragma unroll
      for (int e = 0; e < 8; ++e) u[e] = 1.f; }
    uint4 o;
    o.x = pk2(a.x * u[0] * silu(g[0]), a.y * u[1] * silu(g[1])); o.y = pk2(a.z * u[2] * silu(g[2]), a.w * u[3] * silu(g[3]));
    o.z = pk2(b.x * u[4] * silu(g[4]), b.y * u[5] * silu(g[5])); o.w = pk2(b.z * u[6] * silu(g[6]), b.w * u[7] * silu(g[7]));
    *(uint4*)(out + (long)row * ldo + c * 8) = o;
  }
}
template <int ROWS, int CH, int SPB, bool HAS_U>
DI void staged_gate_store(const char* st, int lane, const u16* __restrict__ gate, const u16* __restrict__ uptr, long ldg, u16* __restrict__ out, long ldo) {
  const SgPre<ROWS * CH / 64> pre = staged_gate_fetch<ROWS, CH, HAS_U>(lane, gate, uptr, ldg);
  staged_gate_finish<ROWS, CH, SPB, HAS_U>(st, lane, pre, out, ldo);
}

constexpr int AT_KP = 208, AT_KSZ = 64 * AT_KP, AT_VP = 144, AT_VSZ = 64 * AT_VP;
DI void attn_qk(f32x16& p0, f32x16& p1, const char* ks, const bf16x8 (&qf)[6], int r, int h, float negB) {
#pragma unroll
  for (int e = 0; e < 16; ++e) { p0[e] = negB; p1[e] = negB; }
#pragma unroll
  for (int s = 0; s < 6; ++s) {
    const bf16x8 k0 = *(const bf16x8*)(ks + r * AT_KP + (2 * s + h) * 16);
    const bf16x8 k1 = *(const bf16x8*)(ks + (32 + r) * AT_KP + (2 * s + h) * 16);
    p0 = mfma(k0, qf[s], p0); p1 = mfma(k1, qf[s], p1);
  }
}
DI void attn_pv(f32x16& o0, f32x16& o1, const f32x16& p0, const f32x16& p1, const char* vs, int r, int h) {
#pragma unroll
  for (int kb = 0; kb < 2; ++kb) {
#pragma unroll
    for (int sp = 0; sp < 2; ++sp) {
      uint4 pw;
      if (kb == 0) { pw.x = pk2(p0[8 * sp + 0], p0[8 * sp + 1]); pw.y = pk2(p0[8 * sp + 2], p0[8 * sp + 3]);
                     pw.z = pk2(p0[8 * sp + 4], p0[8 * sp + 5]); pw.w = pk2(p0[8 * sp + 6], p0[8 * sp + 7]); }
      else         { pw.x = pk2(p1[8 * sp + 0], p1[8 * sp + 1]); pw.y = pk2(p1[8 * sp + 2], p1[8 * sp + 3]);
                     pw.z = pk2(p1[8 * sp + 4], p1[8 * sp + 5]); pw.w = pk2(p1[8 * sp + 6], p1[8 * sp + 7]); }
      const bf16x8 pf = __builtin_bit_cast(bf16x8, pw);
      const int keyoff = 32 * kb + 16 * sp + 4 * h;
      {
        const char* vr = vs + r * AT_VP + ((keyoff * 2) ^ ((r & 16) >> 1));
        const uint2 lo = *(const uint2*)vr, hi = *(const uint2*)(vr + 16);
        uint4 a4 = make_uint4(lo.x, lo.y, hi.x, hi.y);
        o0 = mfma(__builtin_bit_cast(bf16x8, a4), pf, o0);
      }
      {
        const char* vr = vs + (32 + r) * AT_VP + ((keyoff * 2) ^ ((r & 16) >> 1));
        const uint2 lo = *(const uint2*)vr, hi = *(const uint2*)(vr + 16);
        uint4 a4 = make_uint4(lo.x, lo.y, hi.x, hi.y);
        o1 = mfma(__builtin_bit_cast(bf16x8, a4), pf, o1);
      }
    }
  }
}
DI void attn_item(const u16* __restrict__ Qp, const u16* __restrict__ Kp, const u16* __restrict__ VTp, int q0, int nkeys,
                  const u16* __restrict__ gatep, u16* __restrict__ mixp, float negB, char* lds) {
  const int tid = ltid(), w = tid >> 6, lane = tid & 63, r = lane & 31, h = lane >> 5;
  char* Kb0 = lds; char* Vb0 = lds + 2 * AT_KSZ;
  bf16x8 qf[6];
  {
    const u16* qrow = Qp + (long)(q0 + w * 32 + r) * 96 + h * 8;
#pragma unroll
    for (int s = 0; s < 6; ++s) qf[s] = *(const bf16x8*)(qrow + s * 16);
  }
  f32x16 o0, o1;
#pragma unroll
  for (int e = 0; e < 16; ++e) { o0[e] = 0.f; o1[e] = 0.f; }
  float lsum = 0.f;
  const int NT = nkeys >> 6;
  uint4 rkA0, rkA1, rvA, rkB0, rkB1, rvB;
  rkA1 = make_uint4(0, 0, 0, 0); rkB1 = make_uint4(0, 0, 0, 0);
  const int krow0 = tid / 12, kc0 = tid % 12, krow1 = (tid + 512) / 12, kc1 = (tid + 512) % 12;
  const int vrow = tid >> 3, vc = tid & 7;
  const bool klo = tid < 256;
#define AT_FETCH_K(S, t) do { const u16* kt_ = Kp + (long)(t) * 64 * 96; rk##S##0 = *(const uint4*)(kt_ + tid * 8); \
    if (klo) rk##S##1 = *(const uint4*)(kt_ + (tid + 512) * 8); } while (0)
#define AT_FETCH_V(S, t) do { rv##S = *(const uint4*)(VTp + (long)vrow * KPOS + (t) * 64 + vc * 8); } while (0)
#define AT_COMMIT_K(S, buf) do { char* ks_ = Kb0 + (buf) * AT_KSZ; *(uint4*)(ks_ + krow0 * AT_KP + kc0 * 16) = rk##S##0; \
    if (klo) *(uint4*)(ks_ + krow1 * AT_KP + kc1 * 16) = rk##S##1; } while (0)
#define AT_COMMIT_V(S, buf) do { *(uint4*)(Vb0 + (buf) * AT_VSZ + vrow * AT_VP + vc * 16) = (vrow & 16) ? make_uint4(rv##S.z, rv##S.w, rv##S.x, rv##S.y) : rv##S; } while (0)
#define AT_TRIP(t, FS, CS) do { \
    { const int tk_ = ((t) + 3 < NT) ? (t) + 3 : NT - 1, tv_ = ((t) + 2 < NT) ? (t) + 2 : NT - 1; AT_FETCH_K(FS, tk_); AT_FETCH_V(FS, tv_); } \
    f32x16 n0, n1; \
    attn_qk(n0, n1, Kb0 + (((t) + 1) & 1) * AT_KSZ, qf, r, h, negB); \
    const char* vs = Vb0 + ((t) & 1) * AT_VSZ; \
    float rs = 0.f; \
    _Pragma("unroll") for (int e = 0; e < 16; ++e) { p0[e] = __builtin_amdgcn_exp2f(p0[e]); rs += p0[e]; } \
    _Pragma("unroll") for (int e = 0; e < 16; ++e) { p1[e] = __builtin_amdgcn_exp2f(p1[e]); rs += p1[e]; } \
    lsum += rs; \
    attn_pv(o0, o1, p0, p1, vs, r, h); \
    AT_COMMIT_K(CS, (t) & 1); AT_COMMIT_V(CS, ((t) + 1) & 1); \
    __syncthreads(); \
    p0 = n0; p1 = n1; } while (0)
  AT_FETCH_K(A, 0); AT_FETCH_V(A, 0); AT_FETCH_K(B, 1);
  AT_COMMIT_K(A, 0); AT_COMMIT_V(A, 0); AT_COMMIT_K(B, 1);
  AT_FETCH_K(B, 2); AT_FETCH_V(B, 1);
  __syncthreads();
  f32x16 p0, p1;
  attn_qk(p0, p1, Kb0, qf, r, h, negB);
  for (int t = 0; t < NT; t += 2) {
    AT_TRIP(t, A, B);
    AT_TRIP(t + 1, B, A);
  }
#undef AT_TRIP
#undef AT_FETCH_K
#undef AT_FETCH_V
#undef AT_COMMIT_K
#undef AT_COMMIT_V
  lsum += __shfl_xor(lsum, 32);
  const float inv = 1.f / lsum;
  char* stg = lds + w * (32 * 272);
#pragma unroll
  for (int db = 0; db < 2; ++db)
#pragma unroll
    for (int g4 = 0; g4 < 4; ++g4) {
      const int dv = db * 32 + 8 * g4 + 4 * h;
      float4 v;
      if (db == 0) v = make_float4(o0[4 * g4] * inv, o0[4 * g4 + 1] * inv, o0[4 * g4 + 2] * inv, o0[4 * g4 + 3] * inv);
      else         v = make_float4(o1[4 * g4] * inv, o1[4 * g4 + 1] * inv, o1[4 * g4 + 2] * inv, o1[4 * g4 + 3] * inv);
      *(float4*)(stg + r * 272 + dv * 4) = v;
    }
  __syncthreads();
  staged_gate_store<32, 8, 272, false>(stg, lane, gatep + (long)(w * 32) * NP, nullptr, NP, mixp + (long)(w * 32) * 1024, 1024);
  __syncthreads();
}

DI void attn_item64(const u16* __restrict__ Qp, const u16* __restrict__ Kp, const u16* __restrict__ VTp, int q0, int nkeys,
                    const u16* __restrict__ gatep, u16* __restrict__ mixp, char* lds) {
  const int tid = ltid(), w = tid >> 6, lane = tid & 63, r = lane & 31, h = lane >> 5;
  char* Kb0 = lds; char* Vb0 = lds + 2 * AT_KSZ;
  char* qbl = lds + 2 * AT_KSZ + 2 * AT_VSZ + w * (32 * AT_KP) + r * AT_KP + h * 16;
  bf16x8 qa[6];
  {
    const u16* qrow = Qp + (long)(q0 + w * 64 + r) * 96 + h * 8;
#pragma unroll
    for (int s = 0; s < 6; ++s) { qa[s] = *(const bf16x8*)(qrow + s * 16); *(bf16x8*)(qbl + s * 32) = *(const bf16x8*)(qrow + 32 * 96 + s * 16); }
  }
  f32x16 oa0, oa1, ob0, ob1;
#pragma unroll
  for (int e = 0; e < 16; ++e) { oa0[e] = 0.f; oa1[e] = 0.f; ob0[e] = 0.f; ob1[e] = 0.f; }
  float lsa = 0.f, lsb = 0.f;
  const int NT = nkeys >> 6;
  uint2 rkA0, rkA1, rkA2, rkB0, rkB1, rkB2; uint4 rvA, rvB;
  const int kso = (tid >> 3) * AT_KP + (tid & 7) * 24;
  const int vrow = tid >> 3, vc = tid & 7;
#define AT_FETCH_K(S, t) do { const uint2* kt_ = (const uint2*)(Kp + (long)(t) * 64 * 96) + tid * 3; rk##S##0 = kt_[0]; rk##S##1 = kt_[1]; rk##S##2 = kt_[2]; } while (0)
#define AT_FETCH_V(S, t) do { rv##S = *(const uint4*)(VTp + (long)vrow * KPOS + (t) * 64 + vc * 8); } while (0)
#define AT_COMMIT_K(S, buf) do { char* ks_ = Kb0 + (buf) * AT_KSZ + kso; *(uint2*)ks_ = rk##S##0; *(uint2*)(ks_ + 8) = rk##S##1; *(uint2*)(ks_ + 16) = rk##S##2; } while (0)
#define AT_COMMIT_V(S, buf) do { *(uint4*)(Vb0 + (buf) * AT_VSZ + vrow * AT_VP + vc * 16) = (vrow & 16) ? make_uint4(rv##S.z, rv##S.w, rv##S.x, rv##S.y) : rv##S; } while (0)
#define AT_QK_HALF(sa, sb, ks, kb) do { \
    _Pragma("unroll") for (int e = 0; e < 16; ++e) { sa[e] = 0.f; sb[e] = 0.f; } \
    _Pragma("unroll") for (int s_ = 0; s_ < 6; ++s_) { \
      const bf16x8 kf_ = *(const bf16x8*)((ks) + ((kb) * 32 + r) * AT_KP + (2 * s_ + h) * 16); \
      const bf16x8 qf_ = *(const bf16x8*)(qbl + s_ * 32); \
      sa = mfma(kf_, qa[s_], sa); sb = mfma(kf_, qf_, sb); } } while (0)
#define AT_EXP(sx, ls) do { float rs_ = 0.f; \
    _Pragma("unroll") for (int e = 0; e < 16; ++e) { sx[e] = __builtin_amdgcn_exp2f(sx[e]); rs_ += sx[e]; } ls += rs_; } while (0)
#define AT_PV_HALF(pa, pb, vs, kb) do { \
    _Pragma("unroll") for (int sp_ = 0; sp_ < 2; ++sp_) { \
      uint4 wa_, wb_; \
      wa_.x = pk2(pa[8 * sp_ + 0], pa[8 * sp_ + 1]); wa_.y = pk2(pa[8 * sp_ + 2], pa[8 * sp_ + 3]); \
      wa_.z = pk2(pa[8 * sp_ + 4], pa[8 * sp_ + 5]); wa_.w = pk2(pa[8 * sp_ + 6], pa[8 * sp_ + 7]); \
      wb_.x = pk2(pb[8 * sp_ + 0], pb[8 * sp_ + 1]); wb_.y = pk2(pb[8 * sp_ + 2], pb[8 * sp_ + 3]); \
      wb_.z = pk2(pb[8 * sp_ + 4], pb[8 * sp_ + 5]); wb_.w = pk2(pb[8 * sp_ + 6], pb[8 * sp_ + 7]); \
      const bf16x8 fa_ = __builtin_bit_cast(bf16x8, wa_), fb_ = __builtin_bit_cast(bf16x8, wb_); \
      const int keyoff_ = 32 * (kb) + 16 * sp_ + 4 * h; \
      { const char* vr_ = (vs) + r * AT_VP + ((keyoff_ * 2) ^ ((r & 16) >> 1)); \
        const uint2 lo_ = *(const uint2*)vr_, hi_ = *(const uint2*)(vr_ + 16); \
        const bf16x8 vf_ = __builtin_bit_cast(bf16x8, make_uint4(lo_.x, lo_.y, hi_.x, hi_.y)); \
        oa0 = mfma(vf_, fa_, oa0); ob0 = mfma(vf_, fb_, ob0); } \
      { const char* vr_ = (vs) + (32 + r) * AT_VP + ((keyoff_ * 2) ^ ((r & 16) >> 1)); \
        const uint2 lo_ = *(const uint2*)vr_, hi_ = *(const uint2*)(vr_ + 16); \
        const bf16x8 vf_ = __builtin_bit_cast(bf16x8, make_uint4(lo_.x, lo_.y, hi_.x, hi_.y)); \
        oa1 = mfma(vf_, fa_, oa1); ob1 = mfma(vf_, fb_, ob1); } } } while (0)
#define AT_TRIP64(t, FS, CS) do { \
    { const int tn_ = ((t) + 2 < NT) ? (t) + 2 : NT - 1; AT_FETCH_K(FS, tn_); AT_FETCH_V(FS, tn_); } \
    const char* ks = Kb0 + ((t) & 1) * AT_KSZ; const char* vs = Vb0 + ((t) & 1) * AT_VSZ; \
    { f32x16 sa0, sb0; \
      AT_QK_HALF(sa0, sb0, ks, 0); \
      AT_EXP(sa0, lsa); AT_EXP(sb0, lsb); \
      AT_PV_HALF(sa0, sb0, vs, 0); } \
    __builtin_amdgcn_sched_barrier(0); \
    { f32x16 sa1, sb1; \
      AT_QK_HALF(sa1, sb1, ks, 1); \
      AT_EXP(sa1, lsa); AT_EXP(sb1, lsb); \
      AT_PV_HALF(sa1, sb1, vs, 1); } \
    __builtin_amdgcn_sched_barrier(0); \
    AT_COMMIT_K(CS, ((t) + 1) & 1); AT_COMMIT_V(CS, ((t) + 1) & 1); \
    __syncthreads(); } while (0)
  AT_FETCH_K(A, 0); AT_FETCH_V(A, 0);
  AT_COMMIT_K(A, 0); AT_COMMIT_V(A, 0);
  AT_FETCH_K(B, 1); AT_FETCH_V(B, 1);
  __syncthreads();
  for (int t = 0; t < NT; t += 2) {
    AT_TRIP64(t, A, B);
    AT_TRIP64(t + 1, B, A);
  }
#undef AT_TRIP64
#undef AT_PV_HALF
#undef AT_EXP
#undef AT_QK_HALF
#undef AT_FETCH_K
#undef AT_FETCH_V
#undef AT_COMMIT_K
#undef AT_COMMIT_V
  lsa += __shfl_xor(lsa, 32); lsb += __shfl_xor(lsb, 32);
  const float ia = 1.f / lsa, ib = 1.f / lsb;
  char* stg = lds + w * (32 * 272);
#pragma unroll
  for (int blk = 0; blk < 2; ++blk) {
#pragma unroll
    for (int db = 0; db < 2; ++db)
#pragma unroll
      for (int g4 = 0; g4 < 4; ++g4) {
        const int dv = db * 32 + 8 * g4 + 4 * h;
        float4 v;
        if (blk == 0) { if (db == 0) v = make_float4(oa0[4 * g4] * ia, oa0[4 * g4 + 1] * ia, oa0[4 * g4 + 2] * ia, oa0[4 * g4 + 3] * ia);
                        else         v = make_float4(oa1[4 * g4] * ia, oa1[4 * g4 + 1] * ia, oa1[4 * g4 + 2] * ia, oa1[4 * g4 + 3] * ia); }
        else          { if (db == 0) v = make_float4(ob0[4 * g4] * ib, ob0[4 * g4 + 1] * ib, ob0[4 * g4 + 2] * ib, ob0[4 * g4 + 3] * ib);
                        else         v = make_float4(ob1[4 * g4] * ib, ob1[4 * g4 + 1] * ib, ob1[4 * g4 + 2] * ib, ob1[4 * g4 + 3] * ib); }
        *(float4*)(stg + r * 272 + dv * 4) = v;
      }
    const SgPre<4> gpre = staged_gate_fetch<32, 8, false>(lane, gatep + (long)(w * 64 + blk * 32) * NP, nullptr, NP);
    __syncthreads();
    staged_gate_finish<32, 8, 272, false>(stg, lane, gpre, mixp + (long)(w * 64 + blk * 32) * 1024, 1024);
    __syncthreads();
  }
}


__global__ void __launch_bounds__(NT_) fwd_megakernel(Params p) {
  extern __shared__ __attribute__((aligned(16))) char lds[];
  cg::grid_group grid = cg::this_grid();
  const int tid = threadIdx.x, bid = blockIdx.x, nblk = gridDim.x;
  __shared__ uint4 xb_words;
  if (tid == 0) xb_words = make_uint4(0u, 0u, 0u, 0u);
  __syncthreads();
  const XcdBarrier xb = xcd_barrier_post(p.bar, (volatile LAS unsigned*)&xb_words);
  const long gtid = (long)bid * NT_ + tid, gnth = (long)nblk * NT_;

  {
    float* tile = (float*)lds;
    constexpr int T_WIN = 16 * 35, T_WOUT = 16 * 16, T_WUQ = 4 * 12, T_WUKV = 2 * 16;
    constexpr int T_L = T_WIN + T_WOUT + T_WUQ + T_WUKV;
    struct TP { const float* src; u16* dst; const float* kg; int K, N, kt, nt, remap; };
    auto tparams = [&](int it) {
      TP q; const int l = it / T_L; int t = it % T_L;
      if (t < T_WIN) { q.src = p.w_in + (long)l * 1024 * INW; q.dst = p.win_t + (long)l * NP * 1024; q.K = 1024; q.N = INW; q.kt = t / 35; q.nt = t % 35; q.remap = 0; q.kg = nullptr; }
      else if ((t -= T_WIN) < T_WOUT) { q.src = p.w_out + (long)l * 1024 * 1024; q.dst = p.wout_t + (long)l * 1024 * 1024; q.K = 1024; q.N = 1024; q.kt = t / 16; q.nt = t % 16; q.remap = 0; q.kg = nullptr; }
      else if ((t -= T_WOUT) < T_WUQ) { q.src = p.w_uq + (long)l * 256 * 768; q.dst = p.wuq_t + (long)l * 768 * 256; q.K = 256; q.N = 768; q.kt = t / 12; q.nt = t % 12; q.remap = 0; q.kg = p.q_a_g + l * 256; }
      else { t -= T_WUQ; q.src = p.w_ukv + (long)l * 128 * 1024; q.dst = p.wukv_t + (long)l * 1024 * 128; q.K = 128; q.N = 1024; q.kt = t / 16; q.nt = t % 16; q.remap = 1; q.kg = p.kv_a_g + l * 128; }
      return q;
    };
    float pv[8];
    auto tload = [&](const TP& q) {
#pragma unroll
      for (int i = 0; i < 8; ++i) {
        const int kk = i * 8 + (tid >> 6), nn = tid & 63;
        const int n = q.nt * 64 + nn;
        pv[i] = (n < q.N) ? q.src[(long)(q.kt * 64 + kk) * q.N + n] * (q.kg ? q.kg[q.kt * 64 + kk] : 1.f) : 0.f;
      }
    };
    if (bid < T_L * DEPTH) { const TP q0 = tparams(bid); tload(q0); }
    for (int it = bid; it < T_L * DEPTH; it += nblk) {
      const TP q = tparams(it);
#pragma unroll
      for (int i = 0; i < 8; ++i) tile[(i * 8 + (tid >> 6)) * 65 + (tid & 63)] = pv[i];
      __syncthreads();
      if (it + nblk < T_L * DEPTH) { const TP qn = tparams(it + nblk); tload(qn); }
      {
        const int nl = tid >> 3, kc = (tid & 7) * 8;
        const int n = q.nt * 64 + nl;
        if (n < q.N) {
          int dn = n;
          if (q.remap) { const int hh = n >> 7, dd = n & 127; dn = (dd < 64) ? (hh * 64 + dd) : (512 + hh * 64 + dd - 64); }
          uint4 o;
          o.x = pk2(tile[(kc + 0) * 65 + nl], tile[(kc + 1) * 65 + nl]);
          o.y = pk2(tile[(kc + 2) * 65 + nl], tile[(kc + 3) * 65 + nl]);
          o.z = pk2(tile[(kc + 4) * 65 + nl], tile[(kc + 5) * 65 + nl]);
          o.w = pk2(tile[(kc + 6) * 65 + nl], tile[(kc + 7) * 65 + nl]);
          *(uint4*)(q.dst + (long)dn * q.K + q.kt * 64 + kc) = o;
        }
      }
      __syncthreads();
    }
    for (long i = gtid; i < (long)DEPTH * (NP - INW) * 1024; i += gnth) {
      const int l = (int)(i / ((NP - INW) * 1024)); const long rem = i % ((NP - INW) * 1024);
      p.win_t[((long)l * NP + INW) * 1024 + rem] = 0;
    }
    for (long i = gtid; i < (long)DEPTH * 4 * 128 * 128; i += gnth) p.gws_b[i] = f2bf(p.g_ws[i]);
    for (long i = gtid; i < 128 * 64; i += gnth) {
      const int rho = (int)(i >> 6), n1 = (int)(i & 63);
      const int blk = rho >> 5, k1 = (blk >> 1) * 32 + (rho & 31), part = blk & 1;
      const int mm = (k1 * n1) & 63;
      p.t1[i] = f2bf(part == 0 ? cospif(mm * (1.f / 32.f)) : -sinpif(mm * (1.f / 32.f)));
    }
    for (long i = gtid; i < 128 * 128; i += gnth) {
      const int rho = (int)(i >> 7), kk = (int)(i & 127);
      const int rio = rho >> 6, k2 = rho & 63, n2 = kk >> 1, rii = kk & 1;
      const int mm = (n2 * k2) & 63;
      const float c = cospif(mm * (1.f / 32.f)), s = sinpif(mm * (1.f / 32.f));
      p.t2[i] = f2bf(rio == 0 ? (rii == 0 ? c : s) : (rii == 0 ? -s : c));
    }
    for (long i = gtid; i < 512 * 256; i += gnth) {
      const int rho = (int)(i >> 8), n = (int)(i & 255);
      const int ri = rho >> 8, k = rho & 255;
      const int mm = (k * n) & 255;
      p.t256[i] = f2bf(ri == 0 ? cospif(mm * (1.f / 128.f)) : -sinpif(mm * (1.f / 128.f)));
    }
    for (long i = gtid; i < 4096; i += gnth) {
      p.tw[2 * i] = cospif((float)i * (1.f / 2048.f)); p.tw[2 * i + 1] = sinpif((float)i * (1.f / 2048.f));
    }
    for (long i = gtid; i < 64 * 8; i += gnth) {
      const int pos = (int)(i >> 3), jj = (int)(i & 7);
      const float ang = (float)pos * exp2f(-(float)jj * 1.6609640474436813f);
      p.rope[2 * i] = __cosf(ang); p.rope[2 * i + 1] = __sinf(ang);
    }
    for (long i = gtid; i < (long)DEPTH * 256 * 512; i += gnth) {
      const int n = (int)(i & 255), kidx = (int)((i >> 8) & 511), l = (int)(i >> 17);
      const int g = kidx >> 7, j = kidx & 127, jj = j & 63;
      const float* wf = p.w_fmix + (long)l * 256 * 256 + (long)(g * 64) * 256 + n;
      float acc = 0.f;
      for (int c0 = 0; c0 < 64; c0 += 16) {
        float wv[16];
#pragma unroll
        for (int u = 0; u < 16; ++u) wv[u] = wf[(long)(c0 + u) * 256];
#pragma unroll
        for (int u = 0; u < 16; ++u) {
          const int mm = (jj * (c0 + u)) & 63;
          const float coef = (j < 64) ? cospif(mm * (1.f / 32.f)) : sinpif(mm * (1.f / 32.f));
          acc += coef * wv[u];
        }
      }
      p.mf_t[((long)l * 256 + n) * 512 + kidx] = f2bf(acc);
    }
    {
      float* sl = (float*)lds;
      float* red = sl + 9 * 1024;
      __syncthreads();
      for (int i = tid; i < 9 * 1024; i += NT_) {
        const int rr = i >> 10, kk = i & 1023;
        const float v = (rr < 8) ? p.c[rr * 1024 + kk] : p.c_ctx[kk];
        sl[i] = silu(v);
      }
      __syncthreads();
      for (int it = bid; it < DEPTH * 96; it += nblk) {
        const int l = it / 96, cgp = it % 96;
        const int cj = tid & 31, ksl = tid >> 5;
        const float* wm = p.w_mod + (long)l * 1024 * 3072 + cgp * 32 + cj;
        float a[9];
#pragma unroll
        for (int rr = 0; rr < 9; ++rr) a[rr] = 0.f;
        for (int k0 = ksl * 64; k0 < ksl * 64 + 64; k0 += 16) {
          float wv[16];
#pragma unroll
          for (int u = 0; u < 16; ++u) wv[u] = wm[(long)(k0 + u) * 3072];
#pragma unroll
          for (int u = 0; u < 16; ++u)
#pragma unroll
            for (int rr = 0; rr < 9; ++rr) a[rr] += sl[rr * 1024 + k0 + u] * wv[u];
        }
#pragma unroll
        for (int rr = 0; rr < 9; ++rr) red[(ksl * 9 + rr) * 32 + cj] = a[rr];
        __syncthreads();
        if (tid < 288) {
          const int rr = tid >> 5, c2 = tid & 31;
          float s = 0.f;
          for (int q = 0; q < 16; ++q) s += red[(q * 9 + rr) * 32 + c2];
          const int col = cgp * 32 + c2;
          p.mod[((long)l * 9 + rr) * 3072 + col] = s + p.b_mod[l * 3072 + col];
        }
        __syncthreads();
      }
    }
  }
  grid.sync();

  for (int l = 0; l < DEPTH; ++l) {
    const int tid = ltid();
    const float* modl = p.mod + (long)l * 9 * 3072;
    {
      const float* ng = p.norm_g + l * 1024;
      const int lane = tid & 63, wv = tid >> 6;
      float4 g4[4];
#pragma unroll
      for (int i = 0; i < 4; ++i) g4[i] = *(const float4*)(ng + i * 256 + lane * 4);
      const int rstep = nblk * 8;
      float4 v[4], sh[4], sc[4];
#define N_LOAD(row_, vv, shh, scc) do { \
        const int rw_ = (row_) < MT ? (row_) : MT - 1; \
        const float* src_; int mr_; \
        if (rw_ < MX) { src_ = (l == 0 ? p.x : p.out) + (long)rw_ * 1024; mr_ = rw_ >> 12; } \
        else { src_ = (l == 0 ? p.ctx : p.yw) + (long)(rw_ - MX) * 1024; mr_ = 8; } \
        const float* md_ = modl + mr_ * 3072; \
        _Pragma("unroll") for (int i = 0; i < 4; ++i) { const int k0_ = i * 256 + lane * 4; \
          vv[i] = *(const float4*)(src_ + k0_); shh[i] = *(const float4*)(md_ + k0_); scc[i] = *(const float4*)(md_ + 1024 + k0_); } } while (0)
      int row = bid * 8 + wv;
      N_LOAD(row, v, sh, sc);
      for (; row < MT; row += rstep) {
        float4 vn[4], shn[4], scn[4];
        N_LOAD(row + rstep, vn, shn, scn);
        float ss = 0.f;
#pragma unroll
        for (int i = 0; i < 4; ++i) ss += v[i].x * v[i].x + v[i].y * v[i].y + v[i].z * v[i].z + v[i].w * v[i].w;
#pragma unroll
        for (int o = 1; o < 64; o <<= 1) ss += __shfl_xor(ss, o);
        const float rs = rsqrtf(ss * (1.f / 1024.f) + EPS);
#pragma unroll
        for (int i = 0; i < 4; ++i) {
          const int k0 = i * 256 + lane * 4;
          uint2 o;
          o.x = pk2(v[i].x * rs * g4[i].x * (1.f + sc[i].x) + sh[i].x, v[i].y * rs * g4[i].y * (1.f + sc[i].y) + sh[i].y);
          o.y = pk2(v[i].z * rs * g4[i].z * (1.f + sc[i].z) + sh[i].z, v[i].w * rs * g4[i].w * (1.f + sc[i].w) + sh[i].w);
          *(uint2*)(p.hmix + (long)row * 1024 + k0) = o;
        }
#pragma unroll
        for (int i = 0; i < 4; ++i) { v[i] = vn[i]; sh[i] = shn[i]; sc[i] = scn[i]; }
      }
#undef N_LOAD
    }
    xcd_barrier(xb);

    {
      const u16* wt = p.win_t + (long)l * NP * 1024;
      u16* P = p.p;
      int m0 = 0, n0 = 0;
      auto epi = [&](auto& acc, int mw, int nw, int r, int h) {
        constexpr int WM_ = sizeof(acc) / sizeof(acc[0]), WN_ = sizeof(acc[0]) / sizeof(acc[0][0]);
        constexpr int SP = WN_ * 64 + 16;
        constexpr int CH = WN_ * 4;
        const int wv = ltid() >> 6, lane = h * 32 + r;
        char* st = lds + wv * (WM_ * 32 * SP);
        if (n0 + nw >= C_CQ && n0 + nw < C_KROPE) {
#pragma unroll
          for (int i = 0; i < WM_; ++i)
#pragma unroll
            for (int j = 0; j < WN_; ++j) {
              float ss = 0.f;
#pragma unroll
              for (int e = 0; e < 16; ++e) ss += acc[i][j][e] * acc[i][j][e];
              ss += __shfl_xor(ss, 32);
              if (h == 0) p.stats[(long)(m0 + mw + i * 32 + r) * 16 + ((n0 + nw + j * 32 - C_CQ) >> 5)] = ss;
            }
        }
#pragma unroll
        for (int i = 0; i < WM_; ++i)
#pragma unroll
          for (int j = 0; j < WN_; ++j)
#pragma unroll
            for (int g4 = 0; g4 < 4; ++g4) {
              uint2 o;
              o.x = pk2(acc[i][j][4 * g4], acc[i][j][4 * g4 + 1]); o.y = pk2(acc[i][j][4 * g4 + 2], acc[i][j][4 * g4 + 3]);
              *(uint2*)(st + (i * 32 + r) * SP + (j * 32 + 8 * g4 + 4 * h) * 2) = o;
            }
        __syncthreads();
#pragma unroll
        for (int q = 0; q < WM_ * 32 * CH / 64; ++q) {
          const int id = q * 64 + lane; const int row = id / CH, c = id % CH;
          const uint4 v = *(const uint4*)(st + row * SP + c * 16);
          *(uint4*)(P + (long)(m0 + mw + row) * NP + n0 + nw + c * 8) = v;
        }
        __syncthreads();
      };
      {
        auto mkl = [&](int j, LdDirect<256>& la, LdDirect<128>& lb) {
          const int mt = (j / 18) * 8 + (bid & 7), nt = j % 18;
          la.base = p.hmix + (long)mt * 256 * 1024; la.ld = 1024; lb.base = wt + (long)nt * 128 * 1024; lb.ld = 1024; };
        auto set = [&](int j) { m0 = ((j / 18) * 8 + (bid & 7)) * 256; n0 = (j % 18) * 128; };
        gemm_loop3<16, 4, 2, 2, true, false, LdDirect<256>, LdDirect<128>>(bid >> 3, 16 * 18, nblk >> 3, mkl, set, epi, lds);
      }
      {
        const int nty = (l == DEPTH - 1) ? 3 : 36, nt0 = (l == DEPTH - 1) ? 24 : 0;
        auto mkl = [&](int it, LdDirect<128>& la, LdDirect<64>& lb) {
          const int mt = it / nty, nt = nt0 + it % nty;
          la.base = p.hmix + (long)(MX + mt * 128) * 1024; la.ld = 1024; lb.base = wt + (long)nt * 64 * 1024; lb.ld = 1024; };
        auto set = [&](int it) { m0 = MX + (it / nty) * 128; n0 = (nt0 + it % nty) * 64; };
        gemm_loop<4, 1, 1, true, false, LdDirect<128>, LdDirect<64>>(bid, 16 * nty, nblk, mkl, set, epi, 16, lds);
      }
    }
    xcd_barrier(xb);

    {
      constexpr int nKN = 136 * 4, nV = 136 * 4, nF1 = 1024;
      const int nQ = (l == DEPTH - 1) ? 256 * 4 : 272 * 4, nFy = (l == DEPTH - 1) ? 0 : 64, nG = (l == DEPTH - 1) ? 256 : 272;
      float* rstd_s = (float*)(lds + RSTD_OFF);
#define FIRST(off) ((bid + nblk - ((off) % nblk)) % nblk)
      {
        int m0 = 0, n0 = 0;
        auto mkl = [&](int it, LdDirect<128>& la, LdDirect<192>& lb) {
          const int mt = it >> 2, nt = it & 3;
          la.base = p.p + (long)mt * 128 * NP + C_CQ; la.ld = NP;
          lb.base = p.wuq_t + ((long)l * 768 + nt * 192) * 256; lb.ld = 256; };
        auto set = [&](int it) { m0 = (it >> 2) * 128; n0 = (it & 3) * 192; };
        const float* qg = p.q_norm_g + l * 96;
        u16* Qb = p.q; const float* ROPE = p.rope;
        auto epi = [&](f32x16 (&acc)[1][3], int mw, int nw, int r, int h) {
          const int head = (n0 + nw) / 96;
          const float QS = 0.10206207261596575f * 1.4426950408889634f;
          const int m = m0 + mw + r;
          float ss = 0.f;
#pragma unroll
          for (int j = 0; j < 3; ++j)
#pragma unroll
            for (int e = 0; e < 16; ++e) ss += acc[0][j][e] * acc[0][j][e];
          ss += __shfl_xor(ss, 32);
          const float4 sa = *(const float4*)(p.stats + (long)m * 16), sb = *(const float4*)(p.stats + (long)m * 16 + 4);
          const float msq = (sa.x + sa.y + sa.z + sa.w + sb.x + sb.y + sb.z + sb.w) * (1.f / 256.f) + EPS;
          const float rs = rsqrtf(ss * (1.f / 96.f) + EPS * msq);
          int b, pos; bool isx; int irow = 0, icol = 0;
          if (m < MX) { b = m >> 12; const int n = m & 4095; pos = CTX + n; isx = true; irow = n >> 6; icol = n & 63; }
          else { const int my = m - MX; b = my >> 8; pos = my & 255; isx = false; }
          float2 tr[4], tc[4];
#pragma unroll
          for (int e = 0; e < 4; ++e) { tr[e] = *(const float2*)(ROPE + (irow * 8 + 4 * h + e) * 2); tc[e] = *(const float2*)(ROPE + (icol * 8 + 4 * h + e) * 2); }
          const int wv = ltid() >> 6;
          char* stg = lds + wv * (32 * 208);
          u16* qd = (u16*)(stg + r * 208);
#pragma unroll
          for (int j = 0; j < 2; ++j)
#pragma unroll
            for (int g4 = 0; g4 < 4; ++g4) {
              const int f0 = j * 32 + 8 * g4 + 4 * h;
              const float4 g = *(const float4*)(qg + f0);
              uint2 o;
              o.x = pk2(acc[0][j][4 * g4] * rs * g.x * QS, acc[0][j][4 * g4 + 1] * rs * g.y * QS);
              o.y = pk2(acc[0][j][4 * g4 + 2] * rs * g.z * QS, acc[0][j][4 * g4 + 3] * rs * g.w * QS);
              *(uint2*)(qd + f0) = o;
            }
          float x1[4], x2[4], x3[4], x4[4];
          {
            const float4 g1 = *(const float4*)(qg + 64 + 4 * h), g2 = *(const float4*)(qg + 72 + 4 * h);
            const float4 g3 = *(const float4*)(qg + 80 + 4 * h), g4v = *(const float4*)(qg + 88 + 4 * h);
            const float s = rs * QS;
            x1[0] = acc[0][2][0] * s * g1.x; x1[1] = acc[0][2][1] * s * g1.y; x1[2] = acc[0][2][2] * s * g1.z; x1[3] = acc[0][2][3] * s * g1.w;
            x2[0] = acc[0][2][4] * s * g2.x; x2[1] = acc[0][2][5] * s * g2.y; x2[2] = acc[0][2][6] * s * g2.z; x2[3] = acc[0][2][7] * s * g2.w;
            x3[0] = acc[0][2][8] * s * g3.x; x3[1] = acc[0][2][9] * s * g3.y; x3[2] = acc[0][2][10] * s * g3.z; x3[3] = acc[0][2][11] * s * g3.w;
            x4[0] = acc[0][2][12] * s * g4v.x; x4[1] = acc[0][2][13] * s * g4v.y; x4[2] = acc[0][2][14] * s * g4v.z; x4[3] = acc[0][2][15] * s * g4v.w;
          }
          if (isx) {
#pragma unroll
            for (int e = 0; e < 4; ++e) {
              const float cr = tr[e].x, sr = tr[e].y, cc = tc[e].x, sc = tc[e].y;
              const float a1 = x1[e] * cr - x2[e] * sr, a2 = x2[e] * cr + x1[e] * sr;
              const float a3 = x3[e] * cc - x4[e] * sc, a4 = x4[e] * cc + x3[e] * sc;
              x1[e] = a1; x2[e] = a2; x3[e] = a3; x4[e] = a4;
            }
          }
          uint2 o;
          o.x = pk2(x1[0], x1[1]); o.y = pk2(x1[2], x1[3]); *(uint2*)(qd + 64 + 4 * h) = o;
          o.x = pk2(x2[0], x2[1]); o.y = pk2(x2[2], x2[3]); *(uint2*)(qd + 72 + 4 * h) = o;
          o.x = pk2(x3[0], x3[1]); o.y = pk2(x3[2], x3[3]); *(uint2*)(qd + 80 + 4 * h) = o;
          o.x = pk2(x4[0], x4[1]); o.y = pk2(x4[2], x4[3]); *(uint2*)(qd + 88 + 4 * h) = o;
          __syncthreads();
          {
            const int m_0 = m0 + mw;
            int b0, pos0;
            if (m_0 < MX) { b0 = m_0 >> 12; pos0 = CTX + (m_0 & 4095); } else { const int my = m_0 - MX; b0 = my >> 8; pos0 = my & 255; }
            u16* dst = Qb + ((long)(b0 * 8 + head) * KPOS + pos0) * 96;
            const int lane = h * 32 + r;
#pragma unroll
            for (int q = 0; q < 6; ++q) {
              const int id = q * 64 + lane; const int row = id / 12, c = id % 12;
              *(uint4*)(dst + id * 8) = *(const uint4*)(stg + row * 208 + c * 16);
            }
          }
          __syncthreads();
        };
        gemm_loop<4, 1, 3, true, false, LdDirect<128>, LdDirect<192>>(FIRST(0), nQ, nblk, mkl, set, epi, 4, lds);
      }
      {
        int m0 = 0, n0 = 0;
        auto set = [&](int it) { m0 = (it >> 2) * 256; n0 = (it & 3) * 128; };
        {
          auto mkl = [&](int it, LdDirect<256>& la, LdDirect<128>& lb) {
            const int mt = it >> 2, nt = it & 3;
            la.base = p.p + (long)mt * 256 * NP + C_CKV; la.ld = NP;
            lb.base = p.wukv_t + ((long)l * 1024 + nt * 128) * 128; lb.ld = 128; };
          const float* kg = p.k_norm_g + l * 96;
          u16* Kb = p.k; const u16* P = p.p; const float* ROPE = p.rope;
          auto epi = [&](f32x16 (&acc)[2][2], int mw, int nw, int r, int h) {
            const int head = (n0 + nw) >> 6;
#pragma unroll
            for (int i = 0; i < 2; ++i) {
              const int m = m0 + mw + i * 32 + r;
              float kr[16];
              { const u16* kp = P + (long)m * NP + C_KROPE + 16 * h;
                unpack8(*(const uint4*)kp, kr); unpack8(*(const uint4*)(kp + 8), kr + 8); }
              int b, pos; bool isx; int ipos = 0;
              if (m < MX) { b = m >> 12; const int n = m & 4095; pos = CTX + n; isx = true; ipos = h ? (n & 63) : (n >> 6); }
              else { const int my = m - MX; b = my >> 8; pos = my & 255; isx = false; }
              float2 tr[8];
#pragma unroll
              for (int e = 0; e < 8; ++e) tr[e] = *(const float2*)(ROPE + (ipos * 8 + e) * 2);
              const float4 sk = *(const float4*)(p.stats + (long)m * 16 + 8);
              const float rkv2 = 1.f / ((sk.x + sk.y + sk.z + sk.w) * (1.f / 128.f) + EPS);
              float ssr = 0.f, ssn = 0.f;
#pragma unroll
              for (int e = 0; e < 16; ++e) ssr += kr[e] * kr[e];
#pragma unroll
              for (int j = 0; j < 2; ++j)
#pragma unroll
                for (int e = 0; e < 16; ++e) ssn += acc[i][j][e] * acc[i][j][e];
              float ss = ssr + ssn * rkv2;
              ss += __shfl_xor(ss, 32);
              const float rs = rsqrtf(ss * (1.f / 96.f) + EPS);
              const float rsn = rs * sqrtf(rkv2);
              u16* kd = (u16*)(lds + (ltid() >> 6) * (64 * 208) + (i * 32 + r) * 208);
#pragma unroll
              for (int j = 0; j < 2; ++j)
#pragma unroll
                for (int g4 = 0; g4 < 4; ++g4) {
                  const int f0 = j * 32 + 8 * g4 + 4 * h;
                  const float4 g = *(const float4*)(kg + f0);
                  uint2 o;
                  o.x = pk2(acc[i][j][4 * g4] * rsn * g.x, acc[i][j][4 * g4 + 1] * rsn * g.y);
                  o.y = pk2(acc[i][j][4 * g4 + 2] * rsn * g.z, acc[i][j][4 * g4 + 3] * rsn * g.w);
                  *(uint2*)(kd + f0) = o;
                }
              float oa[8], ob[8];
#pragma unroll
              for (int e = 0; e < 8; ++e) {
                const float xa = kr[e] * rs * kg[64 + 16 * h + e], xb = kr[8 + e] * rs * kg[64 + 16 * h + 8 + e];
                if (isx) { const float cs = tr[e].x, sn = tr[e].y; oa[e] = xa * cs - xb * sn; ob[e] = xb * cs + xa * sn; }
                else { oa[e] = xa; ob[e] = xb; }
              }
              uint4 o;
              o.x = pk2(oa[0], oa[1]); o.y = pk2(oa[2], oa[3]); o.z = pk2(oa[4], oa[5]); o.w = pk2(oa[6], oa[7]);
              *(uint4*)(kd + 64 + 16 * h) = o;
              o.x = pk2(ob[0], ob[1]); o.y = pk2(ob[2], ob[3]); o.z = pk2(ob[4], ob[5]); o.w = pk2(ob[6], ob[7]);
              *(uint4*)(kd + 64 + 16 * h + 8) = o;
            }
            __syncthreads();
            {
              const char* stg = lds + (ltid() >> 6) * (64 * 208);
              const int m_0 = m0 + mw;
              int b0, pos0;
              if (m_0 < MX) { b0 = m_0 >> 12; pos0 = CTX + (m_0 & 4095); } else { const int my = m_0 - MX; b0 = my >> 8; pos0 = my & 255; }
              u16* dst = Kb + ((long)(b0 * 8 + head) * KPOS + pos0) * 96;
              const int lane = h * 32 + r;
#pragma unroll
              for (int q = 0; q < 12; ++q) {
                const int id = q * 64 + lane; const int row = id / 12, c = id % 12;
                *(uint4*)(dst + id * 8) = *(const uint4*)(stg + row * 208 + c * 16);
              }
            }
            __syncthreads();
          };
          gemm_loop<4, 2, 2, true, false, LdDirect<256>, LdDirect<128>>(FIRST(64), nKN, nblk, mkl, set, epi, 2, lds);
        }
        {
          auto mkl = [&](int it, LdDirect<256>& la, LdDirect<128>& lb) {
            const int mt = it >> 2, nt = it & 3;
            la.base = p.p + (long)mt * 256 * NP + C_CKV; la.ld = NP;
            lb.base = p.wukv_t + ((long)l * 1024 + 512 + nt * 128) * 128; lb.ld = 128; };
          u16* VT = p.vt;
          auto epi = [&](f32x16 (&acc)[2][2], int mw, int nw, int r, int h) {
            char* stg = lds + (ltid() >> 6) * (64 * 144);
            const int m_0 = m0 + mw;
#pragma unroll
            for (int i = 0; i < 2; ++i)
#pragma unroll
              for (int g4 = 0; g4 < 4; ++g4) {
                const int tl = i * 32 + 8 * g4 + 4 * h;
                float rv[4];
#pragma unroll
                for (int e = 0; e < 4; ++e) { const float4 sk = *(const float4*)(p.stats + (long)(m_0 + tl + e) * 16 + 8);
                  rv[e] = rsqrtf((sk.x + sk.y + sk.z + sk.w) * (1.f / 128.f) + EPS); }
#pragma unroll
                for (int j = 0; j < 2; ++j) {
                  uint2 o;
                  o.x = pk2(acc[i][j][4 * g4] * rv[0], acc[i][j][4 * g4 + 1] * rv[1]); o.y = pk2(acc[i][j][4 * g4 + 2] * rv[2], acc[i][j][4 * g4 + 3] * rv[3]);
                  *(uint2*)(stg + (j * 32 + r) * 144 + tl * 2) = o;
                }
              }
            __syncthreads();
            {
              int b0, pos0;
              if (m_0 < MX) { b0 = m_0 >> 12; pos0 = CTX + (m_0 & 4095); } else { const int my = m_0 - MX; b0 = my >> 8; pos0 = my & 255; }
              const int head = (n0 + nw) >> 6;
              u16* dst = VT + ((long)(b0 * 8 + head) * 64) * KPOS + pos0;
              const int lane = h * 32 + r;
#pragma unroll
              for (int q = 0; q < 8; ++q) {
                const int id = q * 64 + lane; const int dv = id >> 3, c = id & 7;
                *(uint4*)(dst + (long)dv * KPOS + c * 8) = *(const uint4*)(stg + dv * 144 + c * 16);
              }
            }
            __syncthreads();
          };
          gemm_loop<4, 2, 2, false, false, LdDirect<256>, LdDirect<128>>(FIRST(96), nV, nblk, mkl, set, epi, 2, lds);
        }
      }
      {
        int half = 0, n2 = 0, b = 0;
        auto mkl = [&](int it, LdDirect<128>& la, LdTrans<128>& lb) {
          const int half_ = it & 1, n2_ = (it >> 1) & 63, b_ = it >> 7;
          la.base = p.t1; la.ld = 64;
          lb.base = p.p + (long)(b_ * 4096 + n2_) * NP + C_FIN + half_ * 128; lb.strideK = 64L * NP; };
        auto set = [&](int it) { half = it & 1; n2 = (it >> 1) & 63; b = it >> 7; };
        u16* A1 = p.a1; const float* TW = p.tw;
        auto epi = [&](f32x16 (&acc)[2][1], int mw, int nw, int r, int h) {
          const int gc = half * 128 + nw + r;
          float2 t[16];
#pragma unroll
          for (int e = 0; e < 16; ++e) { const float fr = (float)(n2 * ((mw >> 1) + crow(e, h))) * (1.f / 4096.f);
            t[e] = make_float2(__builtin_amdgcn_cosf(fr), __builtin_amdgcn_sinf(fr)); }
#pragma unroll
          for (int e = 0; e < 16; ++e) {
            const int k1 = (mw >> 1) + crow(e, h);
            const float re = acc[0][0][e], im = acc[1][0][e];
            const float re2 = re * t[e].x + im * t[e].y, im2 = im * t[e].x - re * t[e].y;
            const long o = ((((long)b * 64 + k1) * 64 + n2) * 2) * 256 + gc;
            A1[o] = f2bf(re2); A1[o + 256] = f2bf(im2);
          }
        };
        gemm_loop<2, 2, 1, false, true, LdDirect<128>, LdTrans<128>>(FIRST(0), nF1, nblk, mkl, set, epi, 1, lds);
      }
      {
        int half = 0, mt = 0, b = 0;
        auto mkl = [&](int it, LdDirect<128>& la, LdTrans<128>& lb) {
          const int half_ = it & 1, mt_ = (it >> 1) & 3, b_ = it >> 3;
          la.base = p.t256 + (long)mt_ * 128 * 256; la.ld = 256;
          lb.base = p.p + (long)(MX + b_ * 256) * NP + C_FIN + half_ * 128; lb.strideK = (long)NP; };
        auto set = [&](int it) { half = it & 1; mt = (it >> 1) & 3; b = it >> 3; };
        u16* YF = p.yf;
        auto epi = [&](f32x16 (&acc)[1][2], int mw, int nw, int r, int h) {
#pragma unroll
          for (int j = 0; j < 2; ++j) {
            const int gc = half * 128 + nw + j * 32 + r; const int g = gc >> 6, c2 = gc & 63;
#pragma unroll
            for (int e = 0; e < 16; ++e) {
              const int rho = mt * 128 + mw + crow(e, h); const int ri = rho >> 8, k = rho & 255;
              YF[(long)(MX + b * 256 + k) * 512 + g * 128 + ri * 64 + c2] = f2bf(acc[0][j][e]);
            }
          }
        };
        gemm_loop<4, 1, 2, false, true, LdDirect<128>, LdTrans<128>>(FIRST(128), nFy, nblk, mkl, set, epi, 4, lds);
      }
      {
        int hd = 0, row0 = 0;
        auto mkl = [&](int it, LdDirect<128>& la, LdLN4& lb) {
          const int hd_ = it & 3, qd_ = it >> 2;
          la.base = p.gws_b + (long)(l * 4 + hd_) * 128 * 128; la.ld = 128;
          lb.base = p.p + (long)qd_ * 512 * NP + C_GV + hd_ * 64; lb.g = p.g_ln_g + l * 64; };
        auto set = [&](int it) { hd = it & 3; row0 = (it >> 2) * 512; };
        const u16* P = p.p; u16* MIX = p.hmix;
        auto epi = [&](f32x16 (&acc)[1][4], int mw, int nw, int r, int h) {
          const float bias = p.g_bs[(l * 4 + hd) * 128 + mw + r];
          char* stg = lds + (ltid() >> 6) * (32 * 272);
#pragma unroll
          for (int jj = 0; jj < 2; ++jj) {
#pragma unroll
            for (int j2 = 0; j2 < 2; ++j2)
#pragma unroll
              for (int g4 = 0; g4 < 4; ++g4)
                *(float4*)(stg + r * 272 + (j2 * 32 + 8 * g4 + 4 * h) * 4) =
                    make_float4(acc[0][2 * jj + j2][4 * g4] + bias, acc[0][2 * jj + j2][4 * g4 + 1] + bias, acc[0][2 * jj + j2][4 * g4 + 2] + bias, acc[0][2 * jj + j2][4 * g4 + 3] + bias);
            const long row_w = row0 + ((nw >> 6) + jj) * 128 + mw;
            const SgPre<4> gpre = staged_gate_fetch<32, 8, true>(h * 32 + r, P + row_w * NP + C_GGATE + hd * 64, P + row_w * NP + C_GU + hd * 64, NP);
            __syncthreads();
            staged_gate_finish<32, 8, 272, true>(stg, h * 32 + r, gpre, MIX + row_w * 1024 + 256 + hd * 64, 1024);
            __syncthreads();
          }
        };
        gemm_loop<4, 1, 4, true, true, LdDirect<128>, LdLN4>(FIRST(192), nG, nblk, mkl, set, epi, 2, lds);
      }
    }
    xcd_barrier(xb);

    {
      {
        int half = 0, k1 = 0, b = 0;
        auto mkl = [&](int it, LdDirect<128>& la, LdTrans<128>& lb) {
          const int half_ = it & 1, k1_ = (it >> 1) & 63, b_ = it >> 7;
          la.base = p.t2; la.ld = 128;
          lb.base = p.a1 + (((long)b_ * 64 + k1_) * 64 * 2) * 256 + half_ * 128; lb.strideK = 256L; };
        auto set = [&](int it) { half = it & 1; k1 = (it >> 1) & 63; b = it >> 7; };
        u16* YF = p.yf;
        auto epi = [&](f32x16 (&acc)[1][2], int mw, int nw, int r, int h) {
#pragma unroll
          for (int j = 0; j < 2; ++j) {
            const int gc = half * 128 + nw + j * 32 + r; const int g = gc >> 6, c2 = gc & 63;
#pragma unroll
            for (int e = 0; e < 16; ++e) {
              const int rho = mw + crow(e, h); const int ri = rho >> 6, k2 = rho & 63;
              YF[(long)(b * 4096 + k1 + 64 * k2) * 512 + g * 128 + ri * 64 + c2] = f2bf(acc[0][j][e]);
            }
          }
        };
        gemm_loop<4, 1, 2, false, true, LdDirect<128>, LdTrans<128>>(bid, 1024, nblk, mkl, set, epi, 2, lds);
      }
    {
      const u16* mf = p.mf_t + (long)l * 256 * 512;
      int m0 = 0, n0 = 0;
      auto mkl = [&](int it, LdDirect<256>& la, LdDirect<128>& lb) {
        const int mt = it >> 1, nt = it & 1;
        la.base = p.yf + (long)mt * 256 * 512; la.ld = 512; lb.base = mf + (long)nt * 128 * 512; lb.ld = 512; };
      auto set = [&](int it) { m0 = (it >> 1) * 256; n0 = (it & 1) * 128; };
      const u16* P = p.p; u16* MIX = p.hmix;
      auto epi = [&](f32x16 (&acc)[2][2], int mw, int nw, int r, int h) {
        const float sc = (m0 < MX) ? (1.f / 512.f) : (1.f / 128.f);
#pragma unroll
        for (int i = 0; i < 2; ++i) {
          u16 gv[2][16];
#pragma unroll
          for (int j = 0; j < 2; ++j)
#pragma unroll
            for (int e = 0; e < 16; ++e)
              gv[j][e] = P[(long)(m0 + mw + i * 32 + crow(e, h)) * NP + C_FGATE + n0 + nw + j * 32 + r];
#pragma unroll
          for (int j = 0; j < 2; ++j)
#pragma unroll
            for (int e = 0; e < 16; ++e)
              MIX[(long)(m0 + mw + i * 32 + crow(e, h)) * 1024 + n0 + nw + j * 32 + r] = f2bf(acc[i][j][e] * sc * silu(bf2f(gv[j][e])));
        }
      };
      gemm_loop<4, 2, 2, false, false, LdDirect<256>, LdDirect<128>>(128 * 2 + ((bid + nblk - 200) % nblk), (l == DEPTH - 1) ? 128 * 2 : 136 * 2, nblk, mkl, set, epi, 8, lds);
    }
      float negB;
      {
        float gq = 0.f, gk = 0.f;
        for (int i = 0; i < 96; ++i) { gq = fmaxf(gq, fabsf(p.q_norm_g[l * 96 + i])); gk = fmaxf(gk, fabsf(p.k_norm_g[l * 96 + i])); }
        negB = -(96.f * gq * gk * (0.10206207261596575f * 1.4426950408889634f) * 1.02f + 0.5f);
      }
      for (int it = bid; it < 512; it += nblk) {
        const int rnd = it / nblk; const int lb_ = it % nblk;
        int bh, qb;
        if (nblk == 256) { const int xcd = lb_ & 7, slot = lb_ >> 3; bh = rnd * 32 + xcd * 4 + (slot >> 3); qb = slot & 7; }
        else { bh = it >> 3; qb = it & 7; }
        const int b = bh >> 3, hd = bh & 7;
        const long bhoff = (long)(b * 8 + hd);
        const long row_base = (long)b * 4096 + qb * 512;
        attn_item64(p.q + bhoff * KPOS * 96, p.k + bhoff * KPOS * 96, p.vt + bhoff * 64 * KPOS, CTX + qb * 512, KPOS,
                    p.p + row_base * NP + C_AGATE + hd * 64, p.hmix + row_base * 1024 + 512 + hd * 64, lds);
      }
      if (l < DEPTH - 1) {
        for (int bh = (bid + nblk - 64) % nblk; bh < 64; bh += nblk) {
          const int b = bh >> 3, hd = bh & 7;
          const long bhoff = (long)(b * 8 + hd);
          const long row_base = (long)MX + b * 256;
          attn_item(p.q + bhoff * KPOS * 96, p.k + bhoff * KPOS * 96, p.vt + bhoff * 64 * KPOS, 0, CTX,
                    p.p + row_base * NP + C_AGATE + hd * 64, p.hmix + row_base * 1024 + 512 + hd * 64, negB, lds);
        }
      }
    }
    xcd_barrier(xb);

    {
      const u16* mf = p.mf_t + (long)l * 256 * 512;
      int m0 = 0, n0 = 0;
      auto mkl = [&](int it, LdDirect<256>& la, LdDirect<128>& lb) {
        const int mt = it >> 1, nt = it & 1;
        la.base = p.yf + (long)mt * 256 * 512; la.ld = 512; lb.base = mf + (long)nt * 128 * 512; lb.ld = 512; };
      auto set = [&](int it) { m0 = (it >> 1) * 256; n0 = (it & 1) * 128; };
      const u16* P = p.p; u16* MIX = p.hmix;
      auto epi = [&](f32x16 (&acc)[2][2], int mw, int nw, int r, int h) {
        const float sc = (m0 < MX) ? (1.f / 512.f) : (1.f / 128.f);
#pragma unroll
        for (int i = 0; i < 2; ++i) {
          u16 gv[2][16];
#pragma unroll
          for (int j = 0; j < 2; ++j)
#pragma unroll
            for (int e = 0; e < 16; ++e)
              gv[j][e] = P[(long)(m0 + mw + i * 32 + crow(e, h)) * NP + C_FGATE + n0 + nw + j * 32 + r];
#pragma unroll
          for (int j = 0; j < 2; ++j)
#pragma unroll
            for (int e = 0; e < 16; ++e)
              MIX[(long)(m0 + mw + i * 32 + crow(e, h)) * 1024 + n0 + nw + j * 32 + r] = f2bf(acc[i][j][e] * sc * silu(bf2f(gv[j][e])));
        }
      };
      gemm_loop<4, 2, 2, false, false, LdDirect<256>, LdDirect<128>>(bid, 128 * 2, nblk, mkl, set, epi, 8, lds);
    }
    xcd_barrier(xb);

    {
      const u16* wt = p.wout_t + (long)l * 1024 * 1024;
      int m0 = 0, n0 = 0;
      auto epi = [&](auto& acc, int mw, int nw, int r, int h) {
        constexpr int WM_ = sizeof(acc) / sizeof(acc[0]), WN_ = sizeof(acc[0]) / sizeof(acc[0][0]);
        const bool isx = m0 < MX;
        const float* __restrict__ src = isx ? (l == 0 ? p.x : p.out) + (long)m0 * 1024 : (l == 0 ? p.ctx : p.yw) + (long)(m0 - MX) * 1024;
        float* __restrict__ dst = isx ? p.out + (long)m0 * 1024 : p.yw + (long)(m0 - MX) * 1024;
        const float* gp = modl + (isx ? (m0 >> 12) : 8) * 3072 + 2048;
#pragma unroll
        for (int i = 0; i < WM_; ++i) {
          float old[WN_][16];
#pragma unroll
          for (int j = 0; j < WN_; ++j)
#pragma unroll
            for (int e = 0; e < 16; ++e)
              old[j][e] = src[(long)(mw + i * 32 + crow(e, h)) * 1024 + n0 + nw + j * 32 + r];
#pragma unroll
          for (int j = 0; j < WN_; ++j) {
            const float gt = gp[n0 + nw + j * 32 + r];
#pragma unroll
            for (int e = 0; e < 16; ++e)
              dst[(long)(mw + i * 32 + crow(e, h)) * 1024 + n0 + nw + j * 32 + r] = old[j][e] + gt * acc[i][j][e];
          }
        }
      };
      {
        auto mkl = [&](int j, LdDirect<256>& la, LdDirect<128>& lb) {
          const int mt = (j >> 3) * 8 + (bid & 7), nt = j & 7;
          la.base = p.hmix + (long)mt * 256 * 1024; la.ld = 1024; lb.base = wt + (long)nt * 128 * 1024; lb.ld = 1024; };
        auto set = [&](int j) { m0 = ((j >> 3) * 8 + (bid & 7)) * 256; n0 = (j & 7) * 128; };
        gemm_loop3<16, 4, 2, 2, false, false, LdDirect<256>, LdDirect<128>>(bid >> 3, 16 * 8, nblk >> 3, mkl, set, epi, lds);
      }
      if (l < DEPTH - 1) {
        auto mkl = [&](int it, LdDirect<128>& la, LdDirect<64>& lb) {
          const int mt = it >> 4, nt = it & 15;
          la.base = p.hmix + (long)(MX + mt * 128) * 1024; la.ld = 1024; lb.base = wt + (long)nt * 64 * 1024; lb.ld = 1024; };
        auto set = [&](int it) { m0 = MX + (it >> 4) * 128; n0 = (it & 15) * 64; };
        gemm_loop<4, 1, 1, false, false, LdDirect<128>, LdDirect<64>>(bid, 16 * 16, nblk, mkl, set, epi, 16, lds);
      }
    }
    if (l < DEPTH - 1) xcd_barrier(xb);
  }
}

static inline size_t al256(size_t x) { return (x + 255) / 256 * 256; }

extern "C" void kernel_launch(void* const* d_in, const int* in_sizes, int n_in,
                              void* d_out, int out_size, void* d_ws, size_t ws_size,
                              hipStream_t stream) {
  static int grid_blocks = 0;
  if (!grid_blocks) {
    int dev = 0, cus = 0, per_cu = 0;
    (void)hipGetDevice(&dev);
    (void)hipDeviceGetAttribute(&cus, hipDeviceAttributeMultiprocessorCount, dev);
    (void)hipFuncSetAttribute((const void*)fwd_megakernel, hipFuncAttributeMaxDynamicSharedMemorySize, LDS_BYTES);
    (void)hipOccupancyMaxActiveBlocksPerMultiprocessor(&per_cu, fwd_megakernel, NT_, LDS_BYTES);
    if (per_cu < 1) { fprintf(stderr, "occupancy query returned %d\n", per_cu); per_cu = 1; }
    grid_blocks = cus;
  }
  Params p{};
  p.x = (const float*)d_in[0]; p.c = (const float*)d_in[1]; p.ctx = (const float*)d_in[2]; p.c_ctx = (const float*)d_in[3];
  p.w_mod = (const float*)d_in[4]; p.b_mod = (const float*)d_in[5]; p.norm_g = (const float*)d_in[6]; p.w_in = (const float*)d_in[7];
  p.w_fmix = (const float*)d_in[8]; p.g_ln_g = (const float*)d_in[9]; p.g_ws = (const float*)d_in[10]; p.g_bs = (const float*)d_in[11];
  p.q_a_g = (const float*)d_in[12]; p.w_uq = (const float*)d_in[13]; p.kv_a_g = (const float*)d_in[14]; p.w_ukv = (const float*)d_in[15];
  p.q_norm_g = (const float*)d_in[16]; p.k_norm_g = (const float*)d_in[17]; p.w_out = (const float*)d_in[18];
  p.out = (float*)d_out;
  char* ws = (char*)d_ws; size_t off = 0;
  auto take = [&](size_t bytes) { char* r = ws + off; off = al256(off + bytes); return r; };
  p.bar = (unsigned*)take((size_t)XCD_BAR_WORDS * 4);
  p.yw = (float*)take((size_t)MY * 1024 * 4);
  p.mod = (float*)take((size_t)DEPTH * 9 * 3072 * 4);
  p.tw = (float*)take(4096 * 2 * 4);
  p.rope = (float*)take(64 * 8 * 2 * 4);
  p.stats = (float*)take((size_t)MT * 16 * 4);
  p.win_t = (u16*)take((size_t)DEPTH * NP * 1024 * 2);
  p.wout_t = (u16*)take((size_t)DEPTH * 1024 * 1024 * 2);
  p.wuq_t = (u16*)take((size_t)DEPTH * 768 * 256 * 2);
  p.wukv_t = (u16*)take((size_t)DEPTH * 1024 * 128 * 2);
  p.gws_b = (u16*)take((size_t)DEPTH * 4 * 128 * 128 * 2);
  p.mf_t = (u16*)take((size_t)DEPTH * 256 * 512 * 2);
  p.t1 = (u16*)take(128 * 64 * 2);
  p.t2 = (u16*)take(128 * 128 * 2);
  p.t256 = (u16*)take(512 * 256 * 2);
  p.hmix = (u16*)take((size_t)MT * 1024 * 2);
  p.p = (u16*)take((size_t)MT * NP * 2);
  p.q = (u16*)take((size_t)NB * 8 * KPOS * 96 * 2);
  p.k = (u16*)take((size_t)NB * 8 * KPOS * 96 * 2);
  p.vt = (u16*)take((size_t)NB * 8 * 64 * KPOS * 2);
  p.a1 = (u16*)take((size_t)NB * 64 * 64 * 2 * 256 * 2);
  p.yf = (u16*)take((size_t)MT * 512 * 2);
  if (off > ws_size) { fprintf(stderr, "workspace too small: need %zu have %zu\n", off, ws_size); return; }
  (void)hipMemsetAsync(p.bar, 0, (size_t)XCD_BAR_WORDS * 4, stream);
  void* args[] = {&p};
  hipError_t e = hipLaunchCooperativeKernel((void*)fwd_megakernel, dim3(grid_blocks), dim3(NT_), args, LDS_BYTES, stream);
  if (e != hipSuccess) fprintf(stderr, "cooperative launch failed: %s (grid %d)\n", hipGetErrorString(e), grid_blocks);
}
```

```cpp
#include <hip/hip_runtime.h>
#include <hip/hip_cooperative_groups.h>
#include <cstdio>
#include <cstdint>
namespace cg = cooperative_groups;

typedef unsigned short u16;
typedef __attribute__((ext_vector_type(8))) short bf16x8;
typedef __attribute__((ext_vector_type(16))) float f32x16;
typedef __attribute__((ext_vector_type(2))) __bf16 bf2_t;
typedef __attribute__((ext_vector_type(2))) float f2_t;
#define DI __device__ __forceinline__

constexpr int NB = 8, SEQ = 4096, DEPTH = 4, CTX = 256;
constexpr int MX = NB * SEQ, MY = NB * CTX, MT = MX + MY;
constexpr int NP = 2304, INW = 2208;
constexpr int C_FIN = 0, C_FGATE = 256, C_GU = 512, C_GV = 768, C_GGATE = 1024, C_CQ = 1280, C_CKV = 1536, C_KROPE = 1664, C_AGATE = 1696;
constexpr int KPOS = CTX + SEQ;
constexpr int NT_ = 512;
constexpr int PITCH = 144;
constexpr int LDS_BYTES = 131072;
constexpr int RSTD_OFF = 129024;
constexpr float EPS = 1e-6f;
constexpr float PI_F = 3.14159265358979323846f;

struct Params {
  const float *x, *c, *ctx, *c_ctx, *w_mod, *b_mod, *norm_g, *w_in, *w_fmix, *g_ln_g, *g_ws, *g_bs, *q_a_g, *w_uq, *kv_a_g, *w_ukv, *q_norm_g, *k_norm_g, *w_out;
  float* out;
  unsigned* bar;
  float *yw, *mod, *tw, *rope, *stats;
  u16 *win_t, *wout_t, *wuq_t, *wukv_t, *gws_b, *mf_t, *t1, *t2, *t256, *hmix, *p, *q, *k, *vt, *a1, *yf;
};

DI int ltid() { int t = threadIdx.x; asm volatile("" : "+v"(t)); return t; }
DI float bf2f(u16 v) { return __uint_as_float(((unsigned)v) << 16); }
DI unsigned pk2(float a, float b) { f2_t v = {a, b}; bf2_t r = __builtin_convertvector(v, bf2_t); return __builtin_bit_cast(unsigned, r); }
DI u16 f2bf(float a) { return (u16)(pk2(a, 0.f) & 0xffffu); }
DI float silu(float x) { return x / (1.f + __expf(-x)); }
DI int crow(int reg, int h) { return (reg & 3) + 8 * (reg >> 2) + 4 * h; }
DI float lo16(unsigned w) { return __uint_as_float(w << 16); }
DI float hi16(unsigned w) { return __uint_as_float(w & 0xffff0000u); }
DI f32x16 mfma(bf16x8 a, bf16x8 b, f32x16 c) { return __builtin_amdgcn_mfma_f32_32x32x16_bf16(a, b, c, 0, 0, 0); }
DI void unpack8(const uint4& v, float* f) {
  f[0] = lo16(v.x); f[1] = hi16(v.x); f[2] = lo16(v.y); f[3] = hi16(v.y);
  f[4] = lo16(v.z); f[5] = hi16(v.z); f[6] = lo16(v.w); f[7] = hi16(v.w);
}

#define XB_TMO      128
#define XB_XCNT(j)  (256  + 64 * (j))
#define XB_XSUB(j)  (1280 + 64 * (j))
#define XB_XGEN(j)  (2304 + 64 * (j))
#define XB_TOP      3328
#define XB_TOPGEN   3392
#define XCD_BAR_WORDS 3456
#define XB_SPIN_CAP (1u << 18)
#define LAS __attribute__((address_space(3)))
DI unsigned xb_ld(unsigned* p)              { return __hip_atomic_load(p, __ATOMIC_RELAXED, __HIP_MEMORY_SCOPE_AGENT); }
DI unsigned xb_add(unsigned* p, unsigned v) { return __hip_atomic_fetch_add(p, v, __ATOMIC_RELAXED, __HIP_MEMORY_SCOPE_AGENT); }
DI unsigned xb_xcc_id() { return (unsigned)__builtin_amdgcn_s_getreg((3 << 11) | 20) & 0xFu; }
#define XB_SPIN(cond, bar) do { unsigned _sp = 0; while (cond) { __builtin_amdgcn_s_sleep(1); \
    if ((++_sp & 255u) == 0u) { if (xb_ld(&(bar)[XB_TMO])) break; if (_sp > XB_SPIN_CAP) { atomicAdd(&(bar)[XB_TMO], 1u); break; } } } } while (0)
struct XcdBarrier { unsigned* bar; unsigned x; volatile LAS unsigned* st; };
DI XcdBarrier xcd_barrier_post(unsigned* bar, volatile LAS unsigned* st) {
  XcdBarrier b; b.bar = bar; b.x = xb_xcc_id(); b.st = st;
  if (threadIdx.x == 0) (void)xb_add(&bar[XB_XCNT(b.x)], 1u);
  return b;
}
DI void xcd_barrier_complete(unsigned* bar, unsigned x, unsigned& nloc, unsigned& nx) {
  const unsigned G = gridDim.x * gridDim.y * gridDim.z;
  unsigned sum, cnt, mine, sp = 0u;
  for (;;) {
    sum = 0u; cnt = 0u; mine = 0u;
#pragma unroll
    for (unsigned j = 0; j < 16; ++j) { const unsigned c = xb_ld(&bar[XB_XCNT(j)]); sum += c; cnt += (c > 0u) ? 1u : 0u; mine = (j == x) ? c : mine; }
    if (sum == G) break;
    __builtin_amdgcn_s_sleep(1);
    if ((++sp & 255u) == 0u) { if (xb_ld(&bar[XB_TMO])) break; if (sp > XB_SPIN_CAP) { atomicAdd(&bar[XB_TMO], 1u); break; } }
  }
  nloc = mine > 0u ? mine : 1u; nx = cnt > 0u ? cnt : 1u;
}
DI void xcd_barrier(const XcdBarrier& b) {
  asm volatile("s_waitcnt vmcnt(0)" ::: "memory");
  __syncthreads();
  if (threadIdx.x == 0) {
    unsigned* bar = b.bar;
    __builtin_amdgcn_s_waitcnt(0);
    unsigned nloc = b.st[0], nx = b.st[1];
    if (nloc == 0u) { xcd_barrier_complete(bar, b.x, nloc, nx); b.st[0] = nloc; b.st[1] = nx; }
    const unsigned old = xb_add(&bar[XB_XSUB(b.x)], 1u);
    const unsigned gen = old / nloc;
    if (old + 1u == (gen + 1u) * nloc) {
      __builtin_amdgcn_fence(__ATOMIC_RELEASE, "agent");
      asm volatile("s_waitcnt vmcnt(0)" ::: "memory");
      const unsigned og = xb_add(&bar[XB_TOP], 1u);
      const unsigned tg = og / nx;
      if (og + 1u == (tg + 1u) * nx) xb_add(&bar[XB_TOPGEN], 1u);
      else XB_SPIN(xb_ld(&bar[XB_TOPGEN]) == tg, bar);
      __builtin_amdgcn_fence(__ATOMIC_ACQUIRE, "agent");
      xb_add(&bar[XB_XGEN(b.x)], 1u);
      asm volatile("s_waitcnt vmcnt(0)" ::: "memory");
    } else {
      XB_SPIN(xb_ld(&bar[XB_XGEN(b.x)]) == gen, bar);
      __builtin_amdgcn_fence(__ATOMIC_ACQUIRE, "agent");
      asm volatile("s_waitcnt vmcnt(0)" ::: "memory");
    }
  }
  __syncthreads();
}


template <int ROWS> struct LdDirect {
  static constexpr int NR = ROWS * 8 / NT_;
  struct Regs { uint4 v[NR]; };
  const u16* base; long ld;
  DI Regs fetch(int kt, int tid) const { Regs r;
#pragma unroll
    for (int i = 0; i < NR; ++i) { int id = tid + NT_ * i; int row = id >> 3, kc = id & 7;
      r.v[i] = *(const uint4*)(base + (long)row * ld + kt * 64 + kc * 8); }
    return r;
  }
  DI void commit(char* s, const Regs& r, int, int tid) const {
#pragma unroll
    for (int i = 0; i < NR; ++i) { int id = tid + NT_ * i; int row = id >> 3, kc = id & 7;
      *(uint4*)(s + row * PITCH + kc * 16) = r.v[i]; }
  }
};
template <int ROWS> struct LdScaled {
  static constexpr int NR = ROWS * 8 / NT_;
  struct Regs { uint4 v[NR]; };
  const u16* base; long ld; const float* g; const float* rstd_s;
  DI Regs fetch(int kt, int tid) const { Regs r;
#pragma unroll
    for (int i = 0; i < NR; ++i) { int id = tid + NT_ * i; int row = id >> 3, kc = id & 7;
      r.v[i] = *(const uint4*)(base + (long)row * ld + kt * 64 + kc * 8); }
    return r;
  }
  DI void commit(char* s, const Regs& r, int kt, int tid) const {
#pragma unroll
    for (int i = 0; i < NR; ++i) { int id = tid + NT_ * i; int row = id >> 3, kc = id & 7;
      float f[8]; unpack8(r.v[i], f);
      const float rs = rstd_s[row];
      const float4 g0 = *(const float4*)(g + kt * 64 + kc * 8), g1 = *(const float4*)(g + kt * 64 + kc * 8 + 4);
      uint4 o;
      o.x = pk2(f[0] * rs * g0.x, f[1] * rs * g0.y); o.y = pk2(f[2] * rs * g0.z, f[3] * rs * g0.w);
      o.z = pk2(f[4] * rs * g1.x, f[5] * rs * g1.y); o.w = pk2(f[6] * rs * g1.z, f[7] * rs * g1.w);
      *(uint4*)(s + row * PITCH + kc * 16) = o; }
  }
};
template <int BN> struct LdTrans {
  static constexpr int NC = BN / 8;
  static constexpr int NR = 32 * NC / NT_;
  struct Regs { uint4 v[2 * NR]; };
  const u16* base; long strideK;
  DI Regs fetch(int kt, int tid) const { Regs r;
#pragma unroll
    for (int i = 0; i < NR; ++i) { int id = tid + NT_ * i; int nc = id % NC, k2 = id / NC;
      r.v[2 * i] = *(const uint4*)(base + (long)(kt * 64 + 2 * k2) * strideK + nc * 8);
      r.v[2 * i + 1] = *(const uint4*)(base + (long)(kt * 64 + 2 * k2 + 1) * strideK + nc * 8); }
    return r;
  }
  DI void commit(char* s, const Regs& r, int, int tid) const {
#pragma unroll
    for (int i = 0; i < NR; ++i) { int id = tid + NT_ * i; int nc = id % NC, k = 2 * (id / NC);
      const int off = (((k >> 3) ^ (nc & 7)) << 4) + (k & 7) * 2;
      char* d = s + (nc * 8) * PITCH + off;
      const unsigned a[4] = {r.v[2 * i].x, r.v[2 * i].y, r.v[2 * i].z, r.v[2 * i].w};
      const unsigned c[4] = {r.v[2 * i + 1].x, r.v[2 * i + 1].y, r.v[2 * i + 1].z, r.v[2 * i + 1].w};
#pragma unroll
      for (int e = 0; e < 8; ++e) {
        const unsigned lo = (e & 1) ? (a[e >> 1] >> 16) : (a[e >> 1] & 0xffffu);
        const unsigned hi = (e & 1) ? (c[e >> 1] & 0xffff0000u) : (c[e >> 1] << 16);
        *(unsigned*)(d + e * PITCH) = lo | hi; } }
  }
};
struct LdLN {
  static constexpr int NR = 1;
  struct Regs { uint4 v[1]; };
  const u16* base; const float* g;
  DI Regs fetch(int kt, int tid) const { Regs r; int id = tid; int nc = id & 7, k = id >> 3;
    r.v[0] = *(const uint4*)(base + (long)(kt * 64 + k) * NP + nc * 8); return r; }
  DI void commit(char* s, const Regs& r, int, int tid) const {
    int id = tid; int nc = id & 7, k = id >> 3;
    float f[8]; unpack8(r.v[0], f);
    float sm = 0.f;
#pragma unroll
    for (int e = 0; e < 8; ++e) sm += f[e];
    sm += __shfl_xor(sm, 1); sm += __shfl_xor(sm, 2); sm += __shfl_xor(sm, 4);
    const float mean = sm * (1.f / 64.f);
    float sq = 0.f;
#pragma unroll
    for (int e = 0; e < 8; ++e) { f[e] -= mean; sq += f[e] * f[e]; }
    sq += __shfl_xor(sq, 1); sq += __shfl_xor(sq, 2); sq += __shfl_xor(sq, 4);
    const float rs = rsqrtf(sq * (1.f / 64.f) + EPS);
    const int off = (((k >> 3) ^ (nc & 7)) << 4) + (k & 7) * 2;
    char* d = s + (nc * 8) * PITCH + off;
#pragma unroll
    for (int e = 0; e < 8; ++e) *(u16*)(d + e * PITCH) = f2bf(f[e] * rs * g[nc * 8 + e]);
  }
};

template <int WM, int WN, bool SWAP, bool SWZB>
DI void gemm_compute(f32x16 (&acc)[WM][WN], const char* a_s, const char* b_s, int brow0, int h) {
#pragma unroll
  for (int ks = 0; ks < 4; ++ks) {
    bf16x8 af[WM], bfr[WN];
#pragma unroll
    for (int i = 0; i < WM; ++i) af[i] = *(const bf16x8*)(a_s + i * 32 * PITCH + (ks * 2 + h) * 16);
#pragma unroll
    for (int j = 0; j < WN; ++j) {
      const int row = brow0 + j * 32;
      const int ch = SWZB ? ((ks * 2 + h) ^ ((row >> 3) & 7)) : (ks * 2 + h);
      bfr[j] = *(const bf16x8*)(b_s + j * 32 * PITCH + ch * 16);
    }
#pragma unroll
    for (int i = 0; i < WM; ++i)
#pragma unroll
      for (int j = 0; j < WN; ++j)
        acc[i][j] = SWAP ? mfma(bfr[j], af[i], acc[i][j]) : mfma(af[i], bfr[j], acc[i][j]);
  }
  __builtin_amdgcn_iglp_opt(1);
}
struct LdLN4 {
  static constexpr int NR = 4;
  struct Regs { uint4 v[4]; };
  const u16* base; const float* g;
  DI Regs fetch(int kt, int tid) const { Regs r;
    const int nc = tid & 7, kq = (tid >> 3) & 15, ci = tid >> 7;
#pragma unroll
    for (int j = 0; j < 4; ++j) r.v[j] = *(const uint4*)(base + (long)(ci * 128 + kt * 64 + 4 * kq + j) * NP + nc * 8);
    return r; }
  DI void commit(char* s, const Regs& r, int, int tid) const {
    const int nc = tid & 7, kq = (tid >> 3) & 15, ci = tid >> 7;
    float gg[8];
#pragma unroll
    for (int e = 0; e < 8; ++e) gg[e] = g[nc * 8 + e];
    float f[4][8];
#pragma unroll
    for (int j = 0; j < 4; ++j) {
      unpack8(r.v[j], f[j]);
      float sm = 0.f;
#pragma unroll
      for (int e = 0; e < 8; ++e) sm += f[j][e];
      sm += __shfl_xor(sm, 1); sm += __shfl_xor(sm, 2); sm += __shfl_xor(sm, 4);
      const float mean = sm * (1.f / 64.f);
      float sq = 0.f;
#pragma unroll
      for (int e = 0; e < 8; ++e) { f[j][e] -= mean; sq += f[j][e] * f[j][e]; }
      sq += __shfl_xor(sq, 1); sq += __shfl_xor(sq, 2); sq += __shfl_xor(sq, 4);
      const float rs = rsqrtf(sq * (1.f / 64.f) + EPS);
#pragma unroll
      for (int e = 0; e < 8; ++e) f[j][e] *= rs * gg[e];
    }
    const int k = 4 * kq;
    const int off = (((k >> 3) ^ (nc & 7)) << 4) + (k & 7) * 2;
    char* d = s + (ci * 64 + nc * 8) * PITCH + off;
#pragma unroll
    for (int e = 0; e < 8; ++e) { uint2 o; o.x = pk2(f[0][e], f[1][e]); o.y = pk2(f[2][e], f[3][e]); *(uint2*)(d + e * PITCH) = o; }
  }
};
template <class LA, class LB> struct GemmPre { typename LA::Regs a0, a1; typename LB::Regs b0, b1; };
template <class LA, class LB>
DI GemmPre<LA, LB> gemm_prefetch(const LA& la, const LB& lb, int nkt) {
  const int tid = ltid();
  GemmPre<LA, LB> pre;
  const int k1 = nkt > 1 ? 1 : 0;
  pre.a0 = la.fetch(0, tid); pre.b0 = lb.fetch(0, tid);
  pre.a1 = la.fetch(k1, tid); pre.b1 = lb.fetch(k1, tid);
  return pre;
}
template <int WGM, int WM, int WN, bool SWAP, bool SWZB, class LA, class LB, class EPI>
DI GemmPre<LA, LB> gemm_tile(const LA& la, const LB& lb, const EPI& epi, int nkt, char* lds, const GemmPre<LA, LB>& pre, const LA& lan, const LB& lbn) {
  constexpr int WGN = 8 / WGM;
  constexpr int BM = WGM * WM * 32, BN = WGN * WN * 32;
  constexpr int ASZ = BM * PITCH, BSZ = BN * PITCH;
  char* As = lds; char* Bs = lds + 2 * ASZ;
  const int tid = ltid(), w = tid >> 6, lane = tid & 63, r = lane & 31, h = lane >> 5;
  const int wm = w / WGN, wn = w % WGN;
  f32x16 acc[WM][WN];
#pragma unroll
  for (int i = 0; i < WM; ++i)
#pragma unroll
    for (int j = 0; j < WN; ++j)
#pragma unroll
      for (int e = 0; e < 16; ++e) acc[i][j][e] = 0.f;
  typename LA::Regs ra0 = pre.a0, ra1 = pre.a1; typename LB::Regs rb0 = pre.b0, rb1 = pre.b1;
  la.commit(As, ra0, 0, tid); lb.commit(Bs, rb0, 0, tid);
  __syncthreads();
  const int a_off = (wm * WM * 32 + r) * PITCH, b_off = (wn * WN * 32 + r) * PITCH;
  const int k1n = nkt > 1 ? 1 : 0;
#define GEMM_COMPUTE(cur) gemm_compute<WM, WN, SWAP, SWZB>(acc, As + (cur) * ASZ + a_off, Bs + (cur) * BSZ + b_off, wn * WN * 32 + r, h)
  if (nkt == 1) {
    ra0 = lan.fetch(0, tid); rb0 = lbn.fetch(0, tid);
    GEMM_COMPUTE(0);
    ra1 = ra0; rb1 = rb0;
    __syncthreads();
  } else {
    for (int kt = 0; kt < nkt; kt += 2) {
      const bool more = kt + 2 < nkt;
      if (more) { ra0 = la.fetch(kt + 2, tid); rb0 = lb.fetch(kt + 2, tid); }
      else      { ra0 = lan.fetch(0, tid);     rb0 = lbn.fetch(0, tid); }
      GEMM_COMPUTE(0);
      la.commit(As + ASZ, ra1, kt + 1, tid); lb.commit(Bs + BSZ, rb1, kt + 1, tid);
      __syncthreads();
      if (more) { ra1 = la.fetch(kt + 3, tid); rb1 = lb.fetch(kt + 3, tid); }
      else      { ra1 = lan.fetch(k1n, tid);   rb1 = lbn.fetch(k1n, tid); }
      GEMM_COMPUTE(1);
      if (more) { la.commit(As, ra0, kt + 2, tid); lb.commit(Bs, rb0, kt + 2, tid); }
      __syncthreads();
    }
  }
#undef GEMM_COMPUTE
  epi(acc, wm * WM * 32, wn * WN * 32, r, h);
  GemmPre<LA, LB> nx; nx.a0 = ra0; nx.a1 = ra1; nx.b0 = rb0; nx.b1 = rb1;
  return nx;
}
template <int WGM, int WM, int WN, bool SWAP, bool SWZB, class LA, class LB, class MKL, class SET, class EPI>
DI void gemm_loop(int first, int count, int step, const MKL& mkl, const SET& set, const EPI& epi, int nkt, char* lds) {
  if (first >= count) return;
  LA la; LB lb; mkl(first, la, lb);
  GemmPre<LA, LB> pre = gemm_prefetch(la, lb, nkt);
  for (int idx = first; idx < count; idx += step) {
    const int nx = (idx + step < count) ? idx + step : idx;
    LA lan; LB lbn; mkl(nx, lan, lbn);
    set(idx);
    pre = gemm_tile<WGM, WM, WN, SWAP, SWZB>(la, lb, epi, nkt, lds, pre, lan, lbn);
    la = lan; lb = lbn;
  }
}

template <class LA, class LB> struct GemmPre3 { typename LA::Regs a[3]; typename LB::Regs b[3]; };
template <int NKT, int WGM, int WM, int WN, bool SWAP, bool SWZB, class LA, class LB, class MKL, class SET, class EPI>
DI void gemm_loop3(int first, int count, int step, const MKL& mkl, const SET& set, const EPI& epi, char* lds) {
  static_assert(NKT >= 4, "needs at least 4 k-slabs");
  constexpr int WGN = 8 / WGM;
  constexpr int BM = WGM * WM * 32, BN = WGN * WN * 32;
  constexpr int ASZ = BM * PITCH, BSZ = BN * PITCH;
  if (first >= count) return;
  char* As = lds; char* Bs = lds + 2 * ASZ;
  LA la; LB lb; mkl(first, la, lb);
  typename LA::Regs ra0, ra1, ra2; typename LB::Regs rb0, rb1, rb2;
  { const int tid = ltid();
    ra0 = la.fetch(0, tid); rb0 = lb.fetch(0, tid); ra1 = la.fetch(1, tid); rb1 = lb.fetch(1, tid); ra2 = la.fetch(2, tid); rb2 = lb.fetch(2, tid); }
  for (int idx = first; idx < count; idx += step) {
    const int nx = (idx + step < count) ? idx + step : idx;
    LA lan; LB lbn; mkl(nx, lan, lbn);
    set(idx);
    const int tid = ltid(), w = tid >> 6, lane = tid & 63, r = lane & 31, h = lane >> 5;
    const int wm = w / WGN, wn = w % WGN;
    f32x16 acc[WM][WN];
#pragma unroll
    for (int i = 0; i < WM; ++i)
#pragma unroll
      for (int j = 0; j < WN; ++j)
#pragma unroll
        for (int e = 0; e < 16; ++e) acc[i][j][e] = 0.f;
    la.commit(As, ra0, 0, tid); lb.commit(Bs, rb0, 0, tid);
    __syncthreads();
    const int a_off = (wm * WM * 32 + r) * PITCH, b_off = (wn * WN * 32 + r) * PITCH;
#define G3_FETCH(RA, RB, kk) do { if ((kk) < NKT) { RA = la.fetch((kk), tid); RB = lb.fetch((kk), tid); } else { RA = lan.fetch((kk) - NKT, tid); RB = lbn.fetch((kk) - NKT, tid); } } while (0)
#define G3_TRIP(kt, RA, RB, RAn, RBn) do { \
      G3_FETCH(RA, RB, (kt) + 3); \
      gemm_compute<WM, WN, SWAP, SWZB>(acc, As + ((kt) & 1) * ASZ + a_off, Bs + ((kt) & 1) * BSZ + b_off, wn * WN * 32 + r, h); \
      if ((kt) + 1 < NKT) { la.commit(As + (((kt) + 1) & 1) * ASZ, RAn, (kt) + 1, tid); lb.commit(Bs + (((kt) + 1) & 1) * BSZ, RBn, (kt) + 1, tid); } \
      __syncthreads(); } while (0)
#pragma unroll
    for (int k3 = 0; k3 < NKT; k3 += 3) {
      G3_TRIP(k3, ra0, rb0, ra1, rb1);
      if (k3 + 1 < NKT) G3_TRIP(k3 + 1, ra1, rb1, ra2, rb2);
      if (k3 + 2 < NKT) G3_TRIP(k3 + 2, ra2, rb2, ra0, rb0);
    }
#undef G3_TRIP
#undef G3_FETCH
    epi(acc, wm * WM * 32, wn * WN * 32, r, h);
    if (NKT % 3 == 1) { typename LA::Regs ta = ra0; typename LB::Regs tb = rb0; ra0 = ra1; rb0 = rb1; ra1 = ra2; rb1 = rb2; ra2 = ta; rb2 = tb; }
    if (NKT % 3 == 2) { typename LA::Regs ta = ra2; typename LB::Regs tb = rb2; ra2 = ra1; rb2 = rb1; ra1 = ra0; rb1 = rb0; ra0 = ta; rb0 = tb; }
    la = lan; lb = lbn;
  }
}

DI void transpose_cvt_tile(const float* src, u16* dst, int K, int N, int kt, int nt, int remap, float* tile, const float* kgain = nullptr) {
  const int tid = ltid();
#pragma unroll
  for (int i = 0; i < 8; ++i) {
    const int kk = i * 8 + (tid >> 6), nn = tid & 63;
    const int n = nt * 64 + nn;
    tile[kk * 65 + nn] = (n < N) ? src[(long)(kt * 64 + kk) * N + n] * (kgain ? kgain[kt * 64 + kk] : 1.f) : 0.f;
  }
  __syncthreads();
  {
    const int nl = tid >> 3, kc = (tid & 7) * 8;
    const int n = nt * 64 + nl;
    if (n < N) {
      int dn = n;
      if (remap) { const int hh = n >> 7, dd = n & 127; dn = (dd < 64) ? (hh * 64 + dd) : (512 + hh * 64 + dd - 64); }
      uint4 o;
      o.x = pk2(tile[(kc + 0) * 65 + nl], tile[(kc + 1) * 65 + nl]);
      o.y = pk2(tile[(kc + 2) * 65 + nl], tile[(kc + 3) * 65 + nl]);
      o.z = pk2(tile[(kc + 4) * 65 + nl], tile[(kc + 5) * 65 + nl]);
      o.w = pk2(tile[(kc + 6) * 65 + nl], tile[(kc + 7) * 65 + nl]);
      *(uint4*)(dst + (long)dn * K + kt * 64 + kc) = o;
    }
  }
  __syncthreads();
}

template <int NQ> struct SgPre { uint4 g[NQ], u[NQ]; };
template <int ROWS, int CH, bool HAS_U>
DI SgPre<ROWS * CH / 64> staged_gate_fetch(int lane, const u16* __restrict__ gate, const u16* __restrict__ uptr, long ldg) {
  constexpr int NQ = ROWS * CH / 64;
  SgPre<NQ> q;
#pragma unroll
  for (int i = 0; i < NQ; ++i) {
    const int id = i * 64 + lane; const int row = id / CH, c = id % CH;
    q.g[i] = *(const uint4*)(gate + (long)row * ldg + c * 8);
    q.u[i] = HAS_U ? *(const uint4*)(uptr + (long)row * ldg + c * 8) : make_uint4(0, 0, 0, 0);
  }
  return q;
}
template <int ROWS, int CH, int SPB, bool HAS_U>
DI void staged_gate_finish(const char* st, int lane, const SgPre<ROWS * CH / 64>& pre, u16* __restrict__ out, long ldo) {
  constexpr int NQ = ROWS * CH / 64;
#pragma unroll
  for (int q = 0; q < NQ; ++q) {
    const int id = q * 64 + lane; const int row = id / CH, c = id % CH;
    const float4 a = *(const float4*)(st + row * SPB + c * 32), b = *(const float4*)(st + row * SPB + c * 32 + 16);
    float g[8]; unpack8(pre.g[q], g);
    float u[8];
    if (HAS_U) unpack8(pre.u[q], u); else {
#pragma unroll
      for (int e = 0; e < 8; ++e) u[e] = 1.f; }
    uint4 o;
    o.x = pk2(a.x * u[0] * silu(g[0]), a.y * u[1] * silu(g[1])); o.y = pk2(a.z * u[2] * silu(g[2]), a.w * u[3] * silu(g[3]));
    o.z = pk2(b.x * u[4] * silu(g[4]), b.y * u[5] * silu(g[5])); o.w = pk2(b.z * u[6] * silu(g[6]), b.w * u[7] * silu(g[7]));
    *(uint4*)(out + (long)row * ldo + c * 8) = o;
  }
}
template <int ROWS, int CH, int SPB, bool HAS_U>
DI void staged_gate_store(const char* st, int lane, const u16* __restrict__ gate, const u16* __restrict__ uptr, long ldg, u16* __restrict__ out, long ldo) {
  const SgPre<ROWS * CH / 64> pre = staged_gate_fetch<ROWS, CH, HAS_U>(lane, gate, uptr, ldg);
  staged_gate_finish<ROWS, CH, SPB, HAS_U>(st, lane, pre, out, ldo);
}

constexpr int AT_KP = 208, AT_KSZ = 64 * AT_KP, AT_VP = 144, AT_VSZ = 64 * AT_VP;
DI void attn_qk(f32x16& p0, f32x16& p1, const char* ks, const bf16x8 (&qf)[6], int r, int h, float negB) {
#pragma unroll
  for (int e = 0; e < 16; ++e) { p0[e] = negB; p1[e] = negB; }
#pragma unroll
  for (int s = 0; s < 6; ++s) {
    const bf16x8 k0 = *(const bf16x8*)(ks + r * AT_KP + (2 * s + h) * 16);
    const bf16x8 k1 = *(const bf16x8*)(ks + (32 + r) * AT_KP + (2 * s + h) * 16);
    p0 = mfma(k0, qf[s], p0); p1 = mfma(k1, qf[s], p1);
  }
}
DI void attn_pv(f32x16& o0, f32x16& o1, const f32x16& p0, const f32x16& p1, const char* vs, int r, int h) {
#pragma unroll
  for (int kb = 0; kb < 2; ++kb) {
#pragma unroll
    for (int sp = 0; sp < 2; ++sp) {
      uint4 pw;
      if (kb == 0) { pw.x = pk2(p0[8 * sp + 0], p0[8 * sp + 1]); pw.y = pk2(p0[8 * sp + 2], p0[8 * sp + 3]);
                     pw.z = pk2(p0[8 * sp + 4], p0[8 * sp + 5]); pw.w = pk2(p0[8 * sp + 6], p0[8 * sp + 7]); }
      else         { pw.x = pk2(p1[8 * sp + 0], p1[8 * sp + 1]); pw.y = pk2(p1[8 * sp + 2], p1[8 * sp + 3]);
                     pw.z = pk2(p1[8 * sp + 4], p1[8 * sp + 5]); pw.w = pk2(p1[8 * sp + 6], p1[8 * sp + 7]); }
      const bf16x8 pf = __builtin_bit_cast(bf16x8, pw);
      const int keyoff = 32 * kb + 16 * sp + 4 * h;
      {
        const char* vr = vs + r * AT_VP + ((keyoff * 2) ^ ((r & 16) >> 1));
        const uint2 lo = *(const uint2*)vr, hi = *(const uint2*)(vr + 16);
        uint4 a4 = make_uint4(lo.x, lo.y, hi.x, hi.y);
        o0 = mfma(__builtin_bit_cast(bf16x8, a4), pf, o0);
      }
      {
        const char* vr = vs + (32 + r) * AT_VP + ((keyoff * 2) ^ ((r & 16) >> 1));
        const uint2 lo = *(const uint2*)vr, hi = *(const uint2*)(vr + 16);
        uint4 a4 = make_uint4(lo.x, lo.y, hi.x, hi.y);
        o1 = mfma(__builtin_bit_cast(bf16x8, a4), pf, o1);
      }
    }
  }
}
DI void attn_item(const u16* __restrict__ Qp, const u16* __restrict__ Kp, const u16* __restrict__ VTp, int q0, int nkeys,
                  const u16* __restrict__ gatep, u16* __restrict__ mixp, float negB, char* lds) {
  const int tid = ltid(), w = tid >> 6, lane = tid & 63, r = lane & 31, h = lane >> 5;
  char* Kb0 = lds; char* Vb0 = lds + 2 * AT_KSZ;
  bf16x8 qf[6];
  {
    const u16* qrow = Qp + (long)(q0 + w * 32 + r) * 96 + h * 8;
#pragma unroll
    for (int s = 0; s < 6; ++s) qf[s] = *(const bf16x8*)(qrow + s * 16);
  }
  f32x16 o0, o1;
#pragma unroll
  for (int e = 0; e < 16; ++e) { o0[e] = 0.f; o1[e] = 0.f; }
  float lsum = 0.f;
  const int NT = nkeys >> 6;
  uint4 rkA0, rkA1, rvA, rkB0, rkB1, rvB;
  rkA1 = make_uint4(0, 0, 0, 0); rkB1 = make_uint4(0, 0, 0, 0);
  const int krow0 = tid / 12, kc0 = tid % 12, krow1 = (tid + 512) / 12, kc1 = (tid + 512) % 12;
  const int vrow = tid >> 3, vc = tid & 7;
  const bool klo = tid < 256;
#define AT_FETCH_K(S, t) do { const u16* kt_ = Kp + (long)(t) * 64 * 96; rk##S##0 = *(const uint4*)(kt_ + tid * 8); \
    if (klo) rk##S##1 = *(const uint4*)(kt_ + (tid + 512) * 8); } while (0)
#define AT_FETCH_V(S, t) do { rv##S = *(const uint4*)(VTp + (long)vrow * KPOS + (t) * 64 + vc * 8); } while (0)
#define AT_COMMIT_K(S, buf) do { char* ks_ = Kb0 + (buf) * AT_KSZ; *(uint4*)(ks_ + krow0 * AT_KP + kc0 * 16) = rk##S##0; \
    if (klo) *(uint4*)(ks_ + krow1 * AT_KP + kc1 * 16) = rk##S##1; } while (0)
#define AT_COMMIT_V(S, buf) do { *(uint4*)(Vb0 + (buf) * AT_VSZ + vrow * AT_VP + vc * 16) = (vrow & 16) ? make_uint4(rv##S.z, rv##S.w, rv##S.x, rv##S.y) : rv##S; } while (0)
#define AT_TRIP(t, FS, CS) do { \
    { const int tk_ = ((t) + 3 < NT) ? (t) + 3 : NT - 1, tv_ = ((t) + 2 < NT) ? (t) + 2 : NT - 1; AT_FETCH_K(FS, tk_); AT_FETCH_V(FS, tv_); } \
    f32x16 n0, n1; \
    attn_qk(n0, n1, Kb0 + (((t) + 1) & 1) * AT_KSZ, qf, r, h, negB); \
    const char* vs = Vb0 + ((t) & 1) * AT_VSZ; \
    float rs = 0.f; \
    _Pragma("unroll") for (int e = 0; e < 16; ++e) { p0[e] = __builtin_amdgcn_exp2f(p0[e]); rs += p0[e]; } \
    _Pragma("unroll") for (int e = 0; e < 16; ++e) { p1[e] = __builtin_amdgcn_exp2f(p1[e]); rs += p1[e]; } \
    lsum += rs; \
    attn_pv(o0, o1, p0, p1, vs, r, h); \
    AT_COMMIT_K(CS, (t) & 1); AT_COMMIT_V(CS, ((t) + 1) & 1); \
    __syncthreads(); \
    p0 = n0; p1 = n1; } while (0)
  AT_FETCH_K(A, 0); AT_FETCH_V(A, 0); AT_FETCH_K(B, 1);
  AT_COMMIT_K(A, 0); AT_COMMIT_V(A, 0); AT_COMMIT_K(B, 1);
  AT_FETCH_K(B, 2); AT_FETCH_V(B, 1);
  __syncthreads();
  f32x16 p0, p1;
  attn_qk(p0, p1, Kb0, qf, r, h, negB);
  for (int t = 0; t < NT; t += 2) {
    AT_TRIP(t, A, B);
    AT_TRIP(t + 1, B, A);
  }
#undef AT_TRIP
#undef AT_FETCH_K
#undef AT_FETCH_V
#undef AT_COMMIT_K
#undef AT_COMMIT_V
  lsum += __shfl_xor(lsum, 32);
  const float inv = 1.f / lsum;
  char* stg = lds + w * (32 * 272);
#pragma unroll
  for (int db = 0; db < 2; ++db)
#pragma unroll
    for (int g4 = 0; g4 < 4; ++g4) {
      const int dv = db * 32 + 8 * g4 + 4 * h;
      float4 v;
      if (db == 0) v = make_float4(o0[4 * g4] * inv, o0[4 * g4 + 1] * inv, o0[4 * g4 + 2] * inv, o0[4 * g4 + 3] * inv);
      else         v = make_float4(o1[4 * g4] * inv, o1[4 * g4 + 1] * inv, o1[4 * g4 + 2] * inv, o1[4 * g4 + 3] * inv);
      *(float4*)(stg + r * 272 + dv * 4) = v;
    }
  __syncthreads();
  staged_gate_store<32, 8, 272, false>(stg, lane, gatep + (long)(w * 32) * NP, nullptr, NP, mixp + (long)(w * 32) * 1024, 1024);
  __syncthreads();
}

DI void attn_item64(const u16* __restrict__ Qp, const u16* __restrict__ Kp, const u16* __restrict__ VTp, int q0, int nkeys,
                    const u16* __restrict__ gatep, u16* __restrict__ mixp, char* lds) {
  const int tid = ltid(), w = tid >> 6, lane = tid & 63, r = lane & 31, h = lane >> 5;
  char* Kb0 = lds; char* Vb0 = lds + 2 * AT_KSZ;
  char* qbl = lds + 2 * AT_KSZ + 2 * AT_VSZ + w * (32 * AT_KP) + r * AT_KP + h * 16;
  bf16x8 qa[6];
  {
    const u16* qrow = Qp + (long)(q0 + w * 64 + r) * 96 + h * 8;
#pragma unroll
    for (int s = 0; s < 6; ++s) { qa[s] = *(const bf16x8*)(qrow + s * 16); *(bf16x8*)(qbl + s * 32) = *(const bf16x8*)(qrow + 32 * 96 + s * 16); }
  }
  f32x16 oa0, oa1, ob0, ob1;
#pragma unroll
  for (int e = 0; e < 16; ++e) { oa0[e] = 0.f; oa1[e] = 0.f; ob0[e] = 0.f; ob1[e] = 0.f; }
  float lsa = 0.f, lsb = 0.f;
  const int NT = nkeys >> 6;
  uint2 rkA0, rkA1, rkA2, rkB0, rkB1, rkB2; uint4 rvA, rvB;
  const int kso = (tid >> 3) * AT_KP + (tid & 7) * 24;
  const int vrow = tid >> 3, vc = tid & 7;
#define AT_FETCH_K(S, t) do { const uint2* kt_ = (const uint2*)(Kp + (long)(t) * 64 * 96) + tid * 3; rk##S##0 = kt_[0]; rk##S##1 = kt_[1]; rk##S##2 = kt_[2]; } while (0)
#define AT_FETCH_V(S, t) do { rv##S = *(const uint4*)(VTp + (long)vrow * KPOS + (t) * 64 + vc * 8); } while (0)
#define AT_COMMIT_K(S, buf) do { char* ks_ = Kb0 + (buf) * AT_KSZ + kso; *(uint2*)ks_ = rk##S##0; *(uint2*)(ks_ + 8) = rk##S##1; *(uint2*)(ks_ + 16) = rk##S##2; } while (0)
#define AT_COMMIT_V(S, buf) do { *(uint4*)(Vb0 + (buf) * AT_VSZ + vrow * AT_VP + vc * 16) = (vrow & 16) ? make_uint4(rv##S.z, rv##S.w, rv##S.x, rv##S.y) : rv##S; } while (0)
#define AT_QK_HALF(sa, sb, ks, kb) do { \
    _Pragma("unroll") for (int e = 0; e < 16; ++e) { sa[e] = 0.f; sb[e] = 0.f; } \
    _Pragma("unroll") for (int s_ = 0; s_ < 6; ++s_) { \
      const bf16x8 kf_ = *(const bf16x8*)((ks) + ((kb) * 32 + r) * AT_KP + (2 * s_ + h) * 16); \
      const bf16x8 qf_ = *(const bf16x8*)(qbl + s_ * 32); \
      sa = mfma(kf_, qa[s_], sa); sb = mfma(kf_, qf_, sb); } } while (0)
#define AT_EXP(sx, ls) do { float rs_ = 0.f; \
    _Pragma("unroll") for (int e = 0; e < 16; ++e) { sx[e] = __builtin_amdgcn_exp2f(sx[e]); rs_ += sx[e]; } ls += rs_; } while (0)
#define AT_PV_HALF(pa, pb, vs, kb) do { \
    _Pragma("unroll") for (int sp_ = 0; sp_ < 2; ++sp_) { \
      uint4 wa_, wb_; \
      wa_.x = pk2(pa[8 * sp_ + 0], pa[8 * sp_ + 1]); wa_.y = pk2(pa[8 * sp_ + 2], pa[8 * sp_ + 3]); \
      wa_.z = pk2(pa[8 * sp_ + 4], pa[8 * sp_ + 5]); wa_.w = pk2(pa[8 * sp_ + 6], pa[8 * sp_ + 7]); \
      wb_.x = pk2(pb[8 * sp_ + 0], pb[8 * sp_ + 1]); wb_.y = pk2(pb[8 * sp_ + 2], pb[8 * sp_ + 3]); \
      wb_.z = pk2(pb[8 * sp_ + 4], pb[8 * sp_ + 5]); wb_.w = pk2(pb[8 * sp_ + 6], pb[8 * sp_ + 7]); \
      const bf16x8 fa_ = __builtin_bit_cast(bf16x8, wa_), fb_ = __builtin_bit_cast(bf16x8, wb_); \
      const int keyoff_ = 32 * (kb) + 16 * sp_ + 4 * h; \
      { const char* vr_ = (vs) + r * AT_VP + ((keyoff_ * 2) ^ ((r & 16) >> 1)); \
        const uint2 lo_ = *(const uint2*)vr_, hi_ = *(const uint2*)(vr_ + 16); \
        const bf16x8 vf_ = __builtin_bit_cast(bf16x8, make_uint4(lo_.x, lo_.y, hi_.x, hi_.y)); \
        oa0 = mfma(vf_, fa_, oa0); ob0 = mfma(vf_, fb_, ob0); } \
      { const char* vr_ = (vs) + (32 + r) * AT_VP + ((keyoff_ * 2) ^ ((r & 16) >> 1)); \
        const uint2 lo_ = *(const uint2*)vr_, hi_ = *(const uint2*)(vr_ + 16); \
        const bf16x8 vf_ = __builtin_bit_cast(bf16x8, make_uint4(lo_.x, lo_.y, hi_.x, hi_.y)); \
        oa1 = mfma(vf_, fa_, oa1); ob1 = mfma(vf_, fb_, ob1); } } } while (0)
#define AT_TRIP64(t, FS, CS) do { \
    { const int tn_ = ((t) + 2 < NT) ? (t) + 2 : NT - 1; AT_FETCH_K(FS, tn_); AT_FETCH_V(FS, tn_); } \
    const char* ks = Kb0 + ((t) & 1) * AT_KSZ; const char* vs = Vb0 + ((t) & 1) * AT_VSZ; \
    { f32x16 sa0, sb0; \
      AT_QK_HALF(sa0, sb0, ks, 0); \
      AT_EXP(sa0, lsa); AT_EXP(sb0, lsb); \
      AT_PV_HALF(sa0, sb0, vs, 0); } \
    __builtin_amdgcn_sched_barrier(0); \
    { f32x16 sa1, sb1; \
      AT_QK_HALF(sa1, sb1, ks, 1); \
      AT_EXP(sa1, lsa); AT_EXP(sb1, lsb); \
      AT_PV_HALF(sa1, sb1, vs, 1); } \
    __builtin_amdgcn_sched_barrier(0); \
    AT_COMMIT_K(CS, ((t) + 1) & 1); AT_COMMIT_V(CS, ((t) + 1) & 1); \
    __syncthreads(); } while (0)
  AT_FETCH_K(A, 0); AT_FETCH_V(A, 0);
  AT_COMMIT_K(A, 0); AT_COMMIT_V(A, 0);
  AT_FETCH_K(B, 1); AT_FETCH_V(B, 1);
  __syncthreads();
  for (int t = 0; t < NT; t += 2) {
    AT_TRIP64(t, A, B);
    AT_TRIP64(t + 1, B, A);
  }
#undef AT_TRIP64
#undef AT_PV_HALF
#undef AT_EXP
#undef AT_QK_HALF
#undef AT_FETCH_K
#undef AT_FETCH_V
#undef AT_COMMIT_K
#undef AT_COMMIT_V
  lsa += __shfl_xor(lsa, 32); lsb += __shfl_xor(lsb, 32);
  const float ia = 1.f / lsa, ib = 1.f / lsb;
  char* stg = lds + w * (32 * 272);
#pragma unroll
  for (int blk = 0; blk < 2; ++blk) {
#pragma unroll
    for (int db = 0; db < 2; ++db)
#pragma unroll
      for (int g4 = 0; g4 < 4; ++g4) {
        const int dv = db * 32 + 8 * g4 + 4 * h;
        float4 v;
        if (blk == 0) { if (db == 0) v = make_float4(oa0[4 * g4] * ia, oa0[4 * g4 + 1] * ia, oa0[4 * g4 + 2] * ia, oa0[4 * g4 + 3] * ia);
                        else         v = make_float4(oa1[4 * g4] * ia, oa1[4 * g4 + 1] * ia, oa1[4 * g4 + 2] * ia, oa1[4 * g4 + 3] * ia); }
        else          { if (db == 0) v = make_float4(ob0[4 * g4] * ib, ob0[4 * g4 + 1] * ib, ob0[4 * g4 + 2] * ib, ob0[4 * g4 + 3] * ib);
                        else         v = make_float4(ob1[4 * g4] * ib, ob1[4 * g4 + 1] * ib, ob1[4 * g4 + 2] * ib, ob1[4 * g4 + 3] * ib); }
        *(float4*)(stg + r * 272 + dv * 4) = v;
      }
    const SgPre<4> gpre = staged_gate_fetch<32, 8, false>(lane, gatep + (long)(w * 64 + blk * 32) * NP, nullptr, NP);
    __syncthreads();
    staged_gate_finish<32, 8, 272, false>(stg, lane, gpre, mixp + (long)(w * 64 + blk * 32) * 1024, 1024);
    __syncthreads();
  }
}


__global__ void __launch_bounds__(NT_) fwd_megakernel(Params p) {
  extern __shared__ __attribute__((aligned(16))) char lds[];
  cg::grid_group grid = cg::this_grid();
  const int tid = threadIdx.x, bid = blockIdx.x, nblk = gridDim.x;
  __shared__ uint4 xb_words;
  if (tid == 0) xb_words = make_uint4(0u, 0u, 0u, 0u);
  __syncthreads();
  const XcdBarrier xb = xcd_barrier_post(p.bar, (volatile LAS unsigned*)&xb_words);
  const long gtid = (long)bid * NT_ + tid, gnth = (long)nblk * NT_;

  {
    float* tile = (float*)lds;
    constexpr int T_WIN = 16 * 35, T_WOUT = 16 * 16, T_WUQ = 4 * 12, T_WUKV = 2 * 16;
    constexpr int T_L = T_WIN + T_WOUT + T_WUQ + T_WUKV;
    struct TP { const float* src; u16* dst; const float* kg; int K, N, kt, nt, remap; };
    auto tparams = [&](int it) {
      TP q; const int l = it / T_L; int t = it % T_L;
      if (t < T_WIN) { q.src = p.w_in + (long)l * 1024 * INW; q.dst = p.win_t + (long)l * NP * 1024; q.K = 1024; q.N = INW; q.kt = t / 35; q.nt = t % 35; q.remap = 0; q.kg = nullptr; }
      else if ((t -= T_WIN) < T_WOUT) { q.src = p.w_out + (long)l * 1024 * 1024; q.dst = p.wout_t + (long)l * 1024 * 1024; q.K = 1024; q.N = 1024; q.kt = t / 16; q.nt = t % 16; q.remap = 0; q.kg = nullptr; }
      else if ((t -= T_WOUT) < T_WUQ) { q.src = p.w_uq + (long)l * 256 * 768; q.dst = p.wuq_t + (long)l * 768 * 256; q.K = 256; q.N = 768; q.kt = t / 12; q.nt = t % 12; q.remap = 0; q.kg = p.q_a_g + l * 256; }
      else { t -= T_WUQ; q.src = p.w_ukv + (long)l * 128 * 1024; q.dst = p.wukv_t + (long)l * 1024 * 128; q.K = 128; q.N = 1024; q.kt = t / 16; q.nt = t % 16; q.remap = 1; q.kg = p.kv_a_g + l * 128; }
      return q;
    };
    float pv[8];
    auto tload = [&](const TP& q) {
#pragma unroll
      for (int i = 0; i < 8; ++i) {
        const int kk = i * 8 + (tid >> 6), nn = tid & 63;
        const int n = q.nt * 64 + nn;
        pv[i] = (n < q.N) ? q.src[(long)(q.kt * 64 + kk) * q.N + n] * (q.kg ? q.kg[q.kt * 64 + kk] : 1.f) : 0.f;
      }
    };
    if (bid < T_L * DEPTH) { const TP q0 = tparams(bid); tload(q0); }
    for (int it = bid; it < T_L * DEPTH; it += nblk) {
      const TP q = tparams(it);
#pragma unroll
      for (int i = 0; i < 8; ++i) tile[(i * 8 + (tid >> 6)) * 65 + (tid & 63)] = pv[i];
      __syncthreads();
      if (it + nblk < T_L * DEPTH) { const TP qn = tparams(it + nblk); tload(qn); }
      {
        const int nl = tid >> 3, kc = (tid & 7) * 8;
        const int n = q.nt * 64 + nl;
        if (n < q.N) {
          int dn = n;
          if (q.remap) { const int hh = n >> 7, dd = n & 127; dn = (dd < 64) ? (hh * 64 + dd) : (512 + hh * 64 + dd - 64); }
          uint4 o;
          o.x = pk2(tile[(kc + 0) * 65 + nl], tile[(kc + 1) * 65 + nl]);
          o.y = pk2(tile[(kc + 2) * 65 + nl], tile[(kc + 3) * 65 + nl]);
          o.z = pk2(tile[(kc + 4) * 65 + nl], tile[(kc + 5) * 65 + nl]);
          o.w = pk2(tile[(kc + 6) * 65 + nl], tile[(kc + 7) * 65 + nl]);
          *(uint4*)(q.dst + (long)dn * q.K + q.kt * 64 + kc) = o;
        }
      }
      __syncthreads();
    }
    for (long i = gtid; i < (long)DEPTH * (NP - INW) * 1024; i += gnth) {
      const int l = (int)(i / ((NP - INW) * 1024)); const long rem = i % ((NP - INW) * 1024);
      p.win_t[((long)l * NP + INW) * 1024 + rem] = 0;
    }
    for (long i = gtid; i < (long)DEPTH * 4 * 128 * 128; i += gnth) p.gws_b[i] = f2bf(p.g_ws[i]);
    for (long i = gtid; i < 128 * 64; i += gnth) {
      const int rho = (int)(i >> 6), n1 = (int)(i & 63);
      const int blk = rho >> 5, k1 = (blk >> 1) * 32 + (rho & 31), part = blk & 1;
      const int mm = (k1 * n1) & 63;
      p.t1[i] = f2bf(part == 0 ? cospif(mm * (1.f / 32.f)) : -sinpif(mm * (1.f / 32.f)));
    }
    for (long i = gtid; i < 128 * 128; i += gnth) {
      const int rho = (int)(i >> 7), kk = (int)(i & 127);
      const int rio = rho >> 6, k2 = rho & 63, n2 = kk >> 1, rii = kk & 1;
      const int mm = (n2 * k2) & 63;
      const float c = cospif(mm * (1.f / 32.f)), s = sinpif(mm * (1.f / 32.f));
      p.t2[i] = f2bf(rio == 0 ? (rii == 0 ? c : s) : (rii == 0 ? -s : c));
    }
    for (long i = gtid; i < 512 * 256; i += gnth) {
      const int rho = (int)(i >> 8), n = (int)(i & 255);
      const int ri = rho >> 8, k = rho & 255;
      const int mm = (k * n) & 255;
      p.t256[i] = f2bf(ri == 0 ? cospif(mm * (1.f / 128.f)) : -sinpif(mm * (1.f / 128.f)));
    }
    for (long i = gtid; i < 4096; i += gnth) {
      p.tw[2 * i] = cospif((float)i * (1.f / 2048.f)); p.tw[2 * i + 1] = sinpif((float)i * (1.f / 2048.f));
    }
    for (long i = gtid; i < 64 * 8; i += gnth) {
      const int pos = (int)(i >> 3), jj = (int)(i & 7);
      const float ang = (float)pos * exp2f(-(float)jj * 1.6609640474436813f);
      p.rope[2 * i] = __cosf(ang); p.rope[2 * i + 1] = __sinf(ang);
    }
    for (long i = gtid; i < (long)DEPTH * 256 * 512; i += gnth) {
      const int n = (int)(i & 255), kidx = (int)((i >> 8) & 511), l = (int)(i >> 17);
      const int g = kidx >> 7, j = kidx & 127, jj = j & 63;
      const float* wf = p.w_fmix + (long)l * 256 * 256 + (long)(g * 64) * 256 + n;
      float acc = 0.f;
      for (int c0 = 0; c0 < 64; c0 += 16) {
        float wv[16];
#pragma unroll
        for (int u = 0; u < 16; ++u) wv[u] = wf[(long)(c0 + u) * 256];
#pragma unroll
        for (int u = 0; u < 16; ++u) {
          const int mm = (jj * (c0 + u)) & 63;
          const float coef = (j < 64) ? cospif(mm * (1.f / 32.f)) : sinpif(mm * (1.f / 32.f));
          acc += coef * wv[u];
        }
      }
      p.mf_t[((long)l * 256 + n) * 512 + kidx] = f2bf(acc);
    }
    {
      float* sl = (float*)lds;
      float* red = sl + 9 * 1024;
      __syncthreads();
      for (int i = tid; i < 9 * 1024; i += NT_) {
        const int rr = i >> 10, kk = i & 1023;
        const float v = (rr < 8) ? p.c[rr * 1024 + kk] : p.c_ctx[kk];
        sl[i] = silu(v);
      }
      __syncthreads();
      for (int it = bid; it < DEPTH * 96; it += nblk) {
        const int l = it / 96, cgp = it % 96;
        const int cj = tid & 31, ksl = tid >> 5;
        const float* wm = p.w_mod + (long)l * 1024 * 3072 + cgp * 32 + cj;
        float a[9];
#pragma unroll
        for (int rr = 0; rr < 9; ++rr) a[rr] = 0.f;
        for (int k0 = ksl * 64; k0 < ksl * 64 + 64; k0 += 16) {
          float wv[16];
#pragma unroll
          for (int u = 0; u < 16; ++u) wv[u] = wm[(long)(k0 + u) * 3072];
#pragma unroll
          for (int u = 0; u < 16; ++u)
#pragma unroll
            for (int rr = 0; rr < 9; ++rr) a[rr] += sl[rr * 1024 + k0 + u] * wv[u];
        }
#pragma unroll
        for (int rr = 0; rr < 9; ++rr) red[(ksl * 9 + rr) * 32 + cj] = a[rr];
        __syncthreads();
        if (tid < 288) {
          const int rr = tid >> 5, c2 = tid & 31;
          float s = 0.f;
          for (int q = 0; q < 16; ++q) s += red[(q * 9 + rr) * 32 + c2];
          const int col = cgp * 32 + c2;
          p.mod[((long)l * 9 + rr) * 3072 + col] = s + p.b_mod[l * 3072 + col];
        }
        __syncthreads();
      }
    }
  }
  grid.sync();

  for (int l = 0; l < DEPTH; ++l) {
    const int tid = ltid();
    const float* modl = p.mod + (long)l * 9 * 3072;
    {
      const float* ng = p.norm_g + l * 1024;
      const int lane = tid & 63, wv = tid >> 6;
      float4 g4[4];
#pragma unroll
      for (int i = 0; i < 4; ++i) g4[i] = *(const float4*)(ng + i * 256 + lane * 4);
      const int rstep = nblk * 8;
      float4 v[4], sh[4], sc[4];
#define N_LOAD(row_, vv, shh, scc) do { \
        const int rw_ = (row_) < MT ? (row_) : MT - 1; \
        const float* src_; int mr_; \
        if (rw_ < MX) { src_ = (l == 0 ? p.x : p.out) + (long)rw_ * 1024; mr_ = rw_ >> 12; } \
        else { src_ = (l == 0 ? p.ctx : p.yw) + (long)(rw_ - MX) * 1024; mr_ = 8; } \
        const float* md_ = modl + mr_ * 3072; \
        _Pragma("unroll") for (int i = 0; i < 4; ++i) { const int k0_ = i * 256 + lane * 4; \
          vv[i] = *(const float4*)(src_ + k0_); shh[i] = *(const float4*)(md_ + k0_); scc[i] = *(const float4*)(md_ + 1024 + k0_); } } while (0)
      int row = bid * 8 + wv;
      N_LOAD(row, v, sh, sc);
      for (; row < MT; row += rstep) {
        float4 vn[4], shn[4], scn[4];
        N_LOAD(row + rstep, vn, shn, scn);
        float ss = 0.f;
#pragma unroll
        for (int i = 0; i < 4; ++i) ss += v[i].x * v[i].x + v[i].y * v[i].y + v[i].z * v[i].z + v[i].w * v[i].w;
#pragma unroll
        for (int o = 1; o < 64; o <<= 1) ss += __shfl_xor(ss, o);
        const float rs = rsqrtf(ss * (1.f / 1024.f) + EPS);
#pragma unroll
        for (int i = 0; i < 4; ++i) {
          const int k0 = i * 256 + lane * 4;
          uint2 o;
          o.x = pk2(v[i].x * rs * g4[i].x * (1.f + sc[i].x) + sh[i].x, v[i].y * rs * g4[i].y * (1.f + sc[i].y) + sh[i].y);
          o.y = pk2(v[i].z * rs * g4[i].z * (1.f + sc[i].z) + sh[i].z, v[i].w * rs * g4[i].w * (1.f + sc[i].w) + sh[i].w);
          *(uint2*)(p.hmix + (long)row * 1024 + k0) = o;
        }
#pragma unroll
        for (int i = 0; i < 4; ++i) { v[i] = vn[i]; sh[i] = shn[i]; sc[i] = scn[i]; }
      }
#undef N_LOAD
    }
    xcd_barrier(xb);

    {
      const u16* wt = p.win_t + (long)l * NP * 1024;
      u16* P = p.p;
      int m0 = 0, n0 = 0;
      auto epi = [&](auto& acc, int mw, int nw, int r, int h) {
        constexpr int WM_ = sizeof(acc) / sizeof(acc[0]), WN_ = sizeof(acc[0]) / sizeof(acc[0][0]);
        constexpr int SP = WN_ * 64 + 16;
        constexpr int CH = WN_ * 4;
        const int wv = ltid() >> 6, lane = h * 32 + r;
        char* st = lds + wv * (WM_ * 32 * SP);
        if (n0 + nw >= C_CQ && n0 + nw < C_KROPE) {
#pragma unroll
          for (int i = 0; i < WM_; ++i)
#pragma unroll
            for (int j = 0; j < WN_; ++j) {
              float ss = 0.f;
#pragma unroll
              for (int e = 0; e < 16; ++e) ss += acc[i][j][e] * acc[i][j][e];
              ss += __shfl_xor(ss, 32);
              if (h == 0) p.stats[(long)(m0 + mw + i * 32 + r) * 16 + ((n0 + nw + j * 32 - C_CQ) >> 5)] = ss;
            }
        }
#pragma unroll
        for (int i = 0; i < WM_; ++i)
#pragma unroll
          for (int j = 0; j < WN_; ++j)
#pragma unroll
            for (int g4 = 0; g4 < 4; ++g4) {
              uint2 o;
              o.x = pk2(acc[i][j][4 * g4], acc[i][j][4 * g4 + 1]); o.y = pk2(acc[i][j][4 * g4 + 2], acc[i][j][4 * g4 + 3]);
              *(uint2*)(st + (i * 32 + r) * SP + (j * 32 + 8 * g4 + 4 * h) * 2) = o;
            }
        __syncthreads();
#pragma unroll
        for (int q = 0; q < WM_ * 32 * CH / 64; ++q) {
          const int id = q * 64 + lane; const int row = id / CH, c = id % CH;
          const uint4 v = *(const uint4*)(st + row * SP + c * 16);
          *(uint4*)(P + (long)(m0 + mw + row) * NP + n0 + nw + c * 8) = v;
        }
        __syncthreads();
      };
      {
        auto mkl = [&](int j, LdDirect<256>& la, LdDirect<128>& lb) {
          const int mt = (j / 18) * 8 + (bid & 7), nt = j % 18;
          la.base = p.hmix + (long)mt * 256 * 1024; la.ld = 1024; lb.base = wt + (long)nt * 128 * 1024; lb.ld = 1024; };
        auto set = [&](int j) { m0 = ((j / 18) * 8 + (bid & 7)) * 256; n0 = (j % 18) * 128; };
        gemm_loop3<16, 4, 2, 2, true, false, LdDirect<256>, LdDirect<128>>(bid >> 3, 16 * 18, nblk >> 3, mkl, set, epi, lds);
      }
      {
        const int nty = (l == DEPTH - 1) ? 3 : 36, nt0 = (l == DEPTH - 1) ? 24 : 0;
        auto mkl = [&](int it, LdDirect<128>& la, LdDirect<64>& lb) {
          const int mt = it / nty, nt = nt0 + it % nty;
          la.base = p.hmix + (long)(MX + mt * 128) * 1024; la.ld = 1024; lb.base = wt + (long)nt * 64 * 1024; lb.ld = 1024; };
        auto set = [&](int it) { m0 = MX + (it / nty) * 128; n0 = (nt0 + it % nty) * 64; };
        gemm_loop<4, 1, 1, true, false, LdDirect<128>, LdDirect<64>>(bid, 16 * nty, nblk, mkl, set, epi, 16, lds);
      }
    }
    xcd_barrier(xb);

    {
      constexpr int nKN = 136 * 4, nV = 136 * 4, nF1 = 1024;
      const int nQ = (l == DEPTH - 1) ? 256 * 4 : 272 * 4, nFy = (l == DEPTH - 1) ? 0 : 64, nG = (l == DEPTH - 1) ? 256 : 272;
      float* rstd_s = (float*)(lds + RSTD_OFF);
#define FIRST(off) ((bid + nblk - ((off) % nblk)) % nblk)
      {
        int m0 = 0, n0 = 0;
        auto mkl = [&](int it, LdDirect<128>& la, LdDirect<192>& lb) {
          const int mt = it >> 2, nt = it & 3;
          la.base = p.p + (long)mt * 128 * NP + C_CQ; la.ld = NP;
          lb.base = p.wuq_t + ((long)l * 768 + nt * 192) * 256; lb.ld = 256; };
        auto set = [&](int it) { m0 = (it >> 2) * 128; n0 = (it & 3) * 192; };
        const float* qg = p.q_norm_g + l * 96;
        u16* Qb = p.q; const float* ROPE = p.rope;
        auto epi = [&](f32x16 (&acc)[1][3], int mw, int nw, int r, int h) {
          const int head = (n0 + nw) / 96;
          const float QS = 0.10206207261596575f * 1.4426950408889634f;
          const int m = m0 + mw + r;
          float ss = 0.f;
#pragma unroll
          for (int j = 0; j < 3; ++j)
#pragma unroll
            for (int e = 0; e < 16; ++e) ss += acc[0][j][e] * acc[0][j][e];
          ss += __shfl_xor(ss, 32);
          const float4 sa = *(const float4*)(p.stats + (long)m * 16), sb = *(const float4*)(p.stats + (long)m * 16 + 4);
          const float msq = (sa.x + sa.y + sa.z + sa.w + sb.x + sb.y + sb.z + sb.w) * (1.f / 256.f) + EPS;
          const float rs = rsqrtf(ss * (1.f / 96.f) + EPS * msq);
          int b, pos; bool isx; int irow = 0, icol = 0;
          if (m < MX) { b = m >> 12; const int n = m & 4095; pos = CTX + n; isx = true; irow = n >> 6; icol = n & 63; }
          else { const int my = m - MX; b = my >> 8; pos = my & 255; isx = false; }
          float2 tr[4], tc[4];
#pragma unroll
          for (int e = 0; e < 4; ++e) { tr[e] = *(const float2*)(ROPE + (irow * 8 + 4 * h + e) * 2); tc[e] = *(const float2*)(ROPE + (icol * 8 + 4 * h + e) * 2); }
          const int wv = ltid() >> 6;
          char* stg = lds + wv * (32 * 208);
          u16* qd = (u16*)(stg + r * 208);
#pragma unroll
          for (int j = 0; j < 2; ++j)
#pragma unroll
            for (int g4 = 0; g4 < 4; ++g4) {
              const int f0 = j * 32 + 8 * g4 + 4 * h;
              const float4 g = *(const float4*)(qg + f0);
              uint2 o;
              o.x = pk2(acc[0][j][4 * g4] * rs * g.x * QS, acc[0][j][4 * g4 + 1] * rs * g.y * QS);
              o.y = pk2(acc[0][j][4 * g4 + 2] * rs * g.z * QS, acc[0][j][4 * g4 + 3] * rs * g.w * QS);
              *(uint2*)(qd + f0) = o;
            }
          float x1[4], x2[4], x3[4], x4[4];
          {
            const float4 g1 = *(const float4*)(qg + 64 + 4 * h), g2 = *(const float4*)(qg + 72 + 4 * h);
            const float4 g3 = *(const float4*)(qg + 80 + 4 * h), g4v = *(const float4*)(qg + 88 + 4 * h);
            const float s = rs * QS;
            x1[0] = acc[0][2][0] * s * g1.x; x1[1] = acc[0][2][1] * s * g1.y; x1[2] = acc[0][2][2] * s * g1.z; x1[3] = acc[0][2][3] * s * g1.w;
            x2[0] = acc[0][2][4] * s * g2.x; x2[1] = acc[0][2][5] * s * g2.y; x2[2] = acc[0][2][6] * s * g2.z; x2[3] = acc[0][2][7] * s * g2.w;
            x3[0] = acc[0][2][8] * s * g3.x; x3[1] = acc[0][2][9] * s * g3.y; x3[2] = acc[0][2][10] * s * g3.z; x3[3] = acc[0][2][11] * s * g3.w;
            x4[0] = acc[0][2][12] * s * g4v.x; x4[1] = acc[0][2][13] * s * g4v.y; x4[2] = acc[0][2][14] * s * g4v.z; x4[3] = acc[0][2][15] * s * g4v.w;
          }
          if (isx) {
#pragma unroll
            for (int e = 0; e < 4; ++e) {
              const float cr = tr[e].x, sr = tr[e].y, cc = tc[e].x, sc = tc[e].y;
              const float a1 = x1[e] * cr - x2[e] * sr, a2 = x2[e] * cr + x1[e] * sr;
              const float a3 = x3[e] * cc - x4[e] * sc, a4 = x4[e] * cc + x3[e] * sc;
              x1[e] = a1; x2[e] = a2; x3[e] = a3; x4[e] = a4;
            }
          }
          uint2 o;
          o.x = pk2(x1[0], x1[1]); o.y = pk2(x1[2], x1[3]); *(uint2*)(qd + 64 + 4 * h) = o;
          o.x = pk2(x2[0], x2[1]); o.y = pk2(x2[2], x2[3]); *(uint2*)(qd + 72 + 4 * h) = o;
          o.x = pk2(x3[0], x3[1]); o.y = pk2(x3[2], x3[3]); *(uint2*)(qd + 80 + 4 * h) = o;
          o.x = pk2(x4[0], x4[1]); o.y = pk2(x4[2], x4[3]); *(uint2*)(qd + 88 + 4 * h) = o;
          __syncthreads();
          {
            const int m_0 = m0 + mw;
            int b0, pos0;
            if (m_0 < MX) { b0 = m_0 >> 12; pos0 = CTX + (m_0 & 4095); } else { const int my = m_0 - MX; b0 = my >> 8; pos0 = my & 255; }
            u16* dst = Qb + ((long)(b0 * 8 + head) * KPOS + pos0) * 96;
            const int lane = h * 32 + r;
#pragma unroll
            for (int q = 0; q < 6; ++q) {
              const int id = q * 64 + lane; const int row = id / 12, c = id % 12;
              *(uint4*)(dst + id * 8) = *(const uint4*)(stg + row * 208 + c * 16);
            }
          }
          __syncthreads();
        };
        gemm_loop<4, 1, 3, true, false, LdDirect<128>, LdDirect<192>>(FIRST(0), nQ, nblk, mkl, set, epi, 4, lds);
      }
      {
        int m0 = 0, n0 = 0;
        auto set = [&](int it) { m0 = (it >> 2) * 256; n0 = (it & 3) * 128; };
        {
          auto mkl = [&](int it, LdDirect<256>& la, LdDirect<128>& lb) {
            const int mt = it >> 2, nt = it & 3;
            la.base = p.p + (long)mt * 256 * NP + C_CKV; la.ld = NP;
            lb.base = p.wukv_t + ((long)l * 1024 + nt * 128) * 128; lb.ld = 128; };
          const float* kg = p.k_norm_g + l * 96;
          u16* Kb = p.k; const u16* P = p.p; const float* ROPE = p.rope;
          auto epi = [&](f32x16 (&acc)[2][2], int mw, int nw, int r, int h) {
            const int head = (n0 + nw) >> 6;
#pragma unroll
            for (int i = 0; i < 2; ++i) {
              const int m = m0 + mw + i * 32 + r;
              float kr[16];
              { const u16* kp = P + (long)m * NP + C_KROPE + 16 * h;
                unpack8(*(const uint4*)kp, kr); unpack8(*(const uint4*)(kp + 8), kr + 8); }
              int b, pos; bool isx; int ipos = 0;
              if (m < MX) { b = m >> 12; const int n = m & 4095; pos = CTX + n; isx = true; ipos = h ? (n & 63) : (n >> 6); }
              else { const int my = m - MX; b = my >> 8; pos = my & 255; isx = false; }
              float2 tr[8];
#pragma unroll
              for (int e = 0; e < 8; ++e) tr[e] = *(const float2*)(ROPE + (ipos * 8 + e) * 2);
              const float4 sk = *(const float4*)(p.stats + (long)m * 16 + 8);
              const float rkv2 = 1.f / ((sk.x + sk.y + sk.z + sk.w) * (1.f / 128.f) + EPS);
              float ssr = 0.f, ssn = 0.f;
#pragma unroll
              for (int e = 0; e < 16; ++e) ssr += kr[e] * kr[e];
#pragma unroll
              for (int j = 0; j < 2; ++j)
#pragma unroll
                for (int e = 0; e < 16; ++e) ssn += acc[i][j][e] * acc[i][j][e];
              float ss = ssr + ssn * rkv2;
              ss += __shfl_xor(ss, 32);
              const float rs = rsqrtf(ss * (1.f / 96.f) + EPS);
              const float rsn = rs * sqrtf(rkv2);
              u16* kd = (u16*)(lds + (ltid() >> 6) * (64 * 208) + (i * 32 + r) * 208);
#pragma unroll
              for (int j = 0; j < 2; ++j)
#pragma unroll
                for (int g4 = 0; g4 < 4; ++g4) {
                  const int f0 = j * 32 + 8 * g4 + 4 * h;
                  const float4 g = *(const float4*)(kg + f0);
                  uint2 o;
                  o.x = pk2(acc[i][j][4 * g4] * rsn * g.x, acc[i][j][4 * g4 + 1] * rsn * g.y);
                  o.y = pk2(acc[i][j][4 * g4 + 2] * rsn * g.z, acc[i][j][4 * g4 + 3] * rsn * g.w);
                  *(uint2*)(kd + f0) = o;
                }
              float oa[8], ob[8];
#pragma unroll
              for (int e = 0; e < 8; ++e) {
                const float xa = kr[e] * rs * kg[64 + 16 * h + e], xb = kr[8 + e] * rs * kg[64 + 16 * h + 8 + e];
                if (isx) { const float cs = tr[e].x, sn = tr[e].y; oa[e] = xa * cs - xb * sn; ob[e] = xb * cs + xa * sn; }
                else { oa[e] = xa; ob[e] = xb; }
              }
              uint4 o;
              o.x = pk2(oa[0], oa[1]); o.y = pk2(oa[2], oa[3]); o.z = pk2(oa[4], oa[5]); o.w = pk2(oa[6], oa[7]);
              *(uint4*)(kd + 64 + 16 * h) = o;
              o.x = pk2(ob[0], ob[1]); o.y = pk2(ob[2], ob[3]); o.z = pk2(ob[4], ob[5]); o.w = pk2(ob[6], ob[7]);
              *(uint4*)(kd + 64 + 16 * h + 8) = o;
            }
            __syncthreads();
            {
              const char* stg = lds + (ltid() >> 6) * (64 * 208);
              const int m_0 = m0 + mw;
              int b0, pos0;
              if (m_0 < MX) { b0 = m_0 >> 12; pos0 = CTX + (m_0 & 4095); } else { const int my = m_0 - MX; b0 = my >> 8; pos0 = my & 255; }
              u16* dst = Kb + ((long)(b0 * 8 + head) * KPOS + pos0) * 96;
              const int lane = h * 32 + r;
#pragma unroll
              for (int q = 0; q < 12; ++q) {
                const int id = q * 64 + lane; const int row = id / 12, c = id % 12;
                *(uint4*)(dst + id * 8) = *(const uint4*)(stg + row * 208 + c * 16);
              }
            }
            __syncthreads();
          };
          gemm_loop<4, 2, 2, true, false, LdDirect<256>, LdDirect<128>>(FIRST(64), nKN, nblk, mkl, set, epi, 2, lds);
        }
        {
          auto mkl = [&](int it, LdDirect<256>& la, LdDirect<128>& lb) {
            const int mt = it >> 2, nt = it & 3;
            la.base = p.p + (long)mt * 256 * NP + C_CKV; la.ld = NP;
            lb.base = p.wukv_t + ((long)l * 1024 + 512 + nt * 128) * 128; lb.ld = 128; };
          u16* VT = p.vt;
          auto epi = [&](f32x16 (&acc)[2][2], int mw, int nw, int r, int h) {
            char* stg = lds + (ltid() >> 6) * (64 * 144);
            const int m_0 = m0 + mw;
#pragma unroll
            for (int i = 0; i < 2; ++i)
#pragma unroll
              for (int g4 = 0; g4 < 4; ++g4) {
                const int tl = i * 32 + 8 * g4 + 4 * h;
                float rv[4];
#pragma unroll
                for (int e = 0; e < 4; ++e) { const float4 sk = *(const float4*)(p.stats + (long)(m_0 + tl + e) * 16 + 8);
                  rv[e] = rsqrtf((sk.x + sk.y + sk.z + sk.w) * (1.f / 128.f) + EPS); }
#pragma unroll
                for (int j = 0; j < 2; ++j) {
                  uint2 o;
                  o.x = pk2(acc[i][j][4 * g4] * rv[0], acc[i][j][4 * g4 + 1] * rv[1]); o.y = pk2(acc[i][j][4 * g4 + 2] * rv[2], acc[i][j][4 * g4 + 3] * rv[3]);
                  *(uint2*)(stg + (j * 32 + r) * 144 + tl * 2) = o;
                }
              }
            __syncthreads();
            {
              int b0, pos0;
              if (m_0 < MX) { b0 = m_0 >> 12; pos0 = CTX + (m_0 & 4095); } else { const int my = m_0 - MX; b0 = my >> 8; pos0 = my & 255; }
              const int head = (n0 + nw) >> 6;
              u16* dst = VT + ((long)(b0 * 8 + head) * 64) * KPOS + pos0;
              const int lane = h * 32 + r;
#pragma unroll
              for (int q = 0; q < 8; ++q) {
                const int id = q * 64 + lane; const int dv = id >> 3, c = id & 7;
                *(uint4*)(dst + (long)dv * KPOS + c * 8) = *(const uint4*)(stg + dv * 144 + c * 16);
              }
            }
            __syncthreads();
          };
          gemm_loop<4, 2, 2, false, false, LdDirect<256>, LdDirect<128>>(FIRST(96), nV, nblk, mkl, set, epi, 2, lds);
        }
      }
      {
        int half = 0, n2 = 0, b = 0;
        auto mkl = [&](int it, LdDirect<128>& la, LdTrans<128>& lb) {
          const int half_ = it & 1, n2_ = (it >> 1) & 63, b_ = it >> 7;
          la.base = p.t1; la.ld = 64;
          lb.base = p.p + (long)(b_ * 4096 + n2_) * NP + C_FIN + half_ * 128; lb.strideK = 64L * NP; };
        auto set = [&](int it) { half = it & 1; n2 = (it >> 1) & 63; b = it >> 7; };
        u16* A1 = p.a1; const float* TW = p.tw;
        auto epi = [&](f32x16 (&acc)[2][1], int mw, int nw, int r, int h) {
          const int gc = half * 128 + nw + r;
          float2 t[16];
#pragma unroll
          for (int e = 0; e < 16; ++e) { const float fr = (float)(n2 * ((mw >> 1) + crow(e, h))) * (1.f / 4096.f);
            t[e] = make_float2(__builtin_amdgcn_cosf(fr), __builtin_amdgcn_sinf(fr)); }
#pragma unroll
          for (int e = 0; e < 16; ++e) {
            const int k1 = (mw >> 1) + crow(e, h);
            const float re = acc[0][0][e], im = acc[1][0][e];
            const float re2 = re * t[e].x + im * t[e].y, im2 = im * t[e].x - re * t[e].y;
            const long o = ((((long)b * 64 + k1) * 64 + n2) * 2) * 256 + gc;
            A1[o] = f2bf(re2); A1[o + 256] = f2bf(im2);
          }
        };
        gemm_loop<2, 2, 1, false, true, LdDirect<128>, LdTrans<128>>(FIRST(0), nF1, nblk, mkl, set, epi, 1, lds);
      }
      {
        int half = 0, mt = 0, b = 0;
        auto mkl = [&](int it, LdDirect<128>& la, LdTrans<128>& lb) {
          const int half_ = it & 1, mt_ = (it >> 1) & 3, b_ = it >> 3;
          la.base = p.t256 + (long)mt_ * 128 * 256; la.ld = 256;
          lb.base = p.p + (long)(MX + b_ * 256) * NP + C_FIN + half_ * 128; lb.strideK = (long)NP; };
        auto set = [&](int it) { half = it & 1; mt = (it >> 1) & 3; b = it >> 3; };
        u16* YF = p.yf;
        auto epi = [&](f32x16 (&acc)[1][2], int mw, int nw, int r, int h) {
#pragma unroll
          for (int j = 0; j < 2; ++j) {
            const int gc = half * 128 + nw + j * 32 + r; const int g = gc >> 6, c2 = gc & 63;
#pragma unroll
            for (int e = 0; e < 16; ++e) {
              const int rho = mt * 128 + mw + crow(e, h); const int ri = rho >> 8, k = rho & 255;
              YF[(long)(MX + b * 256 + k) * 512 + g * 128 + ri * 64 + c2] = f2bf(acc[0][j][e]);
            }
          }
        };
        gemm_loop<4, 1, 2, false, true, LdDirect<128>, LdTrans<128>>(FIRST(128), nFy, nblk, mkl, set, epi, 4, lds);
      }
      {
        int hd = 0, row0 = 0;
        auto mkl = [&](int it, LdDirect<128>& la, LdLN4& lb) {
          const int hd_ = it & 3, qd_ = it >> 2;
          la.base = p.gws_b + (long)(l * 4 + hd_) * 128 * 128; la.ld = 128;
          lb.base = p.p + (long)qd_ * 512 * NP + C_GV + hd_ * 64; lb.g = p.g_ln_g + l * 64; };
        auto set = [&](int it) { hd = it & 3; row0 = (it >> 2) * 512; };
        const u16* P = p.p; u16* MIX = p.hmix;
        auto epi = [&](f32x16 (&acc)[1][4], int mw, int nw, int r, int h) {
          const float bias = p.g_bs[(l * 4 + hd) * 128 + mw + r];
          char* stg = lds + (ltid() >> 6) * (32 * 272);
#pragma unroll
          for (int jj = 0; jj < 2; ++jj) {
#pragma unroll
            for (int j2 = 0; j2 < 2; ++j2)
#pragma unroll
              for (int g4 = 0; g4 < 4; ++g4)
                *(float4*)(stg + r * 272 + (j2 * 32 + 8 * g4 + 4 * h) * 4) =
                    make_float4(acc[0][2 * jj + j2][4 * g4] + bias, acc[0][2 * jj + j2][4 * g4 + 1] + bias, acc[0][2 * jj + j2][4 * g4 + 2] + bias, acc[0][2 * jj + j2][4 * g4 + 3] + bias);
            const long row_w = row0 + ((nw >> 6) + jj) * 128 + mw;
            const SgPre<4> gpre = staged_gate_fetch<32, 8, true>(h * 32 + r, P + row_w * NP + C_GGATE + hd * 64, P + row_w * NP + C_GU + hd * 64, NP);
            __syncthreads();
            staged_gate_finish<32, 8, 272, true>(stg, h * 32 + r, gpre, MIX + row_w * 1024 + 256 + hd * 64, 1024);
            __syncthreads();
          }
        };
        gemm_loop<4, 1, 4, true, true, LdDirect<128>, LdLN4>(FIRST(192), nG, nblk, mkl, set, epi, 2, lds);
      }
    }
    xcd_barrier(xb);

    {
      {
        int half = 0, k1 = 0, b = 0;
        auto mkl = [&](int it, LdDirect<128>& la, LdTrans<128>& lb) {
          const int half_ = it & 1, k1_ = (it >> 1) & 63, b_ = it >> 7;
          la.base = p.t2; la.ld = 128;
          lb.base = p.a1 + (((long)b_ * 64 + k1_) * 64 * 2) * 256 + half_ * 128; lb.strideK = 256L; };
        auto set = [&](int it) { half = it & 1; k1 = (it >> 1) & 63; b = it >> 7; };
        u16* YF = p.yf;
        auto epi = [&](f32x16 (&acc)[1][2], int mw, int nw, int r, int h) {
#pragma unroll
          for (int j = 0; j < 2; ++j) {
            const int gc = half * 128 + nw + j * 32 + r; const int g = gc >> 6, c2 = gc & 63;
#pragma unroll
            for (int e = 0; e < 16; ++e) {
              const int rho = mw + crow(e, h); const int ri = rho >> 6, k2 = rho & 63;
              YF[(long)(b * 4096 + k1 + 64 * k2) * 512 + g * 128 + ri * 64 + c2] = f2bf(acc[0][j][e]);
            }
          }
        };
        gemm_loop<4, 1, 2, false, true, LdDirect<128>, LdTrans<128>>(bid, 1024, nblk, mkl, set, epi, 2, lds);
      }
    {
      const u16* mf = p.mf_t + (long)l * 256 * 512;
      int m0 = 0, n0 = 0;
      auto mkl = [&](int it, LdDirect<256>& la, LdDirect<128>& lb) {
        const int mt = it >> 1, nt = it & 1;
        la.base = p.yf + (long)mt * 256 * 512; la.ld = 512; lb.base = mf + (long)nt * 128 * 512; lb.ld = 512; };
      auto set = [&](int it) { m0 = (it >> 1) * 256; n0 = (it & 1) * 128; };
      const u16* P = p.p; u16* MIX = p.hmix;
      auto epi = [&](f32x16 (&acc)[2][2], int mw, int nw, int r, int h) {
        const float sc = (m0 < MX) ? (1.f / 512.f) : (1.f / 128.f);
#pragma unroll
        for (int i = 0; i < 2; ++i) {
          u16 gv[2][16];
#pragma unroll
          for (int j = 0; j < 2; ++j)
#pragma unroll
            for (int e = 0; e < 16; ++e)
              gv[j][e] = P[(long)(m0 + mw + i * 32 + crow(e, h)) * NP + C_FGATE + n0 + nw + j * 32 + r];
#pragma unroll
          for (int j = 0; j < 2; ++j)
#pragma unroll
            for (int e = 0; e < 16; ++e)
              MIX[(long)(m0 + mw + i * 32 + crow(e, h)) * 1024 + n0 + nw + j * 32 + r] = f2bf(acc[i][j][e] * sc * silu(bf2f(gv[j][e])));
        }
      };
      gemm_loop<4, 2, 2, false, false, LdDirect<256>, LdDirect<128>>(128 * 2 + ((bid + nblk - 200) % nblk), (l == DEPTH - 1) ? 128 * 2 : 136 * 2, nblk, mkl, set, epi, 8, lds);
    }
      float negB;
      {
        float gq = 0.f, gk = 0.f;
        for (int i = 0; i < 96; ++i) { gq = fmaxf(gq, fabsf(p.q_norm_g[l * 96 + i])); gk = fmaxf(gk, fabsf(p.k_norm_g[l * 96 + i])); }
        negB = -(96.f * gq * gk * (0.10206207261596575f * 1.4426950408889634f) * 1.02f + 0.5f);
      }
      for (int it = bid; it < 512; it += nblk) {
        const int rnd = it / nblk; const int lb_ = it % nblk;
        int bh, qb;
        if (nblk == 256) { const int xcd = lb_ & 7, slot = lb_ >> 3; bh = rnd * 32 + xcd * 4 + (slot >> 3); qb = slot & 7; }
        else { bh = it >> 3; qb = it & 7; }
        const int b = bh >> 3, hd = bh & 7;
        const long bhoff = (long)(b * 8 + hd);
        const long row_base = (long)b * 4096 + qb * 512;
        attn_item64(p.q + bhoff * KPOS * 96, p.k + bhoff * KPOS * 96, p.vt + bhoff * 64 * KPOS, CTX + qb * 512, KPOS,
                    p.p + row_base * NP + C_AGATE + hd * 64, p.hmix + row_base * 1024 + 512 + hd * 64, lds);
      }
      if (l < DEPTH - 1) {
        for (int bh = (bid + nblk - 64) % nblk; bh < 64; bh += nblk) {
          const int b = bh >> 3, hd = bh & 7;
          const long bhoff = (long)(b * 8 + hd);
          const long row_base = (long)MX + b * 256;
          attn_item(p.q + bhoff * KPOS * 96, p.k + bhoff * KPOS * 96, p.vt + bhoff * 64 * KPOS, 0, CTX,
                    p.p + row_base * NP + C_AGATE + hd * 64, p.hmix + row_base * 1024 + 512 + hd * 64, negB, lds);
        }
      }
    }
    xcd_barrier(xb);

    {
      const u16* mf = p.mf_t + (long)l * 256 * 512;
      int m0 = 0, n0 = 0;
      auto mkl = [&](int it, LdDirect<256>& la, LdDirect<128>& lb) {
        const int mt = it >> 1, nt = it & 1;
        la.base = p.yf + (long)mt * 256 * 512; la.ld = 512; lb.base = mf + (long)nt * 128 * 512; lb.ld = 512; };
      auto set = [&](int it) { m0 = (it >> 1) * 256; n0 = (it & 1) * 128; };
      const u16* P = p.p; u16* MIX = p.hmix;
      auto epi = [&](f32x16 (&acc)[2][2], int mw, int nw, int r, int h) {
        const float sc = (m0 < MX) ? (1.f / 512.f) : (1.f / 128.f);
#pragma unroll
        for (int i = 0; i < 2; ++i) {
          u16 gv[2][16];
#pragma unroll
          for (int j = 0; j < 2; ++j)
#pragma unroll
            for (int e = 0; e < 16; ++e)
              gv[j][e] = P[(long)(m0 + mw + i * 32 + crow(e, h)) * NP + C_FGATE + n0 + nw + j * 32 + r];
#pragma unroll
          for (int j = 0; j < 2; ++j)
#pragma unroll
            for (int e = 0; e < 16; ++e)
              MIX[(long)(m0 + mw + i * 32 + crow(e, h)) * 1024 + n0 + nw + j * 32 + r] = f2bf(acc[i][j][e] * sc * silu(bf2f(gv[j][e])));
        }
      };
      gemm_loop<4, 2, 2, false, false, LdDirect<256>, LdDirect<128>>(bid, 128 * 2, nblk, mkl, set, epi, 8, lds);
    }
    xcd_barrier(xb);

    {
      const u16* wt = p.wout_t + (long)l * 1024 * 1024;
      int m0 = 0, n0 = 0;
      auto epi = [&](auto& acc, int mw, int nw, int r, int h) {
        constexpr int WM_ = sizeof(acc) / sizeof(acc[0]), WN_ = sizeof(acc[0]) / sizeof(acc[0][0]);
        const bool isx = m0 < MX;
        const float* __restrict__ src = isx ? (l == 0 ? p.x : p.out) + (long)m0 * 1024 : (l == 0 ? p.ctx : p.yw) + (long)(m0 - MX) * 1024;
        float* __restrict__ dst = isx ? p.out + (long)m0 * 1024 : p.yw + (long)(m0 - MX) * 1024;
        const float* gp = modl + (isx ? (m0 >> 12) : 8) * 3072 + 2048;
#pragma unroll
        for (int i = 0; i < WM_; ++i) {
          float old[WN_][16];
#pragma unroll
          for (int j = 0; j < WN_; ++j)
#pragma unroll
            for (int e = 0; e < 16; ++e)
              old[j][e] = src[(long)(mw + i * 32 + crow(e, h)) * 1024 + n0 + nw + j * 32 + r];
#pragma unroll
          for (int j = 0; j < WN_; ++j) {
            const float gt = gp[n0 + nw + j * 32 + r];
#pragma unroll
            for (int e = 0; e < 16; ++e)
              dst[(long)(mw + i * 32 + crow(e, h)) * 1024 + n0 + nw + j * 32 + r] = old[j][e] + gt * acc[i][j][e];
          }
        }
      };
      {
        auto mkl = [&](int j, LdDirect<256>& la, LdDirect<128>& lb) {
          const int mt = (j >> 3) * 8 + (bid & 7), nt = j & 7;
          la.base = p.hmix + (long)mt * 256 * 1024; la.ld = 1024; lb.base = wt + (long)nt * 128 * 1024; lb.ld = 1024; };
        auto set = [&](int j) { m0 = ((j >> 3) * 8 + (bid & 7)) * 256; n0 = (j & 7) * 128; };
        gemm_loop3<16, 4, 2, 2, false, false, LdDirect<256>, LdDirect<128>>(bid >> 3, 16 * 8, nblk >> 3, mkl, set, epi, lds);
      }
      if (l < DEPTH - 1) {
        auto mkl = [&](int it, LdDirect<128>& la, LdDirect<64>& lb) {
          const int mt = it >> 4, nt = it & 15;
          la.base = p.hmix + (long)(MX + mt * 128) * 1024; la.ld = 1024; lb.base = wt + (long)nt * 64 * 1024; lb.ld = 1024; };
        auto set = [&](int it) { m0 = MX + (it >> 4) * 128; n0 = (it & 15) * 64; };
        gemm_loop<4, 1, 1, false, false, LdDirect<128>, LdDirect<64>>(bid, 16 * 16, nblk, mkl, set, epi, 16, lds);
      }
    }
    if (l < DEPTH - 1) xcd_barrier(xb);
  }
}

static inline size_t al256(size_t x) { return (x + 255) / 256 * 256; }

extern "C" void kernel_launch(void* const* d_in, const int* in_sizes, int n_in,
                              void* d_out, int out_size, void* d_ws, size_t ws_size,
                              hipStream_t stream) {
  static int grid_blocks = 0;
  if (!grid_blocks) {
    int dev = 0, cus = 0, per_cu = 0;
    (void)hipGetDevice(&dev);
    (void)hipDeviceGetAttribute(&cus, hipDeviceAttributeMultiprocessorCount, dev);
    (void)hipFuncSetAttribute((const void*)fwd_megakernel, hipFuncAttributeMaxDynamicSharedMemorySize, LDS_BYTES);
    (void)hipOccupancyMaxActiveBlocksPerMultiprocessor(&per_cu, fwd_megakernel, NT_, LDS_BYTES);
    if (per_cu < 1) { fprintf(stderr, "occupancy query returned %d\n", per_cu); per_cu = 1; }
    grid_blocks = cus;
  }
  Params p{};
  p.x = (const float*)d_in[0]; p.c = (const float*)d_in[1]; p.ctx = (const float*)d_in[2]; p.c_ctx = (const float*)d_in[3];
  p.w_mod = (const float*)d_in[4]; p.b_mod = (const float*)d_in[5]; p.norm_g = (const float*)d_in[6]; p.w_in = (const float*)d_in[7];
  p.w_fmix = (const float*)d_in[8]; p.g_ln_g = (const float*)d_in[9]; p.g_ws = (const float*)d_in[10]; p.g_bs = (const float*)d_in[11];
  p.q_a_g = (const float*)d_in[12]; p.w_uq = (const float*)d_in[13]; p.kv_a_g = (const float*)d_in[14]; p.w_ukv = (const float*)d_in[15];
  p.q_norm_g = (const float*)d_in[16]; p.k_norm_g = (const float*)d_in[17]; p.w_out = (const float*)d_in[18];
  p.out = (float*)d_out;
  char* ws = (char*)d_ws; size_t off = 0;
  auto take = [&](size_t bytes) { char* r = ws + off; off = al256(off + bytes); return r; };
  p.bar = (unsigned*)take((size_t)XCD_BAR_WORDS * 4);
  p.yw = (float*)take((size_t)MY * 1024 * 4);
  p.mod = (float*)take((size_t)DEPTH * 9 * 3072 * 4);
  p.tw = (float*)take(4096 * 2 * 4);
  p.rope = (float*)take(64 * 8 * 2 * 4);
  p.stats = (float*)take((size_t)MT * 16 * 4);
  p.win_t = (u16*)take((size_t)DEPTH * NP * 1024 * 2);
  p.wout_t = (u16*)take((size_t)DEPTH * 1024 * 1024 * 2);
  p.wuq_t = (u16*)take((size_t)DEPTH * 768 * 256 * 2);
  p.wukv_t = (u16*)take((size_t)DEPTH * 1024 * 128 * 2);
  p.gws_b = (u16*)take((size_t)DEPTH * 4 * 128 * 128 * 2);
  p.mf_t = (u16*)take((size_t)DEPTH * 256 * 512 * 2);
  p.t1 = (u16*)take(128 * 64 * 2);
  p.t2 = (u16*)take(128 * 128 * 2);
  p.t256 = (u16*)take(512 * 256 * 2);
  p.hmix = (u16*)take((size_t)MT * 1024 * 2);
  p.p = (u16*)take((size_t)MT * NP * 2);
  p.q = (u16*)take((size_t)NB * 8 * KPOS * 96 * 2);
  p.k = (u16*)take((size_t)NB * 8 * KPOS * 96 * 2);
  p.vt = (u16*)take((size_t)NB * 8 * 64 * KPOS * 2);
  p.a1 = (u16*)take((size_t)NB * 64 * 64 * 2 * 256 * 2);
  p.yf = (u16*)take((size_t)MT * 512 * 2);
  if (off > ws_size) { fprintf(stderr, "workspace too small: need %zu have %zu\n", off, ws_size); return; }
  (void)hipMemsetAsync(p.bar, 0, (size_t)XCD_BAR_WORDS * 4, stream);
  void* args[] = {&p};
  hipError_t e = hipLaunchCooperativeKernel((void*)fwd_megakernel, dim3(grid_blocks), dim3(NT_), args, LDS_BYTES, stream);
  if (e != hipSuccess) fprintf(stderr, "cooperative launch failed: %s (grid %d)\n", hipGetErrorString(e), grid_blocks);
}
```

```cpp
#include <hip/hip_runtime.h>
#include <hip/hip_cooperative_groups.h>
#include <cstdio>
#include <cstdint>
namespace cg = cooperative_groups;

typedef unsigned short u16;
typedef __attribute__((ext_vector_type(8))) short bf16x8;
typedef __attribute__((ext_vector_type(16))) float f32x16;
typedef __attribute__((ext_vector_type(2))) __bf16 bf2_t;
typedef __attribute__((ext_vector_type(2))) float f2_t;
#define DI __device__ __forceinline__

constexpr int NB = 8, SEQ = 4096, DEPTH = 4, CTX = 256;
constexpr int MX = NB * SEQ, MY = NB * CTX, MT = MX + MY;
constexpr int NP = 2304, INW = 2208;
constexpr int C_FIN = 0, C_FGATE = 256, C_GU = 512, C_GV = 768, C_GGATE = 1024, C_CQ = 1280, C_CKV = 1536, C_KROPE = 1664, C_AGATE = 1696;
constexpr int KPOS = CTX + SEQ;
constexpr int NT_ = 512;
constexpr int PITCH = 144;
constexpr int LDS_BYTES = 131072;
constexpr int RSTD_OFF = 129024;
constexpr float EPS = 1e-6f;
constexpr float PI_F = 3.14159265358979323846f;

struct Params {
  const float *x, *c, *ctx, *c_ctx, *w_mod, *b_mod, *norm_g, *w_in, *w_fmix, *g_ln_g, *g_ws, *g_bs, *q_a_g, *w_uq, *kv_a_g, *w_ukv, *q_norm_g, *k_norm_g, *w_out;
  float* out;
  unsigned* bar;
  float *yw, *mod, *tw, *rope, *stats;
  u16 *win_t, *wout_t, *wuq_t, *wukv_t, *gws_b, *mf_t, *t1, *t2, *t256, *hmix, *p, *q, *k, *vt, *a1, *yf;
};

DI int ltid() { int t = threadIdx.x; asm volatile("" : "+v"(t)); return t; }
DI float bf2f(u16 v) { return __uint_as_float(((unsigned)v) << 16); }
DI unsigned pk2(float a, float b) { f2_t v = {a, b}; bf2_t r = __builtin_convertvector(v, bf2_t); return __builtin_bit_cast(unsigned, r); }
DI u16 f2bf(float a) { return (u16)(pk2(a, 0.f) & 0xffffu); }
DI float silu(float x) { return x / (1.f + __expf(-x)); }
DI int crow(int reg, int h) { return (reg & 3) + 8 * (reg >> 2) + 4 * h; }
DI float lo16(unsigned w) { return __uint_as_float(w << 16); }
DI float hi16(unsigned w) { return __uint_as_float(w & 0xffff0000u); }
DI f32x16 mfma(bf16x8 a, bf16x8 b, f32x16 c) { return __builtin_amdgcn_mfma_f32_32x32x16_bf16(a, b, c, 0, 0, 0); }
DI void unpack8(const uint4& v, float* f) {
  f[0] = lo16(v.x); f[1] = hi16(v.x); f[2] = lo16(v.y); f[3] = hi16(v.y);
  f[4] = lo16(v.z); f[5] = hi16(v.z); f[6] = lo16(v.w); f[7] = hi16(v.w);
}

#define XB_TMO      128
#define XB_XCNT(j)  (256  + 64 * (j))
#define XB_XSUB(j)  (1280 + 64 * (j))
#define XB_XGEN(j)  (2304 + 64 * (j))
#define XB_TOP      3328
#define XB_TOPGEN   3392
#define XCD_BAR_WORDS 3456
#define XB_SPIN_CAP (1u << 18)
#define LAS __attribute__((address_space(3)))
DI unsigned xb_ld(unsigned* p)              { return __hip_atomic_load(p, __ATOMIC_RELAXED, __HIP_MEMORY_SCOPE_AGENT); }
DI unsigned xb_add(unsigned* p, unsigned v) { return __hip_atomic_fetch_add(p, v, __ATOMIC_RELAXED, __HIP_MEMORY_SCOPE_AGENT); }
DI unsigned xb_xcc_id() { return (unsigned)__builtin_amdgcn_s_getreg((3 << 11) | 20) & 0xFu; }
#define XB_SPIN(cond, bar) do { unsigned _sp = 0; while (cond) { __builtin_amdgcn_s_sleep(1); \
    if ((++_sp & 255u) == 0u) { if (xb_ld(&(bar)[XB_TMO])) break; if (_sp > XB_SPIN_CAP) { atomicAdd(&(bar)[XB_TMO], 1u); break; } } } } while (0)
struct XcdBarrier { unsigned* bar; unsigned x; volatile LAS unsigned* st; };
DI XcdBarrier xcd_barrier_post(unsigned* bar, volatile LAS unsigned* st) {
  XcdBarrier b; b.bar = bar; b.x = xb_xcc_id(); b.st = st;
  if (threadIdx.x == 0) (void)xb_add(&bar[XB_XCNT(b.x)], 1u);
  return b;
}
DI void xcd_barrier_complete(unsigned* bar, unsigned x, unsigned& nloc, unsigned& nx) {
  const unsigned G = gridDim.x * gridDim.y * gridDim.z;
  unsigned sum, cnt, mine, sp = 0u;
  for (;;) {
    sum = 0u; cnt = 0u; mine = 0u;
#pragma unroll
    for (unsigned j = 0; j < 16; ++j) { const unsigned c = xb_ld(&bar[XB_XCNT(j)]); sum += c; cnt += (c > 0u) ? 1u : 0u; mine = (j == x) ? c : mine; }
    if (sum == G) break;
    __builtin_amdgcn_s_sleep(1);
    if ((++sp & 255u) == 0u) { if (xb_ld(&bar[XB_TMO])) break; if (sp > XB_SPIN_CAP) { atomicAdd(&bar[XB_TMO], 1u); break; } }
  }
  nloc = mine > 0u ? mine : 1u; nx = cnt > 0u ? cnt : 1u;
}
DI void xcd_barrier(const XcdBarrier& b) {
  asm volatile("s_waitcnt vmcnt(0)" ::: "memory");
  __syncthreads();
  if (threadIdx.x == 0) {
    unsigned* bar = b.bar;
    __builtin_amdgcn_s_waitcnt(0);
    unsigned nloc = b.st[0], nx = b.st[1];
    if (nloc == 0u) { xcd_barrier_complete(bar, b.x, nloc, nx); b.st[0] = nloc; b.st[1] = nx; }
    const unsigned old = xb_add(&bar[XB_XSUB(b.x)], 1u);
    const unsigned gen = old / nloc;
    if (old + 1u == (gen + 1u) * nloc) {
      __builtin_amdgcn_fence(__ATOMIC_RELEASE, "agent");
      asm volatile("s_waitcnt vmcnt(0)" ::: "memory");
      const unsigned og = xb_add(&bar[XB_TOP], 1u);
      const unsigned tg = og / nx;
      if (og + 1u == (tg + 1u) * nx) xb_add(&bar[XB_TOPGEN], 1u);
      else XB_SPIN(xb_ld(&bar[XB_TOPGEN]) == tg, bar);
      __builtin_amdgcn_fence(__ATOMIC_ACQUIRE, "agent");
      xb_add(&bar[XB_XGEN(b.x)], 1u);
      asm volatile("s_waitcnt vmcnt(0)" ::: "memory");
    } else {
      XB_SPIN(xb_ld(&bar[XB_XGEN(b.x)]) == gen, bar);
      __builtin_amdgcn_fence(__ATOMIC_ACQUIRE, "agent");
      asm volatile("s_waitcnt vmcnt(0)" ::: "memory");
    }
  }
  __syncthreads();
}


template <int ROWS> struct LdDirect {
  static constexpr int NR = ROWS * 8 / NT_;
  struct Regs { uint4 v[NR]; };
  const u16* base; long ld;
  DI Regs fetch(int kt, int tid) const { Regs r;
#pragma unroll
    for (int i = 0; i < NR; ++i) { int id = tid + NT_ * i; int row = id >> 3, kc = id & 7;
      r.v[i] = *(const uint4*)(base + (long)row * ld + kt * 64 + kc * 8); }
    return r;
  }
  DI void commit(char* s, const Regs& r, int, int tid) const {
#pragma unroll
    for (int i = 0; i < NR; ++i) { int id = tid + NT_ * i; int row = id >> 3, kc = id & 7;
      *(uint4*)(s + row * PITCH + kc * 16) = r.v[i]; }
  }
};
template <int ROWS> struct LdScaled {
  static constexpr int NR = ROWS * 8 / NT_;
  struct Regs { uint4 v[NR]; };
  const u16* base; long ld; const float* g; const float* rstd_s;
  DI Regs fetch(int kt, int tid) const { Regs r;
#pragma unroll
    for (int i = 0; i < NR; ++i) { int id = tid + NT_ * i; int row = id >> 3, kc = id & 7;
      r.v[i] = *(const uint4*)(base + (long)row * ld + kt * 64 + kc * 8); }
    return r;
  }
  DI void commit(char* s, const Regs& r, int kt, int tid) const {
#pragma unroll
    for (int i = 0; i < NR; ++i) { int id = tid + NT_ * i; int row = id >> 3, kc = id & 7;
      float f[8]; unpack8(r.v[i], f);
      const float rs = rstd_s[row];
      const float4 g0 = *(const float4*)(g + kt * 64 + kc * 8), g1 = *(const float4*)(g + kt * 64 + kc * 8 + 4);
      uint4 o;
      o.x = pk2(f[0] * rs * g0.x, f[1] * rs * g0.y); o.y = pk2(f[2] * rs * g0.z, f[3] * rs * g0.w);
      o.z = pk2(f[4] * rs * g1.x, f[5] * rs * g1.y); o.w = pk2(f[6] * rs * g1.z, f[7] * rs * g1.w);
      *(uint4*)(s + row * PITCH + kc * 16) = o; }
  }
};
template <int BN> struct LdTrans {
  static constexpr int NC = BN / 8;
  static constexpr int NR = 32 * NC / NT_;
  struct Regs { uint4 v[2 * NR]; };
  const u16* base; long strideK;
  DI Regs fetch(int kt, int tid) const { Regs r;
#pragma unroll
    for (int i = 0; i < NR; ++i) { int id = tid + NT_ * i; int nc = id % NC, k2 = id / NC;
      r.v[2 * i] = *(const uint4*)(base + (long)(kt * 64 + 2 * k2) * strideK + nc * 8);
      r.v[2 * i + 1] = *(const uint4*)(base + (long)(kt * 64 + 2 * k2 + 1) * strideK + nc * 8); }
    return r;
  }
  DI void commit(char* s, const Regs& r, int, int tid) const {
#pragma unroll
    for (int i = 0; i < NR; ++i) { int id = tid + NT_ * i; int nc = id % NC, k = 2 * (id / NC);
      const int off = (((k >> 3) ^ (nc & 7)) << 4) + (k & 7) * 2;
      char* d = s + (nc * 8) * PITCH + off;
      const unsigned a[4] = {r.v[2 * i].x, r.v[2 * i].y, r.v[2 * i].z, r.v[2 * i].w};
      const unsigned c[4] = {r.v[2 * i + 1].x, r.v[2 * i + 1].y, r.v[2 * i + 1].z, r.v[2 * i + 1].w};
#pragma unroll
      for (int e = 0; e < 8; ++e) {
        const unsigned lo = (e & 1) ? (a[e >> 1] >> 16) : (a[e >> 1] & 0xffffu);
        const unsigned hi = (e & 1) ? (c[e >> 1] & 0xffff0000u) : (c[e >> 1] << 16);
        *(unsigned*)(d + e * PITCH) = lo | hi; } }
  }
};
struct LdLN {
  static constexpr int NR = 1;
  struct Regs { uint4 v[1]; };
  const u16* base; const float* g;
  DI Regs fetch(int kt, int tid) const { Regs r; int id = tid; int nc = id & 7, k = id >> 3;
    r.v[0] = *(const uint4*)(base + (long)(kt * 64 + k) * NP + nc * 8); return r; }
  DI void commit(char* s, const Regs& r, int, int tid) const {
    int id = tid; int nc = id & 7, k = id >> 3;
    float f[8]; unpack8(r.v[0], f);
    float sm = 0.f;
#pragma unroll
    for (int e = 0; e < 8; ++e) sm += f[e];
    sm += __shfl_xor(sm, 1); sm += __shfl_xor(sm, 2); sm += __shfl_xor(sm, 4);
    const float mean = sm * (1.f / 64.f);
    float sq = 0.f;
#pragma unroll
    for (int e = 0; e < 8; ++e) { f[e] -= mean; sq += f[e] * f[e]; }
    sq += __shfl_xor(sq, 1); sq += __shfl_xor(sq, 2); sq += __shfl_xor(sq, 4);
    const float rs = rsqrtf(sq * (1.f / 64.f) + EPS);
    const int off = (((k >> 3) ^ (nc & 7)) << 4) + (k & 7) * 2;
    char* d = s + (nc * 8) * PITCH + off;
#pragma unroll
    for (int e = 0; e < 8; ++e) *(u16*)(d + e * PITCH) = f2bf(f[e] * rs * g[nc * 8 + e]);
  }
};

template <int WM, int WN, bool SWAP, bool SWZB>
DI void gemm_compute(f32x16 (&acc)[WM][WN], const char* a_s, const char* b_s, int brow0, int h) {
#pragma unroll
  for (int ks = 0; ks < 4; ++ks) {
    bf16x8 af[WM], bfr[WN];
#pragma unroll
    for (int i = 0; i < WM; ++i) af[i] = *(const bf16x8*)(a_s + i * 32 * PITCH + (ks * 2 + h) * 16);
#pragma unroll
    for (int j = 0; j < WN; ++j) {
      const int row = brow0 + j * 32;
      const int ch = SWZB ? ((ks * 2 + h) ^ ((row >> 3) & 7)) : (ks * 2 + h);
      bfr[j] = *(const bf16x8*)(b_s + j * 32 * PITCH + ch * 16);
    }
#pragma unroll
    for (int i = 0; i < WM; ++i)
#pragma unroll
      for (int j = 0; j < WN; ++j)
        acc[i][j] = SWAP ? mfma(bfr[j], af[i], acc[i][j]) : mfma(af[i], bfr[j], acc[i][j]);
  }
  __builtin_amdgcn_iglp_opt(0);
}
struct LdLN4 {
  static constexpr int NR = 4;
  struct Regs { uint4 v[4]; };
  const u16* base; const float* g;
  DI Regs fetch(int kt, int tid) const { Regs r;
    const int nc = tid & 7, kq = (tid >> 3) & 15, ci = tid >> 7;
#pragma unroll
    for (int j = 0; j < 4; ++j) r.v[j] = *(const uint4*)(base + (long)(ci * 128 + kt * 64 + 4 * kq + j) * NP + nc * 8);
    return r; }
  DI void commit(char* s, const Regs& r, int, int tid) const {
    const int nc = tid & 7, kq = (tid >> 3) & 15, ci = tid >> 7;
    float gg[8];
#pragma unroll
    for (int e = 0; e < 8; ++e) gg[e] = g[nc * 8 + e];
    float f[4][8];
#pragma unroll
    for (int j = 0; j < 4; ++j) {
      unpack8(r.v[j], f[j]);
      float sm = 0.f;
#pragma unroll
      for (int e = 0; e < 8; ++e) sm += f[j][e];
      sm += __shfl_xor(sm, 1); sm += __shfl_xor(sm, 2); sm += __shfl_xor(sm, 4);
      const float mean = sm * (1.f / 64.f);
      float sq = 0.f;
#pragma unroll
      for (int e = 0; e < 8; ++e) { f[j][e] -= mean; sq += f[j][e] * f[j][e]; }
      sq += __shfl_xor(sq, 1); sq += __shfl_xor(sq, 2); sq += __shfl_xor(sq, 4);
      const float rs = rsqrtf(sq * (1.f / 64.f) + EPS);
#pragma unroll
      for (int e = 0; e < 8; ++e) f[j][e] *= rs * gg[e];
    }
    const int k = 4 * kq;
    const int off = (((k >> 3) ^ (nc & 7)) << 4) + (k & 7) * 2;
    char* d = s + (ci * 64 + nc * 8) * PITCH + off;
#pragma unroll
    for (int e = 0; e < 8; ++e) { uint2 o; o.x = pk2(f[0][e], f[1][e]); o.y = pk2(f[2][e], f[3][e]); *(uint2*)(d + e * PITCH) = o; }
  }
};
template <class LA, class LB> struct GemmPre { typename LA::Regs a0, a1; typename LB::Regs b0, b1; };
template <class LA, class LB>
DI GemmPre<LA, LB> gemm_prefetch(const LA& la, const LB& lb, int nkt) {
  const int tid = ltid();
  GemmPre<LA, LB> pre;
  const int k1 = nkt > 1 ? 1 : 0;
  pre.a0 = la.fetch(0, tid); pre.b0 = lb.fetch(0, tid);
  pre.a1 = la.fetch(k1, tid); pre.b1 = lb.fetch(k1, tid);
  return pre;
}
template <int WGM, int WM, int WN, bool SWAP, bool SWZB, class LA, class LB, class EPI>
DI GemmPre<LA, LB> gemm_tile(const LA& la, const LB& lb, const EPI& epi, int nkt, char* lds, const GemmPre<LA, LB>& pre, const LA& lan, const LB& lbn) {
  constexpr int WGN = 8 / WGM;
  constexpr int BM = WGM * WM * 32, BN = WGN * WN * 32;
  constexpr int ASZ = BM * PITCH, BSZ = BN * PITCH;
  char* As = lds; char* Bs = lds + 2 * ASZ;
  const int tid = ltid(), w = tid >> 6, lane = tid & 63, r = lane & 31, h = lane >> 5;
  const int wm = w / WGN, wn = w % WGN;
  f32x16 acc[WM][WN];
#pragma unroll
  for (int i = 0; i < WM; ++i)
#pragma unroll
    for (int j = 0; j < WN; ++j)
#pragma unroll
      for (int e = 0; e < 16; ++e) acc[i][j][e] = 0.f;
  typename LA::Regs ra0 = pre.a0, ra1 = pre.a1; typename LB::Regs rb0 = pre.b0, rb1 = pre.b1;
  la.commit(As, ra0, 0, tid); lb.commit(Bs, rb0, 0, tid);
  __syncthreads();
  const int a_off = (wm * WM * 32 + r) * PITCH, b_off = (wn * WN * 32 + r) * PITCH;
  const int k1n = nkt > 1 ? 1 : 0;
#define GEMM_COMPUTE(cur) gemm_compute<WM, WN, SWAP, SWZB>(acc, As + (cur) * ASZ + a_off, Bs + (cur) * BSZ + b_off, wn * WN * 32 + r, h)
  if (nkt == 1) {
    ra0 = lan.fetch(0, tid); rb0 = lbn.fetch(0, tid);
    GEMM_COMPUTE(0);
    ra1 = ra0; rb1 = rb0;
    __syncthreads();
  } else {
    for (int kt = 0; kt < nkt; kt += 2) {
      const bool more = kt + 2 < nkt;
      if (more) { ra0 = la.fetch(kt + 2, tid); rb0 = lb.fetch(kt + 2, tid); }
      else      { ra0 = lan.fetch(0, tid);     rb0 = lbn.fetch(0, tid); }
      GEMM_COMPUTE(0);
      la.commit(As + ASZ, ra1, kt + 1, tid); lb.commit(Bs + BSZ, rb1, kt + 1, tid);
      __syncthreads();
      if (more) { ra1 = la.fetch(kt + 3, tid); rb1 = lb.fetch(kt + 3, tid); }
      else      { ra1 = lan.fetch(k1n, tid);   rb1 = lbn.fetch(k1n, tid); }
      GEMM_COMPUTE(1);
      if (more) { la.commit(As, ra0, kt + 2, tid); lb.commit(Bs, rb0, kt + 2, tid); }
      __syncthreads();
    }
  }
#undef GEMM_COMPUTE
  epi(acc, wm * WM * 32, wn * WN * 32, r, h);
  GemmPre<LA, LB> nx; nx.a0 = ra0; nx.a1 = ra1; nx.b0 = rb0; nx.b1 = rb1;
  return nx;
}
template <int WGM, int WM, int WN, bool SWAP, bool SWZB, class LA, class LB, class MKL, class SET, class EPI>
DI void gemm_loop(int first, int count, int step, const MKL& mkl, const SET& set, const EPI& epi, int nkt, char* lds) {
  if (first >= count) return;
  LA la; LB lb; mkl(first, la, lb);
  GemmPre<LA, LB> pre = gemm_prefetch(la, lb, nkt);
  for (int idx = first; idx < count; idx += step) {
    const int nx = (idx + step < count) ? idx + step : idx;
    LA lan; LB lbn; mkl(nx, lan, lbn);
    set(idx);
    pre = gemm_tile<WGM, WM, WN, SWAP, SWZB>(la, lb, epi, nkt, lds, pre, lan, lbn);
    la = lan; lb = lbn;
  }
}

template <class LA, class LB> struct GemmPre3 { typename LA::Regs a[3]; typename LB::Regs b[3]; };
template <int NKT, int WGM, int WM, int WN, bool SWAP, bool SWZB, class LA, class LB, class MKL, class SET, class EPI>
DI void gemm_loop3(int first, int count, int step, const MKL& mkl, const SET& set, const EPI& epi, char* lds) {
  static_assert(NKT >= 4, "needs at least 4 k-slabs");
  constexpr int WGN = 8 / WGM;
  constexpr int BM = WGM * WM * 32, BN = WGN * WN * 32;
  constexpr int ASZ = BM * PITCH, BSZ = BN * PITCH;
  if (first >= count) return;
  char* As = lds; char* Bs = lds + 2 * ASZ;
  LA la; LB lb; mkl(first, la, lb);
  typename LA::Regs ra0, ra1, ra2; typename LB::Regs rb0, rb1, rb2;
  { const int tid = ltid();
    ra0 = la.fetch(0, tid); rb0 = lb.fetch(0, tid); ra1 = la.fetch(1, tid); rb1 = lb.fetch(1, tid); ra2 = la.fetch(2, tid); rb2 = lb.fetch(2, tid); }
  for (int idx = first; idx < count; idx += step) {
    const int nx = (idx + step < count) ? idx + step : idx;
    LA lan; LB lbn; mkl(nx, lan, lbn);
    set(idx);
    const int tid = ltid(), w = tid >> 6, lane = tid & 63, r = lane & 31, h = lane >> 5;
    const int wm = w / WGN, wn = w % WGN;
    f32x16 acc[WM][WN];
#pragma unroll
    for (int i = 0; i < WM; ++i)
#pragma unroll
      for (int j = 0; j < WN; ++j)
#pragma unroll
        for (int e = 0; e < 16; ++e) acc[i][j][e] = 0.f;
    la.commit(As, ra0, 0, tid); lb.commit(Bs, rb0, 0, tid);
    __syncthreads();
    const int a_off = (wm * WM * 32 + r) * PITCH, b_off = (wn * WN * 32 + r) * PITCH;
#define G3_FETCH(RA, RB, kk) do { if ((kk) < NKT) { RA = la.fetch((kk), tid); RB = lb.fetch((kk), tid); } else { RA = lan.fetch((kk) - NKT, tid); RB = lbn.fetch((kk) - NKT, tid); } } while (0)
#define G3_TRIP(kt, RA, RB, RAn, RBn) do { \
      G3_FETCH(RA, RB, (kt) + 3); \
      gemm_compute<WM, WN, SWAP, SWZB>(acc, As + ((kt) & 1) * ASZ + a_off, Bs + ((kt) & 1) * BSZ + b_off, wn * WN * 32 + r, h); \
      if ((kt) + 1 < NKT) { la.commit(As + (((kt) + 1) & 1) * ASZ, RAn, (kt) + 1, tid); lb.commit(Bs + (((kt) + 1) & 1) * BSZ, RBn, (kt) + 1, tid); } \
      __syncthreads(); } while (0)
#pragma unroll
    for (int k3 = 0; k3 < NKT; k3 += 3) {
      G3_TRIP(k3, ra0, rb0, ra1, rb1);
      if (k3 + 1 < NKT) G3_TRIP(k3 + 1, ra1, rb1, ra2, rb2);
      if (k3 + 2 < NKT) G3_TRIP(k3 + 2, ra2, rb2, ra0, rb0);
    }
#undef G3_TRIP
#undef G3_FETCH
    epi(acc, wm * WM * 32, wn * WN * 32, r, h);
    if (NKT % 3 == 1) { typename LA::Regs ta = ra0; typename LB::Regs tb = rb0; ra0 = ra1; rb0 = rb1; ra1 = ra2; rb1 = rb2; ra2 = ta; rb2 = tb; }
    if (NKT % 3 == 2) { typename LA::Regs ta = ra2; typename LB::Regs tb = rb2; ra2 = ra1; rb2 = rb1; ra1 = ra0; rb1 = rb0; ra0 = ta; rb0 = tb; }
    la = lan; lb = lbn;
  }
}

DI void transpose_cvt_tile(const float* src, u16* dst, int K, int N, int kt, int nt, int remap, float* tile, const float* kgain = nullptr) {
  const int tid = ltid();
#pragma unroll
  for (int i = 0; i < 8; ++i) {
    const int kk = i * 8 + (tid >> 6), nn = tid & 63;
    const int n = nt * 64 + nn;
    tile[kk * 65 + nn] = (n < N) ? src[(long)(kt * 64 + kk) * N + n] * (kgain ? kgain[kt * 64 + kk] : 1.f) : 0.f;
  }
  __syncthreads();
  {
    const int nl = tid >> 3, kc = (tid & 7) * 8;
    const int n = nt * 64 + nl;
    if (n < N) {
      int dn = n;
      if (remap) { const int hh = n >> 7, dd = n & 127; dn = (dd < 64) ? (hh * 64 + dd) : (512 + hh * 64 + dd - 64); }
      uint4 o;
      o.x = pk2(tile[(kc + 0) * 65 + nl], tile[(kc + 1) * 65 + nl]);
      o.y = pk2(tile[(kc + 2) * 65 + nl], tile[(kc + 3) * 65 + nl]);
      o.z = pk2(tile[(kc + 4) * 65 + nl], tile[(kc + 5) * 65 + nl]);
      o.w = pk2(tile[(kc + 6) * 65 + nl], tile[(kc + 7) * 65 + nl]);
      *(uint4*)(dst + (long)dn * K + kt * 64 + kc) = o;
    }
  }
  __syncthreads();
}

template <int NQ> struct SgPre { uint4 g[NQ], u[NQ]; };
template <int ROWS, int CH, bool HAS_U>
DI SgPre<ROWS * CH / 64> staged_gate_fetch(int lane, const u16* __restrict__ gate, const u16* __restrict__ uptr, long ldg) {
  constexpr int NQ = ROWS * CH / 64;
  SgPre<NQ> q;
#pragma unroll
  for (int i = 0; i < NQ; ++i) {
    const int id = i * 64 + lane; const int row = id / CH, c = id % CH;
    q.g[i] = *(const uint4*)(gate + (long)row * ldg + c * 8);
    q.u[i] = HAS_U ? *(const uint4*)(uptr + (long)row * ldg + c * 8) : make_uint4(0, 0, 0, 0);
  }
  return q;
}
template <int ROWS, int CH, int SPB, bool HAS_U>
DI void staged_gate_finish(const char* st, int lane, const SgPre<ROWS * CH / 64>& pre, u16* __restrict__ out, long ldo) {
  constexpr int NQ = ROWS * CH / 64;
#pragma unroll
  for (int q = 0; q < NQ; ++q) {
    const int id = q * 64 + lane; const int row = id / CH, c = id % CH;
    const float4 a = *(const float4*)(st + row * SPB + c * 32), b = *(const float4*)(st + row * SPB + c * 32 + 16);
    float g[8]; unpack8(pre.g[q], g);
    float u[8];
    if (HAS_U) unpack8(pre.u[q], u); else {
#pragma unroll
      for (int e = 0; e < 8; ++e) u[e] = 1.f; }
    uint4 o;
    o.x = pk2(a.x * u[0] * silu(g[0]), a.y * u[1] * silu(g[1])); o.y = pk2(a.z * u[2] * silu(g[2]), a.w * u[3] * silu(g[3]));
    o.z = pk2(b.x * u[4] * silu(g[4]), b.y * u[5] * silu(g[5])); o.w = pk2(b.z * u[6] * silu(g[6]), b.w * u[7] * silu(g[7]));
    *(uint4*)(out + (long)row * ldo + c * 8) = o;
  }
}
template <int ROWS, int CH, int SPB, bool HAS_U>
DI void staged_gate_store(const char* st, int lane, const u16* __restrict__ gate, const u16* __restrict__ uptr, long ldg, u16* __restrict__ out, long ldo) {
  const SgPre<ROWS * CH / 64> pre = staged_gate_fetch<ROWS, CH, HAS_U>(lane, gate, uptr, ldg);
  staged_gate_finish<ROWS, CH, SPB, HAS_U>(st, lane, pre, out, ldo);
}

constexpr int AT_KP = 208, AT_KSZ = 64 * AT_KP, AT_VP = 144, AT_VSZ = 64 * AT_VP;
DI void attn_qk(f32x16& p0, f32x16& p1, const char* ks, const bf16x8 (&qf)[6], int r, int h, float negB) {
#pragma unroll
  for (int e = 0; e < 16; ++e) { p0[e] = negB; p1[e] = negB; }
#pragma unroll
  for (int s = 0; s < 6; ++s) {
    const bf16x8 k0 = *(const bf16x8*)(ks + r * AT_KP + (2 * s + h) * 16);
    const bf16x8 k1 = *(const bf16x8*)(ks + (32 + r) * AT_KP + (2 * s + h) * 16);
    p0 = mfma(k0, qf[s], p0); p1 = mfma(k1, qf[s], p1);
  }
}
DI void attn_pv(f32x16& o0, f32x16& o1, const f32x16& p0, const f32x16& p1, const char* vs, int r, int h) {
#pragma unroll
  for (int kb = 0; kb < 2; ++kb) {
#pragma unroll
    for (int sp = 0; sp < 2; ++sp) {
      uint4 pw;
      if (kb == 0) { pw.x = pk2(p0[8 * sp + 0], p0[8 * sp + 1]); pw.y = pk2(p0[8 * sp + 2], p0[8 * sp + 3]);
                     pw.z = pk2(p0[8 * sp + 4], p0[8 * sp + 5]); pw.w = pk2(p0[8 * sp + 6], p0[8 * sp + 7]); }
      else         { pw.x = pk2(p1[8 * sp + 0], p1[8 * sp + 1]); pw.y = pk2(p1[8 * sp + 2], p1[8 * sp + 3]);
                     pw.z = pk2(p1[8 * sp + 4], p1[8 * sp + 5]); pw.w = pk2(p1[8 * sp + 6], p1[8 * sp + 7]); }
      const bf16x8 pf = __builtin_bit_cast(bf16x8, pw);
      const int keyoff = 32 * kb + 16 * sp + 4 * h;
      {
        const char* vr = vs + r * AT_VP + ((keyoff * 2) ^ ((r & 16) >> 1));
        const uint2 lo = *(const uint2*)vr, hi = *(const uint2*)(vr + 16);
        uint4 a4 = make_uint4(lo.x, lo.y, hi.x, hi.y);
        o0 = mfma(__builtin_bit_cast(bf16x8, a4), pf, o0);
      }
      {
        const char* vr = vs + (32 + r) * AT_VP + ((keyoff * 2) ^ ((r & 16) >> 1));
        const uint2 lo = *(const uint2*)vr, hi = *(const uint2*)(vr + 16);
        uint4 a4 = make_uint4(lo.x, lo.y, hi.x, hi.y);
        o1 = mfma(__builtin_bit_cast(bf16x8, a4), pf, o1);
      }
    }
  }
}
DI void attn_item(const u16* __restrict__ Qp, const u16* __restrict__ Kp, const u16* __restrict__ VTp, int q0, int nkeys,
                  const u16* __restrict__ gatep, u16* __restrict__ mixp, float negB, char* lds) {
  const int tid = ltid(), w = tid >> 6, lane = tid & 63, r = lane & 31, h = lane >> 5;
  char* Kb0 = lds; char* Vb0 = lds + 2 * AT_KSZ;
  bf16x8 qf[6];
  {
    const u16* qrow = Qp + (long)(q0 + w * 32 + r) * 96 + h * 8;
#pragma unroll
    for (int s = 0; s < 6; ++s) qf[s] = *(const bf16x8*)(qrow + s * 16);
  }
  f32x16 o0, o1;
#pragma unroll
  for (int e = 0; e < 16; ++e) { o0[e] = 0.f; o1[e] = 0.f; }
  float lsum = 0.f;
  const int NT = nkeys >> 6;
  uint4 rkA0, rkA1, rvA, rkB0, rkB1, rvB;
  rkA1 = make_uint4(0, 0, 0, 0); rkB1 = make_uint4(0, 0, 0, 0);
  const int krow0 = tid / 12, kc0 = tid % 12, krow1 = (tid + 512) / 12, kc1 = (tid + 512) % 12;
  const int vrow = tid >> 3, vc = tid & 7;
  const bool klo = tid < 256;
#define AT_FETCH_K(S, t) do { const u16* kt_ = Kp + (long)(t) * 64 * 96; rk##S##0 = *(const uint4*)(kt_ + tid * 8); \
    if (klo) rk##S##1 = *(const uint4*)(kt_ + (tid + 512) * 8); } while (0)
#define AT_FETCH_V(S, t) do { rv##S = *(const uint4*)(VTp + (long)vrow * KPOS + (t) * 64 + vc * 8); } while (0)
#define AT_COMMIT_K(S, buf) do { char* ks_ = Kb0 + (buf) * AT_KSZ; *(uint4*)(ks_ + krow0 * AT_KP + kc0 * 16) = rk##S##0; \
    if (klo) *(uint4*)(ks_ + krow1 * AT_KP + kc1 * 16) = rk##S##1; } while (0)
#define AT_COMMIT_V(S, buf) do { *(uint4*)(Vb0 + (buf) * AT_VSZ + vrow * AT_VP + vc * 16) = (vrow & 16) ? make_uint4(rv##S.z, rv##S.w, rv##S.x, rv##S.y) : rv##S; } while (0)
#define AT_TRIP(t, FS, CS) do { \
    { const int tk_ = ((t) + 3 < NT) ? (t) + 3 : NT - 1, tv_ = ((t) + 2 < NT) ? (t) + 2 : NT - 1; AT_FETCH_K(FS, tk_); AT_FETCH_V(FS, tv_); } \
    f32x16 n0, n1; \
    attn_qk(n0, n1, Kb0 + (((t) + 1) & 1) * AT_KSZ, qf, r, h, negB); \
    const char* vs = Vb0 + ((t) & 1) * AT_VSZ; \
    float rs = 0.f; \
    _Pragma("unroll") for (int e = 0; e < 16; ++e) { p0[e] = __builtin_amdgcn_exp2f(p0[e]); rs += p0[e]; } \
    _Pragma("unroll") for (int e = 0; e < 16; ++e) { p1[e] = __builtin_amdgcn_exp2f(p1[e]); rs += p1[e]; } \
    lsum += rs; \
    attn_pv(o0, o1, p0, p1, vs, r, h); \
    AT_COMMIT_K(CS, (t) & 1); AT_COMMIT_V(CS, ((t) + 1) & 1); \
    __syncthreads(); \
    p0 = n0; p1 = n1; } while (0)
  AT_FETCH_K(A, 0); AT_FETCH_V(A, 0); AT_FETCH_K(B, 1);
  AT_COMMIT_K(A, 0); AT_COMMIT_V(A, 0); AT_COMMIT_K(B, 1);
  AT_FETCH_K(B, 2); AT_FETCH_V(B, 1);
  __syncthreads();
  f32x16 p0, p1;
  attn_qk(p0, p1, Kb0, qf, r, h, negB);
  for (int t = 0; t < NT; t += 2) {
    AT_TRIP(t, A, B);
    AT_TRIP(t + 1, B, A);
  }
#undef AT_TRIP
#undef AT_FETCH_K
#undef AT_FETCH_V
#undef AT_COMMIT_K
#undef AT_COMMIT_V
  lsum += __shfl_xor(lsum, 32);
  const float inv = 1.f / lsum;
  char* stg = lds + w * (32 * 272);
#pragma unroll
  for (int db = 0; db < 2; ++db)
#pragma unroll
    for (int g4 = 0; g4 < 4; ++g4) {
      const int dv = db * 32 + 8 * g4 + 4 * h;
      float4 v;
      if (db == 0) v = make_float4(o0[4 * g4] * inv, o0[4 * g4 + 1] * inv, o0[4 * g4 + 2] * inv, o0[4 * g4 + 3] * inv);
      else         v = make_float4(o1[4 * g4] * inv, o1[4 * g4 + 1] * inv, o1[4 * g4 + 2] * inv, o1[4 * g4 + 3] * inv);
      *(float4*)(stg + r * 272 + dv * 4) = v;
    }
  __syncthreads();
  staged_gate_store<32, 8, 272, false>(stg, lane, gatep + (long)(w * 32) * NP, nullptr, NP, mixp + (long)(w * 32) * 1024, 1024);
  __syncthreads();
}

DI void attn_item64(const u16* __restrict__ Qp, const u16* __restrict__ Kp, const u16* __restrict__ VTp, int q0, int nkeys,
                    const u16* __restrict__ gatep, u16* __restrict__ mixp, char* lds) {
  const int tid = ltid(), w = tid >> 6, lane = tid & 63, r = lane & 31, h = lane >> 5;
  char* Kb0 = lds; char* Vb0 = lds + 2 * AT_KSZ;
  char* qbl = lds + 2 * AT_KSZ + 2 * AT_VSZ + w * (32 * AT_KP) + r * AT_KP + h * 16;
  bf16x8 qa[6];
  {
    const u16* qrow = Qp + (long)(q0 + w * 64 + r) * 96 + h * 8;
#pragma unroll
    for (int s = 0; s < 6; ++s) { qa[s] = *(const bf16x8*)(qrow + s * 16); *(bf16x8*)(qbl + s * 32) = *(const bf16x8*)(qrow + 32 * 96 + s * 16); }
  }
  f32x16 oa0, oa1, ob0, ob1;
#pragma unroll
  for (int e = 0; e < 16; ++e) { oa0[e] = 0.f; oa1[e] = 0.f; ob0[e] = 0.f; ob1[e] = 0.f; }
  float lsa = 0.f, lsb = 0.f;
  const int NT = nkeys >> 6;
  uint2 rkA0, rkA1, rkA2, rkB0, rkB1, rkB2; uint4 rvA, rvB;
  const int kso = (tid >> 3) * AT_KP + (tid & 7) * 24;
  const int vrow = tid >> 3, vc = tid & 7;
#define AT_FETCH_K(S, t) do { const uint2* kt_ = (const uint2*)(Kp + (long)(t) * 64 * 96) + tid * 3; rk##S##0 = kt_[0]; rk##S##1 = kt_[1]; rk##S##2 = kt_[2]; } while (0)
#define AT_FETCH_V(S, t) do { rv##S = *(const uint4*)(VTp + (long)vrow * KPOS + (t) * 64 + vc * 8); } while (0)
#define AT_COMMIT_K(S, buf) do { char* ks_ = Kb0 + (buf) * AT_KSZ + kso; *(uint2*)ks_ = rk##S##0; *(uint2*)(ks_ + 8) = rk##S##1; *(uint2*)(ks_ + 16) = rk##S##2; } while (0)
#define AT_COMMIT_V(S, buf) do { *(uint4*)(Vb0 + (buf) * AT_VSZ + vrow * AT_VP + vc * 16) = (vrow & 16) ? make_uint4(rv##S.z, rv##S.w, rv##S.x, rv##S.y) : rv##S; } while (0)
#define AT_QK_HALF(sa, sb, ks, kb) do { \
    _Pragma("unroll") for (int e = 0; e < 16; ++e) { sa[e] = 0.f; sb[e] = 0.f; } \
    _Pragma("unroll") for (int s_ = 0; s_ < 6; ++s_) { \
      const bf16x8 kf_ = *(const bf16x8*)((ks) + ((kb) * 32 + r) * AT_KP + (2 * s_ + h) * 16); \
      const bf16x8 qf_ = *(const bf16x8*)(qbl + s_ * 32); \
      sa = mfma(kf_, qa[s_], sa); sb = mfma(kf_, qf_, sb); } } while (0)
#define AT_EXP(sx, ls) do { float rs_ = 0.f; \
    _Pragma("unroll") for (int e = 0; e < 16; ++e) { sx[e] = __builtin_amdgcn_exp2f(sx[e]); rs_ += sx[e]; } ls += rs_; } while (0)
#define AT_PV_HALF(pa, pb, vs, kb) do { \
    _Pragma("unroll") for (int sp_ = 0; sp_ < 2; ++sp_) { \
      uint4 wa_, wb_; \
      wa_.x = pk2(pa[8 * sp_ + 0], pa[8 * sp_ + 1]); wa_.y = pk2(pa[8 * sp_ + 2], pa[8 * sp_ + 3]); \
      wa_.z = pk2(pa[8 * sp_ + 4], pa[8 * sp_ + 5]); wa_.w = pk2(pa[8 * sp_ + 6], pa[8 * sp_ + 7]); \
      wb_.x = pk2(pb[8 * sp_ + 0], pb[8 * sp_ + 1]); wb_.y = pk2(pb[8 * sp_ + 2], pb[8 * sp_ + 3]); \
      wb_.z = pk2(pb[8 * sp_ + 4], pb[8 * sp_ + 5]); wb_.w = pk2(pb[8 * sp_ + 6], pb[8 * sp_ + 7]); \
      const bf16x8 fa_ = __builtin_bit_cast(bf16x8, wa_), fb_ = __builtin_bit_cast(bf16x8, wb_); \
      const int keyoff_ = 32 * (kb) + 16 * sp_ + 4 * h; \
      { const char* vr_ = (vs) + r * AT_VP + ((keyoff_ * 2) ^ ((r & 16) >> 1)); \
        const uint2 lo_ = *(const uint2*)vr_, hi_ = *(const uint2*)(vr_ + 16); \
        const bf16x8 vf_ = __builtin_bit_cast(bf16x8, make_uint4(lo_.x, lo_.y, hi_.x, hi_.y)); \
        oa0 = mfma(vf_, fa_, oa0); ob0 = mfma(vf_, fb_, ob0); } \
      { const char* vr_ = (vs) + (32 + r) * AT_VP + ((keyoff_ * 2) ^ ((r & 16) >> 1)); \
        const uint2 lo_ = *(const uint2*)vr_, hi_ = *(const uint2*)(vr_ + 16); \
        const bf16x8 vf_ = __builtin_bit_cast(bf16x8, make_uint4(lo_.x, lo_.y, hi_.x, hi_.y)); \
        oa1 = mfma(vf_, fa_, oa1); ob1 = mfma(vf_, fb_, ob1); } } } while (0)
#define AT_TRIP64(t, FS, CS) do { \
    { const int tn_ = ((t) + 2 < NT) ? (t) + 2 : NT - 1; AT_FETCH_K(FS, tn_); AT_FETCH_V(FS, tn_); } \
    const char* ks = Kb0 + ((t) & 1) * AT_KSZ; const char* vs = Vb0 + ((t) & 1) * AT_VSZ; \
    { f32x16 sa0, sb0; \
      AT_QK_HALF(sa0, sb0, ks, 0); \
      AT_EXP(sa0, lsa); AT_EXP(sb0, lsb); \
      AT_PV_HALF(sa0, sb0, vs, 0); } \
    __builtin_amdgcn_sched_barrier(0); \
    { f32x16 sa1, sb1; \
      AT_QK_HALF(sa1, sb1, ks, 1); \
      AT_EXP(sa1, lsa); AT_EXP(sb1, lsb); \
      AT_PV_HALF(sa1, sb1, vs, 1); } \
    __builtin_amdgcn_sched_barrier(0); \
    AT_COMMIT_K(CS, ((t) + 1) & 1); AT_COMMIT_V(CS, ((t) + 1) & 1); \
    __syncthreads(); } while (0)
  AT_FETCH_K(A, 0); AT_FETCH_V(A, 0);
  AT_COMMIT_K(A, 0); AT_COMMIT_V(A, 0);
  AT_FETCH_K(B, 1); AT_FETCH_V(B, 1);
  __syncthreads();
  for (int t = 0; t < NT; t += 2) {
    AT_TRIP64(t, A, B);
    AT_TRIP64(t + 1, B, A);
  }
#undef AT_TRIP64
#undef AT_PV_HALF
#undef AT_EXP
#undef AT_QK_HALF
#undef AT_FETCH_K
#undef AT_FETCH_V
#undef AT_COMMIT_K
#undef AT_COMMIT_V
  lsa += __shfl_xor(lsa, 32); lsb += __shfl_xor(lsb, 32);
  const float ia = 1.f / lsa, ib = 1.f / lsb;
  char* stg = lds + w * (32 * 272);
#pragma unroll
  for (int blk = 0; blk < 2; ++blk) {
#pragma unroll
    for (int db = 0; db < 2; ++db)
#pragma unroll
      for (int g4 = 0; g4 < 4; ++g4) {
        const int dv = db * 32 + 8 * g4 + 4 * h;
        float4 v;
        if (blk == 0) { if (db == 0) v = make_float4(oa0[4 * g4] * ia, oa0[4 * g4 + 1] * ia, oa0[4 * g4 + 2] * ia, oa0[4 * g4 + 3] * ia);
                        else         v = make_float4(oa1[4 * g4] * ia, oa1[4 * g4 + 1] * ia, oa1[4 * g4 + 2] * ia, oa1[4 * g4 + 3] * ia); }
        else          { if (db == 0) v = make_float4(ob0[4 * g4] * ib, ob0[4 * g4 + 1] * ib, ob0[4 * g4 + 2] * ib, ob0[4 * g4 + 3] * ib);
                        else         v = make_float4(ob1[4 * g4] * ib, ob1[4 * g4 + 1] * ib, ob1[4 * g4 + 2] * ib, ob1[4 * g4 + 3] * ib); }
        *(float4*)(stg + r * 272 + dv * 4) = v;
      }
    const SgPre<4> gpre = staged_gate_fetch<32, 8, false>(lane, gatep + (long)(w * 64 + blk * 32) * NP, nullptr, NP);
    __syncthreads();
    staged_gate_finish<32, 8, 272, false>(stg, lane, gpre, mixp + (long)(w * 64 + blk * 32) * 1024, 1024);
    __syncthreads();
  }
}


__global__ void __launch_bounds__(NT_) fwd_megakernel(Params p) {
  extern __shared__ __attribute__((aligned(16))) char lds[];
  cg::grid_group grid = cg::this_grid();
  const int tid = threadIdx.x, bid = blockIdx.x, nblk = gridDim.x;
  __shared__ uint4 xb_words;
  if (tid == 0) xb_words = make_uint4(0u, 0u, 0u, 0u);
  __syncthreads();
  const XcdBarrier xb = xcd_barrier_post(p.bar, (volatile LAS unsigned*)&xb_words);
  const long gtid = (long)bid * NT_ + tid, gnth = (long)nblk * NT_;

  {
    float* tile = (float*)lds;
    constexpr int T_WIN = 16 * 35, T_WOUT = 16 * 16, T_WUQ = 4 * 12, T_WUKV = 2 * 16;
    constexpr int T_L = T_WIN + T_WOUT + T_WUQ + T_WUKV;
    struct TP { const float* src; u16* dst; const float* kg; int K, N, kt, nt, remap; };
    auto tparams = [&](int it) {
      TP q; const int l = it / T_L; int t = it % T_L;
      if (t < T_WIN) { q.src = p.w_in + (long)l * 1024 * INW; q.dst = p.win_t + (long)l * NP * 1024; q.K = 1024; q.N = INW; q.kt = t / 35; q.nt = t % 35; q.remap = 0; q.kg = nullptr; }
      else if ((t -= T_WIN) < T_WOUT) { q.src = p.w_out + (long)l * 1024 * 1024; q.dst = p.wout_t + (long)l * 1024 * 1024; q.K = 1024; q.N = 1024; q.kt = t / 16; q.nt = t % 16; q.remap = 0; q.kg = nullptr; }
      else if ((t -= T_WOUT) < T_WUQ) { q.src = p.w_uq + (long)l * 256 * 768; q.dst = p.wuq_t + (long)l * 768 * 256; q.K = 256; q.N = 768; q.kt = t / 12; q.nt = t % 12; q.remap = 0; q.kg = p.q_a_g + l * 256; }
      else { t -= T_WUQ; q.src = p.w_ukv + (long)l * 128 * 1024; q.dst = p.wukv_t + (long)l * 1024 * 128; q.K = 128; q.N = 1024; q.kt = t / 16; q.nt = t % 16; q.remap = 1; q.kg = p.kv_a_g + l * 128; }
      return q;
    };
    float pv[8];
    auto tload = [&](const TP& q) {
#pragma unroll
      for (int i = 0; i < 8; ++i) {
        const int kk = i * 8 + (tid >> 6), nn = tid & 63;
        const int n = q.nt * 64 + nn;
        pv[i] = (n < q.N) ? q.src[(long)(q.kt * 64 + kk) * q.N + n] * (q.kg ? q.kg[q.kt * 64 + kk] : 1.f) : 0.f;
      }
    };
    if (bid < T_L * DEPTH) { const TP q0 = tparams(bid); tload(q0); }
    for (int it = bid; it < T_L * DEPTH; it += nblk) {
      const TP q = tparams(it);
#pragma unroll
      for (int i = 0; i < 8; ++i) tile[(i * 8 + (tid >> 6)) * 65 + (tid & 63)] = pv[i];
      __syncthreads();
      if (it + nblk < T_L * DEPTH) { const TP qn = tparams(it + nblk); tload(qn); }
      {
        const int nl = tid >> 3, kc = (tid & 7) * 8;
        const int n = q.nt * 64 + nl;
        if (n < q.N) {
          int dn = n;
          if (q.remap) { const int hh = n >> 7, dd = n & 127; dn = (dd < 64) ? (hh * 64 + dd) : (512 + hh * 64 + dd - 64); }
          uint4 o;
          o.x = pk2(tile[(kc + 0) * 65 + nl], tile[(kc + 1) * 65 + nl]);
          o.y = pk2(tile[(kc + 2) * 65 + nl], tile[(kc + 3) * 65 + nl]);
          o.z = pk2(tile[(kc + 4) * 65 + nl], tile[(kc + 5) * 65 + nl]);
          o.w = pk2(tile[(kc + 6) * 65 + nl], tile[(kc + 7) * 65 + nl]);
          *(uint4*)(q.dst + (long)dn * q.K + q.kt * 64 + kc) = o;
        }
      }
      __syncthreads();
    }
    for (long i = gtid; i < (long)DEPTH * (NP - INW) * 1024; i += gnth) {
      const int l = (int)(i / ((NP - INW) * 1024)); const long rem = i % ((NP - INW) * 1024);
      p.win_t[((long)l * NP + INW) * 1024 + rem] = 0;
    }
    for (long i = gtid; i < (long)DEPTH * 4 * 128 * 128; i += gnth) p.gws_b[i] = f2bf(p.g_ws[i]);
    for (long i = gtid; i < 128 * 64; i += gnth) {
      const int rho = (int)(i >> 6), n1 = (int)(i & 63);
      const int blk = rho >> 5, k1 = (blk >> 1) * 32 + (rho & 31), part = blk & 1;
      const int mm = (k1 * n1) & 63;
      p.t1[i] = f2bf(part == 0 ? cospif(mm * (1.f / 32.f)) : -sinpif(mm * (1.f / 32.f)));
    }
    for (long i = gtid; i < 128 * 128; i += gnth) {
      const int rho = (int)(i >> 7), kk = (int)(i & 127);
      const int rio = rho >> 6, k2 = rho & 63, n2 = kk >> 1, rii = kk & 1;
      const int mm = (n2 * k2) & 63;
      const float c = cospif(mm * (1.f / 32.f)), s = sinpif(mm * (1.f / 32.f));
      p.t2[i] = f2bf(rio == 0 ? (rii == 0 ? c : s) : (rii == 0 ? -s : c));
    }
    for (long i = gtid; i < 512 * 256; i += gnth) {
      const int rho = (int)(i >> 8), n = (int)(i & 255);
      const int ri = rho >> 8, k = rho & 255;
      const int mm = (k * n) & 255;
      p.t256[i] = f2bf(ri == 0 ? cospif(mm * (1.f / 128.f)) : -sinpif(mm * (1.f / 128.f)));
    }
    for (long i = gtid; i < 4096; i += gnth) {
      p.tw[2 * i] = cospif((float)i * (1.f / 2048.f)); p.tw[2 * i + 1] = sinpif((float)i * (1.f / 2048.f));
    }
    for (long i = gtid; i < 64 * 8; i += gnth) {
      const int pos = (int)(i >> 3), jj = (int)(i & 7);
      const float ang = (float)pos * exp2f(-(float)jj * 1.6609640474436813f);
      p.rope[2 * i] = __cosf(ang); p.rope[2 * i + 1] = __sinf(ang);
    }
    for (long i = gtid; i < (long)DEPTH * 256 * 512; i += gnth) {
      const int n = (int)(i & 255), kidx = (int)((i >> 8) & 511), l = (int)(i >> 17);
      const int g = kidx >> 7, j = kidx & 127, jj = j & 63;
      const float* wf = p.w_fmix + (long)l * 256 * 256 + (long)(g * 64) * 256 + n;
      float acc = 0.f;
      for (int c0 = 0; c0 < 64; c0 += 16) {
        float wv[16];
#pragma unroll
        for (int u = 0; u < 16; ++u) wv[u] = wf[(long)(c0 + u) * 256];
#pragma unroll
        for (int u = 0; u < 16; ++u) {
          const int mm = (jj * (c0 + u)) & 63;
          const float coef = (j < 64) ? cospif(mm * (1.f / 32.f)) : sinpif(mm * (1.f / 32.f));
          acc += coef * wv[u];
        }
      }
      p.mf_t[((long)l * 256 + n) * 512 + kidx] = f2bf(acc);
    }
    {
      float* sl = (float*)lds;
      float* red = sl + 9 * 1024;
      __syncthreads();
      for (int i = tid; i < 9 * 1024; i += NT_) {
        const int rr = i >> 10, kk = i & 1023;
        const float v = (rr < 8) ? p.c[rr * 1024 + kk] : p.c_ctx[kk];
        sl[i] = silu(v);
      }
      __syncthreads();
      for (int it = bid; it < DEPTH * 96; it += nblk) {
        const int l = it / 96, cgp = it % 96;
        const int cj = tid & 31, ksl = tid >> 5;
        const float* wm = p.w_mod + (long)l * 1024 * 3072 + cgp * 32 + cj;
        float a[9];
#pragma unroll
        for (int rr = 0; rr < 9; ++rr) a[rr] = 0.f;
        for (int k0 = ksl * 64; k0 < ksl * 64 + 64; k0 += 16) {
          float wv[16];
#pragma unroll
          for (int u = 0; u < 16; ++u) wv[u] = wm[(long)(k0 + u) * 3072];
#pragma unroll
          for (int u = 0; u < 16; ++u)
#pragma unroll
            for (int rr = 0; rr < 9; ++rr) a[rr] += sl[rr * 1024 + k0 + u] * wv[u];
        }
#pragma unroll
        for (int rr = 0; rr < 9; ++rr) red[(ksl * 9 + rr) * 32 + cj] = a[rr];
        __syncthreads();
        if (tid < 288) {
          const int rr = tid >> 5, c2 = tid & 31;
          float s = 0.f;
          for (int q = 0; q < 16; ++q) s += red[(q * 9 + rr) * 32 + c2];
          const int col = cgp * 32 + c2;
          p.mod[((long)l * 9 + rr) * 3072 + col] = s + p.b_mod[l * 3072 + col];
        }
        __syncthreads();
      }
    }
  }
  grid.sync();

  for (int l = 0; l < DEPTH; ++l) {
    const int tid = ltid();
    const float* modl = p.mod + (long)l * 9 * 3072;
    {
      const float* ng = p.norm_g + l * 1024;
      const int lane = tid & 63, wv = tid >> 6;
      float4 g4[4];
#pragma unroll
      for (int i = 0; i < 4; ++i) g4[i] = *(const float4*)(ng + i * 256 + lane * 4);
      const int rstep = nblk * 8;
      float4 v[4], sh[4], sc[4];
#define N_LOAD(row_, vv, shh, scc) do { \
        const int rw_ = (row_) < MT ? (row_) : MT - 1; \
        const float* src_; int mr_; \
        if (rw_ < MX) { src_ = (l == 0 ? p.x : p.out) + (long)rw_ * 1024; mr_ = rw_ >> 12; } \
        else { src_ = (l == 0 ? p.ctx : p.yw) + (long)(rw_ - MX) * 1024; mr_ = 8; } \
        const float* md_ = modl + mr_ * 3072; \
        _Pragma("unroll") for (int i = 0; i < 4; ++i) { const int k0_ = i * 256 + lane * 4; \
          vv[i] = *(const float4*)(src_ + k0_); shh[i] = *(const float4*)(md_ + k0_); scc[i] = *(const float4*)(md_ + 1024 + k0_); } } while (0)
      int row = bid * 8 + wv;
      N_LOAD(row, v, sh, sc);
      for (; row < MT; row += rstep) {
        float4 vn[4], shn[4], scn[4];
        N_LOAD(row + rstep, vn, shn, scn);
        float ss = 0.f;
#pragma unroll
        for (int i = 0; i < 4; ++i) ss += v[i].x * v[i].x + v[i].y * v[i].y + v[i].z * v[i].z + v[i].w * v[i].w;
#pragma unroll
        for (int o = 1; o < 64; o <<= 1) ss += __shfl_xor(ss, o);
        const float rs = rsqrtf(ss * (1.f / 1024.f) + EPS);
#pragma unroll
        for (int i = 0; i < 4; ++i) {
          const int k0 = i * 256 + lane * 4;
          uint2 o;
          o.x = pk2(v[i].x * rs * g4[i].x * (1.f + sc[i].x) + sh[i].x, v[i].y * rs * g4[i].y * (1.f + sc[i].y) + sh[i].y);
          o.y = pk2(v[i].z * rs * g4[i].z * (1.f + sc[i].z) + sh[i].z, v[i].w * rs * g4[i].w * (1.f + sc[i].w) + sh[i].w);
          *(uint2*)(p.hmix + (long)row * 1024 + k0) = o;
        }
#pragma unroll
        for (int i = 0; i < 4; ++i) { v[i] = vn[i]; sh[i] = shn[i]; sc[i] = scn[i]; }
      }
#undef N_LOAD
    }
    xcd_barrier(xb);

    {
      const u16* wt = p.win_t + (long)l * NP * 1024;
      u16* P = p.p;
      int m0 = 0, n0 = 0;
      auto epi = [&](auto& acc, int mw, int nw, int r, int h) {
        constexpr int WM_ = sizeof(acc) / sizeof(acc[0]), WN_ = sizeof(acc[0]) / sizeof(acc[0][0]);
        constexpr int SP = WN_ * 64 + 16;
        constexpr int CH = WN_ * 4;
        const int wv = ltid() >> 6, lane = h * 32 + r;
        char* st = lds + wv * (WM_ * 32 * SP);
        if (n0 + nw >= C_CQ && n0 + nw < C_KROPE) {
#pragma unroll
          for (int i = 0; i < WM_; ++i)
#pragma unroll
            for (int j = 0; j < WN_; ++j) {
              float ss = 0.f;
#pragma unroll
              for (int e = 0; e < 16; ++e) ss += acc[i][j][e] * acc[i][j][e];
              ss += __shfl_xor(ss, 32);
              if (h == 0) p.stats[(long)(m0 + mw + i * 32 + r) * 16 + ((n0 + nw + j * 32 - C_CQ) >> 5)] = ss;
            }
        }
#pragma unroll
        for (int i = 0; i < WM_; ++i)
#pragma unroll
          for (int j = 0; j < WN_; ++j)
#pragma unroll
            for (int g4 = 0; g4 < 4; ++g4) {
              uint2 o;
              o.x = pk2(acc[i][j][4 * g4], acc[i][j][4 * g4 + 1]); o.y = pk2(acc[i][j][4 * g4 + 2], acc[i][j][4 * g4 + 3]);
              *(uint2*)(st + (i * 32 + r) * SP + (j * 32 + 8 * g4 + 4 * h) * 2) = o;
            }
        __syncthreads();
#pragma unroll
        for (int q = 0; q < WM_ * 32 * CH / 64; ++q) {
          const int id = q * 64 + lane; const int row = id / CH, c = id % CH;
          const uint4 v = *(const uint4*)(st + row * SP + c * 16);
          *(uint4*)(P + (long)(m0 + mw + row) * NP + n0 + nw + c * 8) = v;
        }
        __syncthreads();
      };
      {
        auto mkl = [&](int j, LdDirect<256>& la, LdDirect<128>& lb) {
          const int mt = (j / 18) * 8 + (bid & 7), nt = j % 18;
          la.base = p.hmix + (long)mt * 256 * 1024; la.ld = 1024; lb.base = wt + (long)nt * 128 * 1024; lb.ld = 1024; };
        auto set = [&](int j) { m0 = ((j / 18) * 8 + (bid & 7)) * 256; n0 = (j % 18) * 128; };
        gemm_loop3<16, 4, 2, 2, true, false, LdDirect<256>, LdDirect<128>>(bid >> 3, 16 * 18, nblk >> 3, mkl, set, epi, lds);
      }
      {
        const int nty = (l == DEPTH - 1) ? 3 : 36, nt0 = (l == DEPTH - 1) ? 24 : 0;
        auto mkl = [&](int it, LdDirect<128>& la, LdDirect<64>& lb) {
          const int mt = it / nty, nt = nt0 + it % nty;
          la.base = p.hmix + (long)(MX + mt * 128) * 1024; la.ld = 1024; lb.base = wt + (long)nt * 64 * 1024; lb.ld = 1024; };
        auto set = [&](int it) { m0 = MX + (it / nty) * 128; n0 = (nt0 + it % nty) * 64; };
        gemm_loop<4, 1, 1, true, false, LdDirect<128>, LdDirect<64>>(bid, 16 * nty, nblk, mkl, set, epi, 16, lds);
      }
    }
    xcd_barrier(xb);

    {
      constexpr int nKN = 136 * 4, nV = 136 * 4, nF1 = 1024;
      const int nQ = (l == DEPTH - 1) ? 256 * 4 : 272 * 4, nFy = (l == DEPTH - 1) ? 0 : 64, nG = (l == DEPTH - 1) ? 256 : 272;
      float* rstd_s = (float*)(lds + RSTD_OFF);
#define FIRST(off) ((bid + nblk - ((off) % nblk)) % nblk)
      {
        int m0 = 0, n0 = 0;
        auto mkl = [&](int it, LdDirect<128>& la, LdDirect<192>& lb) {
          const int mt = it >> 2, nt = it & 3;
          la.base = p.p + (long)mt * 128 * NP + C_CQ; la.ld = NP;
          lb.base = p.wuq_t + ((long)l * 768 + nt * 192) * 256; lb.ld = 256; };
        auto set = [&](int it) { m0 = (it >> 2) * 128; n0 = (it & 3) * 192; };
        const float* qg = p.q_norm_g + l * 96;
        u16* Qb = p.q; const float* ROPE = p.rope;
        auto epi = [&](f32x16 (&acc)[1][3], int mw, int nw, int r, int h) {
          const int head = (n0 + nw) / 96;
          const float QS = 0.10206207261596575f * 1.4426950408889634f;
          const int m = m0 + mw + r;
          float ss = 0.f;
#pragma unroll
          for (int j = 0; j < 3; ++j)
#pragma unroll
            for (int e = 0; e < 16; ++e) ss += acc[0][j][e] * acc[0][j][e];
          ss += __shfl_xor(ss, 32);
          const float4 sa = *(const float4*)(p.stats + (long)m * 16), sb = *(const float4*)(p.stats + (long)m * 16 + 4);
          const float msq = (sa.x + sa.y + sa.z + sa.w + sb.x + sb.y + sb.z + sb.w) * (1.f / 256.f) + EPS;
          const float rs = rsqrtf(ss * (1.f / 96.f) + EPS * msq);
          int b, pos; bool isx; int irow = 0, icol = 0;
          if (m < MX) { b = m >> 12; const int n = m & 4095; pos = CTX + n; isx = true; irow = n >> 6; icol = n & 63; }
          else { const int my = m - MX; b = my >> 8; pos = my & 255; isx = false; }
          float2 tr[4], tc[4];
#pragma unroll
          for (int e = 0; e < 4; ++e) { tr[e] = *(const float2*)(ROPE + (irow * 8 + 4 * h + e) * 2); tc[e] = *(const float2*)(ROPE + (icol * 8 + 4 * h + e) * 2); }
          const int wv = ltid() >> 6;
          char* stg = lds + wv * (32 * 208);
          u16* qd = (u16*)(stg + r * 208);
#pragma unroll
          for (int j = 0; j < 2; ++j)
#pragma unroll
            for (int g4 = 0; g4 < 4; ++g4) {
              const int f0 = j * 32 + 8 * g4 + 4 * h;
              const float4 g = *(const float4*)(qg + f0);
              uint2 o;
              o.x = pk2(acc[0][j][4 * g4] * rs * g.x * QS, acc[0][j][4 * g4 + 1] * rs * g.y * QS);
              o.y = pk2(acc[0][j][4 * g4 + 2] * rs * g.z * QS, acc[0][j][4 * g4 + 3] * rs * g.w * QS);
              *(uint2*)(qd + f0) = o;
            }
          float x1[4], x2[4], x3[4], x4[4];
          {
            const float4 g1 = *(const float4*)(qg + 64 + 4 * h), g2 = *(const float4*)(qg + 72 + 4 * h);
            const float4 g3 = *(const float4*)(qg + 80 + 4 * h), g4v = *(const float4*)(qg + 88 + 4 * h);
            const float s = rs * QS;
            x1[0] = acc[0][2][0] * s * g1.x; x1[1] = acc[0][2][1] * s * g1.y; x1[2] = acc[0][2][2] * s * g1.z; x1[3] = acc[0][2][3] * s * g1.w;
            x2[0] = acc[0][2][4] * s * g2.x; x2[1] = acc[0][2][5] * s * g2.y; x2[2] = acc[0][2][6] * s * g2.z; x2[3] = acc[0][2][7] * s * g2.w;
            x3[0] = acc[0][2][8] * s * g3.x; x3[1] = acc[0][2][9] * s * g3.y; x3[2] = acc[0][2][10] * s * g3.z; x3[3] = acc[0][2][11] * s * g3.w;
            x4[0] = acc[0][2][12] * s * g4v.x; x4[1] = acc[0][2][13] * s * g4v.y; x4[2] = acc[0][2][14] * s * g4v.z; x4[3] = acc[0][2][15] * s * g4v.w;
          }
          if (isx) {
#pragma unroll
            for (int e = 0; e < 4; ++e) {
              const float cr = tr[e].x, sr = tr[e].y, cc = tc[e].x, sc = tc[e].y;
              const float a1 = x1[e] * cr - x2[e] * sr, a2 = x2[e] * cr + x1[e] * sr;
              const float a3 = x3[e] * cc - x4[e] * sc, a4 = x4[e] * cc + x3[e] * sc;
              x1[e] = a1; x2[e] = a2; x3[e] = a3; x4[e] = a4;
            }
          }
          uint2 o;
          o.x = pk2(x1[0], x1[1]); o.y = pk2(x1[2], x1[3]); *(uint2*)(qd + 64 + 4 * h) = o;
          o.x = pk2(x2[0], x2[1]); o.y = pk2(x2[2], x2[3]); *(uint2*)(qd + 72 + 4 * h) = o;
          o.x = pk2(x3[0], x3[1]); o.y = pk2(x3[2], x3[3]); *(uint2*)(qd + 80 + 4 * h) = o;
          o.x = pk2(x4[0], x4[1]); o.y = pk2(x4[2], x4[3]); *(uint2*)(qd + 88 + 4 * h) = o;
          __syncthreads();
          {
            const int m_0 = m0 + mw;
            int b0, pos0;
            if (m_0 < MX) { b0 = m_0 >> 12; pos0 = CTX + (m_0 & 4095); } else { const int my = m_0 - MX; b0 = my >> 8; pos0 = my & 255; }
            u16* dst = Qb + ((long)(b0 * 8 + head) * KPOS + pos0) * 96;
            const int lane = h * 32 + r;
#pragma unroll
            for (int q = 0; q < 6; ++q) {
              const int id = q * 64 + lane; const int row = id / 12, c = id % 12;
              *(uint4*)(dst + id * 8) = *(const uint4*)(stg + row * 208 + c * 16);
            }
          }
          __syncthreads();
        };
        gemm_loop<4, 1, 3, true, false, LdDirect<128>, LdDirect<192>>(FIRST(0), nQ, nblk, mkl, set, epi, 4, lds);
      }
      {
        int m0 = 0, n0 = 0;
        auto set = [&](int it) { m0 = (it >> 2) * 256; n0 = (it & 3) * 128; };
        {
          auto mkl = [&](int it, LdDirect<256>& la, LdDirect<128>& lb) {
            const int mt = it >> 2, nt = it & 3;
            la.base = p.p + (long)mt * 256 * NP + C_CKV; la.ld = NP;
            lb.base = p.wukv_t + ((long)l * 1024 + nt * 128) * 128; lb.ld = 128; };
          const float* kg = p.k_norm_g + l * 96;
          u16* Kb = p.k; const u16* P = p.p; const float* ROPE = p.rope;
          auto epi = [&](f32x16 (&acc)[2][2], int mw, int nw, int r, int h) {
            const int head = (n0 + nw) >> 6;
#pragma unroll
            for (int i = 0; i < 2; ++i) {
              const int m = m0 + mw + i * 32 + r;
              float kr[16];
              { const u16* kp = P + (long)m * NP + C_KROPE + 16 * h;
                unpack8(*(const uint4*)kp, kr); unpack8(*(const uint4*)(kp + 8), kr + 8); }
              int b, pos; bool isx; int ipos = 0;
              if (m < MX) { b = m >> 12; const int n = m & 4095; pos = CTX + n; isx = true; ipos = h ? (n & 63) : (n >> 6); }
              else { const int my = m - MX; b = my >> 8; pos = my & 255; isx = false; }
              float2 tr[8];
#pragma unroll
              for (int e = 0; e < 8; ++e) tr[e] = *(const float2*)(ROPE + (ipos * 8 + e) * 2);
              const float4 sk = *(const float4*)(p.stats + (long)m * 16 + 8);
              const float rkv2 = 1.f / ((sk.x + sk.y + sk.z + sk.w) * (1.f / 128.f) + EPS);
              float ssr = 0.f, ssn = 0.f;
#pragma unroll
              for (int e = 0; e < 16; ++e) ssr += kr[e] * kr[e];
#pragma unroll
              for (int j = 0; j < 2; ++j)
#pragma unroll
                for (int e = 0; e < 16; ++e) ssn += acc[i][j][e] * acc[i][j][e];
              float ss = ssr + ssn * rkv2;
              ss += __shfl_xor(ss, 32);
              const float rs = rsqrtf(ss * (1.f / 96.f) + EPS);
              const float rsn = rs * sqrtf(rkv2);
              u16* kd = (u16*)(lds + (ltid() >> 6) * (64 * 208) + (i * 32 + r) * 208);
#pragma unroll
              for (int j = 0; j < 2; ++j)
#pragma unroll
                for (int g4 = 0; g4 < 4; ++g4) {
                  const int f0 = j * 32 + 8 * g4 + 4 * h;
                  const float4 g = *(const float4*)(kg + f0);
                  uint2 o;
                  o.x = pk2(acc[i][j][4 * g4] * rsn * g.x, acc[i][j][4 * g4 + 1] * rsn * g.y);
                  o.y = pk2(acc[i][j][4 * g4 + 2] * rsn * g.z, acc[i][j][4 * g4 + 3] * rsn * g.w);
                  *(uint2*)(kd + f0) = o;
                }
              float oa[8], ob[8];
#pragma unroll
              for (int e = 0; e < 8; ++e) {
                const float xa = kr[e] * rs * kg[64 + 16 * h + e], xb = kr[8 + e] * rs * kg[64 + 16 * h + 8 + e];
                if (isx) { const float cs = tr[e].x, sn = tr[e].y; oa[e] = xa * cs - xb * sn; ob[e] = xb * cs + xa * sn; }
                else { oa[e] = xa; ob[e] = xb; }
              }
              uint4 o;
              o.x = pk2(oa[0], oa[1]); o.y = pk2(oa[2], oa[3]); o.z = pk2(oa[4], oa[5]); o.w = pk2(oa[6], oa[7]);
              *(uint4*)(kd + 64 + 16 * h) = o;
              o.x = pk2(ob[0], ob[1]); o.y = pk2(ob[2], ob[3]); o.z = pk2(ob[4], ob[5]); o.w = pk2(ob[6], ob[7]);
              *(uint4*)(kd + 64 + 16 * h + 8) = o;
            }
            __syncthreads();
            {
              const char* stg = lds + (ltid() >> 6) * (64 * 208);
              const int m_0 = m0 + mw;
              int b0, pos0;
              if (m_0 < MX) { b0 = m_0 >> 12; pos0 = CTX + (m_0 & 4095); } else { const int my = m_0 - MX; b0 = my >> 8; pos0 = my & 255; }
              u16* dst = Kb + ((long)(b0 * 8 + head) * KPOS + pos0) * 96;
              const int lane = h * 32 + r;
#pragma unroll
              for (int q = 0; q < 12; ++q) {
                const int id = q * 64 + lane; const int row = id / 12, c = id % 12;
                *(uint4*)(dst + id * 8) = *(const uint4*)(stg + row * 208 + c * 16);
              }
            }
            __syncthreads();
          };
          gemm_loop<4, 2, 2, true, false, LdDirect<256>, LdDirect<128>>(FIRST(64), nKN, nblk, mkl, set, epi, 2, lds);
        }
        {
          auto mkl = [&](int it, LdDirect<256>& la, LdDirect<128>& lb) {
            const int mt = it >> 2, nt = it & 3;
            la.base = p.p + (long)mt * 256 * NP + C_CKV; la.ld = NP;
            lb.base = p.wukv_t + ((long)l * 1024 + 512 + nt * 128) * 128; lb.ld = 128; };
          u16* VT = p.vt;
          auto epi = [&](f32x16 (&acc)[2][2], int mw, int nw, int r, int h) {
            char* stg = lds + (ltid() >> 6) * (64 * 144);
            const int m_0 = m0 + mw;
#pragma unroll
            for (int i = 0; i < 2; ++i)
#pragma unroll
              for (int g4 = 0; g4 < 4; ++g4) {
                const int tl = i * 32 + 8 * g4 + 4 * h;
                float rv[4];
#pragma unroll
                for (int e = 0; e < 4; ++e) { const float4 sk = *(const float4*)(p.stats + (long)(m_0 + tl + e) * 16 + 8);
                  rv[e] = rsqrtf((sk.x + sk.y + sk.z + sk.w) * (1.f / 128.f) + EPS); }
#pragma unroll
                for (int j = 0; j < 2; ++j) {
                  uint2 o;
                  o.x = pk2(acc[i][j][4 * g4] * rv[0], acc[i][j][4 * g4 + 1] * rv[1]); o.y = pk2(acc[i][j][4 * g4 + 2] * rv[2], acc[i][j][4 * g4 + 3] * rv[3]);
                  *(uint2*)(stg + (j * 32 + r) * 144 + tl * 2) = o;
                }
              }
            __syncthreads();
            {
              int b0, pos0;
              if (m_0 < MX) { b0 = m_0 >> 12; pos0 = CTX + (m_0 & 4095); } else { const int my = m_0 - MX; b0 = my >> 8; pos0 = my & 255; }
              const int head = (n0 + nw) >> 6;
              u16* dst = VT + ((long)(b0 * 8 + head) * 64) * KPOS + pos0;
              const int lane = h * 32 + r;
#pragma unroll
              for (int q = 0; q < 8; ++q) {
                const int id = q * 64 + lane; const int dv = id >> 3, c = id & 7;
                *(uint4*)(dst + (long)dv * KPOS + c * 8) = *(const uint4*)(stg + dv * 144 + c * 16);
              }
            }
            __syncthreads();
          };
          gemm_loop<4, 2, 2, false, false, LdDirect<256>, LdDirect<128>>(FIRST(96), nV, nblk, mkl, set, epi, 2, lds);
        }
      }
      {
        int half = 0, n2 = 0, b = 0;
        auto mkl = [&](int it, LdDirect<128>& la, LdTrans<128>& lb) {
          const int half_ = it & 1, n2_ = (it >> 1) & 63, b_ = it >> 7;
          la.base = p.t1; la.ld = 64;
          lb.base = p.p + (long)(b_ * 4096 + n2_) * NP + C_FIN + half_ * 128; lb.strideK = 64L * NP; };
        auto set = [&](int it) { half = it & 1; n2 = (it >> 1) & 63; b = it >> 7; };
        u16* A1 = p.a1; const float* TW = p.tw;
        auto epi = [&](f32x16 (&acc)[2][1], int mw, int nw, int r, int h) {
          const int gc = half * 128 + nw + r;
          float2 t[16];
#pragma unroll
          for (int e = 0; e < 16; ++e) { const float fr = (float)(n2 * ((mw >> 1) + crow(e, h))) * (1.f / 4096.f);
            t[e] = make_float2(__builtin_amdgcn_cosf(fr), __builtin_amdgcn_sinf(fr)); }
#pragma unroll
          for (int e = 0; e < 16; ++e) {
            const int k1 = (mw >> 1) + crow(e, h);
            const float re = acc[0][0][e], im = acc[1][0][e];
            const float re2 = re * t[e].x + im * t[e].y, im2 = im * t[e].x - re * t[e].y;
            const long o = ((((long)b * 64 + k1) * 64 + n2) * 2) * 256 + gc;
            A1[o] = f2bf(re2); A1[o + 256] = f2bf(im2);
          }
        };
        gemm_loop<2, 2, 1, false, true, LdDirect<128>, LdTrans<128>>(FIRST(0), nF1, nblk, mkl, set, epi, 1, lds);
      }
      {
        int half = 0, mt = 0, b = 0;
        auto mkl = [&](int it, LdDirect<128>& la, LdTrans<128>& lb) {
          const int half_ = it & 1, mt_ = (it >> 1) & 3, b_ = it >> 3;
          la.base = p.t256 + (long)mt_ * 128 * 256; la.ld = 256;
          lb.base = p.p + (long)(MX + b_ * 256) * NP + C_FIN + half_ * 128; lb.strideK = (long)NP; };
        auto set = [&](int it) { half = it & 1; mt = (it >> 1) & 3; b = it >> 3; };
        u16* YF = p.yf;
        auto epi = [&](f32x16 (&acc)[1][2], int mw, int nw, int r, int h) {
#pragma unroll
          for (int j = 0; j < 2; ++j) {
            const int gc = half * 128 + nw + j * 32 + r; const int g = gc >> 6, c2 = gc & 63;
#pragma unroll
            for (int e = 0; e < 16; ++e) {
              const int rho = mt * 128 + mw + crow(e, h); const int ri = rho >> 8, k = rho & 255;
              YF[(long)(MX + b * 256 + k) * 512 + g * 128 + ri * 64 + c2] = f2bf(acc[0][j][e]);
            }
          }
        };
        gemm_loop<4, 1, 2, false, true, LdDirect<128>, LdTrans<128>>(FIRST(128), nFy, nblk, mkl, set, epi, 4, lds);
      }
      {
        int hd = 0, row0 = 0;
        auto mkl = [&](int it, LdDirect<128>& la, LdLN4& lb) {
          const int hd_ = it & 3, qd_ = it >> 2;
          la.base = p.gws_b + (long)(l * 4 + hd_) * 128 * 128; la.ld = 128;
          lb.base = p.p + (long)qd_ * 512 * NP + C_GV + hd_ * 64; lb.g = p.g_ln_g + l * 64; };
        auto set = [&](int it) { hd = it & 3; row0 = (it >> 2) * 512; };
        const u16* P = p.p; u16* MIX = p.hmix;
        auto epi = [&](f32x16 (&acc)[1][4], int mw, int nw, int r, int h) {
          const float bias = p.g_bs[(l * 4 + hd) * 128 + mw + r];
          char* stg = lds + (ltid() >> 6) * (32 * 272);
#pragma unroll
          for (int jj = 0; jj < 2; ++jj) {
#pragma unroll
            for (int j2 = 0; j2 < 2; ++j2)
#pragma unroll
              for (int g4 = 0; g4 < 4; ++g4)
                *(float4*)(stg + r * 272 + (j2 * 32 + 8 * g4 + 4 * h) * 4) =
                    make_float4(acc[0][2 * jj + j2][4 * g4] + bias, acc[0][2 * jj + j2][4 * g4 + 1] + bias, acc[0][2 * jj + j2][4 * g4 + 2] + bias, acc[0][2 * jj + j2][4 * g4 + 3] + bias);
            const long row_w = row0 + ((nw >> 6) + jj) * 128 + mw;
            const SgPre<4> gpre = staged_gate_fetch<32, 8, true>(h * 32 + r, P + row_w * NP + C_GGATE + hd * 64, P + row_w * NP + C_GU + hd * 64, NP);
            __syncthreads();
            staged_gate_finish<32, 8, 272, true>(stg, h * 32 + r, gpre, MIX + row_w * 1024 + 256 + hd * 64, 1024);
            __syncthreads();
          }
        };
        gemm_loop<4, 1, 4, true, true, LdDirect<128>, LdLN4>(FIRST(192), nG, nblk, mkl, set, epi, 2, lds);
      }
    }
    xcd_barrier(xb);

    {
      {
        int half = 0, k1 = 0, b = 0;
        auto mkl = [&](int it, LdDirect<128>& la, LdTrans<128>& lb) {
          const int half_ = it & 1, k1_ = (it >> 1) & 63, b_ = it >> 7;
          la.base = p.t2; la.ld = 128;
          lb.base = p.a1 + (((long)b_ * 64 + k1_) * 64 * 2) * 256 + half_ * 128; lb.strideK = 256L; };
        auto set = [&](int it) { half = it & 1; k1 = (it >> 1) & 63; b = it >> 7; };
        u16* YF = p.yf;
        auto epi = [&](f32x16 (&acc)[1][2], int mw, int nw, int r, int h) {
#pragma unroll
          for (int j = 0; j < 2; ++j) {
            const int gc = half * 128 + nw + j * 32 + r; const int g = gc >> 6, c2 = gc & 63;
#pragma unroll
            for (int e = 0; e < 16; ++e) {
              const int rho = mw + crow(e, h); const int ri = rho >> 6, k2 = rho & 63;
              YF[(long)(b * 4096 + k1 + 64 * k2) * 512 + g * 128 + ri * 64 + c2] = f2bf(acc[0][j][e]);
            }
          }
        };
        gemm_loop<4, 1, 2, false, true, LdDirect<128>, LdTrans<128>>(bid, 1024, nblk, mkl, set, epi, 2, lds);
      }
    {
      const u16* mf = p.mf_t + (long)l * 256 * 512;
      int m0 = 0, n0 = 0;
      auto mkl = [&](int it, LdDirect<256>& la, LdDirect<128>& lb) {
        const int mt = it >> 1, nt = it & 1;
        la.base = p.yf + (long)mt * 256 * 512; la.ld = 512; lb.base = mf + (long)nt * 128 * 512; lb.ld = 512; };
      auto set = [&](int it) { m0 = (it >> 1) * 256; n0 = (it & 1) * 128; };
      const u16* P = p.p; u16* MIX = p.hmix;
      auto epi = [&](f32x16 (&acc)[2][2], int mw, int nw, int r, int h) {
        const float sc = (m0 < MX) ? (1.f / 512.f) : (1.f / 128.f);
#pragma unroll
        for (int i = 0; i < 2; ++i) {
          u16 gv[2][16];
#pragma unroll
          for (int j = 0; j < 2; ++j)
#pragma unroll
            for (int e = 0; e < 16; ++e)
              gv[j][e] = P[(long)(m0 + mw + i * 32 + crow(e, h)) * NP + C_FGATE + n0 + nw + j * 32 + r];
#pragma unroll
          for (int j = 0; j < 2; ++j)
#pragma unroll
            for (int e = 0; e < 16; ++e)
              MIX[(long)(m0 + mw + i * 32 + crow(e, h)) * 1024 + n0 + nw + j * 32 + r] = f2bf(acc[i][j][e] * sc * silu(bf2f(gv[j][e])));
        }
      };
      gemm_loop<4, 2, 2, false, false, LdDirect<256>, LdDirect<128>>(128 * 2 + ((bid + nblk - 200) % nblk), (l == DEPTH - 1) ? 128 * 2 : 136 * 2, nblk, mkl, set, epi, 8, lds);
    }
      float negB;
      {
        float gq = 0.f, gk = 0.f;
        for (int i = 0; i < 96; ++i) { gq = fmaxf(gq, fabsf(p.q_norm_g[l * 96 + i])); gk = fmaxf(gk, fabsf(p.k_norm_g[l * 96 + i])); }
        negB = -(96.f * gq * gk * (0.10206207261596575f * 1.4426950408889634f) * 1.02f + 0.5f);
      }
      for (int it = bid; it < 512; it += nblk) {
        const int rnd = it / nblk; const int lb_ = it % nblk;
        int bh, qb;
        if (nblk == 256) { const int xcd = lb_ & 7, slot = lb_ >> 3; bh = rnd * 32 + xcd * 4 + (slot >> 3); qb = slot & 7; }
        else { bh = it >> 3; qb = it & 7; }
        const int b = bh >> 3, hd = bh & 7;
        const long bhoff = (long)(b * 8 + hd);
        const long row_base = (long)b * 4096 + qb * 512;
        attn_item64(p.q + bhoff * KPOS * 96, p.k + bhoff * KPOS * 96, p.vt + bhoff * 64 * KPOS, CTX + qb * 512, KPOS,
                    p.p + row_base * NP + C_AGATE + hd * 64, p.hmix + row_base * 1024 + 512 + hd * 64, lds);
      }
      if (l < DEPTH - 1) {
        for (int bh = (bid + nblk - 64) % nblk; bh < 64; bh += nblk) {
          const int b = bh >> 3, hd = bh & 7;
          const long bhoff = (long)(b * 8 + hd);
          const long row_base = (long)MX + b * 256;
          attn_item(p.q + bhoff * KPOS * 96, p.k + bhoff * KPOS * 96, p.vt + bhoff * 64 * KPOS, 0, CTX,
                    p.p + row_base * NP + C_AGATE + hd * 64, p.hmix + row_base * 1024 + 512 + hd * 64, negB, lds);
        }
      }
    }
    xcd_barrier(xb);

    {
      const u16* mf = p.mf_t + (long)l * 256 * 512;
      int m0 = 0, n0 = 0;
      auto mkl = [&](int it, LdDirect<256>& la, LdDirect<128>& lb) {
        const int mt = it >> 1, nt = it & 1;
        la.base = p.yf + (long)mt * 256 * 512; la.ld = 512; lb.base = mf + (long)nt * 128 * 512; lb.ld = 512; };
      auto set = [&](int it) { m0 = (it >> 1) * 256; n0 = (it & 1) * 128; };
      const u16* P = p.p; u16* MIX = p.hmix;
      auto epi = [&](f32x16 (&acc)[2][2], int mw, int nw, int r, int h) {
        const float sc = (m0 < MX) ? (1.f / 512.f) : (1.f / 128.f);
#pragma unroll
        for (int i = 0; i < 2; ++i) {
          u16 gv[2][16];
#pragma unroll
          for (int j = 0; j < 2; ++j)
#pragma unroll
            for (int e = 0; e < 16; ++e)
              gv[j][e] = P[(long)(m0 + mw + i * 32 + crow(e, h)) * NP + C_FGATE + n0 + nw + j * 32 + r];
#pragma unroll
          for (int j = 0; j < 2; ++j)
#pragma unroll
            for (int e = 0; e < 16; ++e)
              MIX[(long)(m0 + mw + i * 32 + crow(e, h)) * 1024 + n0 + nw + j * 32 + r] = f2bf(acc[i][j][e] * sc * silu(bf2f(gv[j][e])));
        }
      };
      gemm_loop<4, 2, 2, false, false, LdDirect<256>, LdDirect<128>>(bid, 128 * 2, nblk, mkl, set, epi, 8, lds);
    }
    xcd_barrier(xb);

    {
      const u16* wt = p.wout_t + (long)l * 1024 * 1024;
      int m0 = 0, n0 = 0;
      auto epi = [&](auto& acc, int mw, int nw, int r, int h) {
        constexpr int WM_ = sizeof(acc) / sizeof(acc[0]), WN_ = sizeof(acc[0]) / sizeof(acc[0][0]);
        const bool isx = m0 < MX;
        const float* __restrict__ src = isx ? (l == 0 ? p.x : p.out) + (long)m0 * 1024 : (l == 0 ? p.ctx : p.yw) + (long)(m0 - MX) * 1024;
        float* __restrict__ dst = isx ? p.out + (long)m0 * 1024 : p.yw + (long)(m0 - MX) * 1024;
        const float* gp = modl + (isx ? (m0 >> 12) : 8) * 3072 + 2048;
#pragma unroll
        for (int i = 0; i < WM_; ++i) {
          float old[WN_][16];
#pragma unroll
          for (int j = 0; j < WN_; ++j)
#pragma unroll
            for (int e = 0; e < 16; ++e)
              old[j][e] = src[(long)(mw + i * 32 + crow(e, h)) * 1024 + n0 + nw + j * 32 + r];
#pragma unroll
          for (int j = 0; j < WN_; ++j) {
            const float gt = gp[n0 + nw + j * 32 + r];
#pragma unroll
            for (int e = 0; e < 16; ++e)
              dst[(long)(mw + i * 32 + crow(e, h)) * 1024 + n0 + nw + j * 32 + r] = old[j][e] + gt * acc[i][j][e];
          }
        }
      };
      {
        auto mkl = [&](int j, LdDirect<256>& la, LdDirect<128>& lb) {
          const int mt = (j >> 3) * 8 + (bid & 7), nt = j & 7;
          la.base = p.hmix + (long)mt * 256 * 1024; la.ld = 1024; lb.base = wt + (long)nt * 128 * 1024; lb.ld = 1024; };
        auto set = [&](int j) { m0 = ((j >> 3) * 8 + (bid & 7)) * 256; n0 = (j & 7) * 128; };
        gemm_loop3<16, 4, 2, 2, false, false, LdDirect<256>, LdDirect<128>>(bid >> 3, 16 * 8, nblk >> 3, mkl, set, epi, lds);
      }
      if (l < DEPTH - 1) {
        auto mkl = [&](int it, LdDirect<128>& la, LdDirect<64>& lb) {
          const int mt = it >> 4, nt = it & 15;
          la.base = p.hmix + (long)(MX + mt * 128) * 1024; la.ld = 1024; lb.base = wt + (long)nt * 64 * 1024; lb.ld = 1024; };
        auto set = [&](int it) { m0 = MX + (it >> 4) * 128; n0 = (it & 15) * 64; };
        gemm_loop<4, 1, 1, false, false, LdDirect<128>, LdDirect<64>>(bid, 16 * 16, nblk, mkl, set, epi, 16, lds);
      }
    }
    if (l < DEPTH - 1) xcd_barrier(xb);
  }
}

static inline size_t al256(size_t x) { return (x + 255) / 256 * 256; }

extern "C" void kernel_launch(void* const* d_in, const int* in_sizes, int n_in,
                              void* d_out, int out_size, void* d_ws, size_t ws_size,
                              hipStream_t stream) {
  static int grid_blocks = 0;
  if (!grid_blocks) {
    int dev = 0, cus = 0, per_cu = 0;
    (void)hipGetDevice(&dev);
    (void)hipDeviceGetAttribute(&cus, hipDeviceAttributeMultiprocessorCount, dev);
    (void)hipFuncSetAttribute((const void*)fwd_megakernel, hipFuncAttributeMaxDynamicSharedMemorySize, LDS_BYTES);
    (void)hipOccupancyMaxActiveBlocksPerMultiprocessor(&per_cu, fwd_megakernel, NT_, LDS_BYTES);
    if (per_cu < 1) { fprintf(stderr, "occupancy query returned %d\n", per_cu); per_cu = 1; }
    grid_blocks = cus;
  }
  Params p{};
  p.x = (const float*)d_in[0]; p.c = (const float*)d_in[1]; p.ctx = (const float*)d_in[2]; p.c_ctx = (const float*)d_in[3];
  p.w_mod = (const float*)d_in[4]; p.b_mod = (const float*)d_in[5]; p.norm_g = (const float*)d_in[6]; p.w_in = (const float*)d_in[7];
  p.w_fmix = (const float*)d_in[8]; p.g_ln_g = (const float*)d_in[9]; p.g_ws = (const float*)d_in[10]; p.g_bs = (const float*)d_in[11];
  p.q_a_g = (const float*)d_in[12]; p.w_uq = (const float*)d_in[13]; p.kv_a_g = (const float*)d_in[14]; p.w_ukv = (const float*)d_in[15];
  p.q_norm_g = (const float*)d_in[16]; p.k_norm_g = (const float*)d_in[17]; p.w_out = (const float*)d_in[18];
  p.out = (float*)d_out;
  char* ws = (char*)d_ws; size_t off = 0;
  auto take = [&](size_t bytes) { char* r = ws + off; off = al256(off + bytes); return r; };
  p.bar = (unsigned*)take((size_t)XCD_BAR_WORDS * 4);
  p.yw = (float*)take((size_t)MY * 1024 * 4);
  p.mod = (float*)take((size_t)DEPTH * 9 * 3072 * 4);
  p.tw = (float*)take(4096 * 2 * 4);
  p.rope = (float*)take(64 * 8 * 2 * 4);
  p.stats = (float*)take((size_t)MT * 16 * 4);
  p.win_t = (u16*)take((size_t)DEPTH * NP * 1024 * 2);
  p.wout_t = (u16*)take((size_t)DEPTH * 1024 * 1024 * 2);
  p.wuq_t = (u16*)take((size_t)DEPTH * 768 * 256 * 2);
  p.wukv_t = (u16*)take((size_t)DEPTH * 1024 * 128 * 2);
  p.gws_b = (u16*)take((size_t)DEPTH * 4 * 128 * 128 * 2);
  p.mf_t = (u16*)take((size_t)DEPTH * 256 * 512 * 2);
  p.t1 = (u16*)take(128 * 64 * 2);
  p.t2 = (u16*)take(128 * 128 * 2);
  p.t256 = (u16*)take(512 * 256 * 2);
  p.hmix = (u16*)take((size_t)MT * 1024 * 2);
  p.p = (u16*)take((size_t)MT * NP * 2);
  p.q = (u16*)take((size_t)NB * 8 * KPOS * 96 * 2);
  p.k = (u16*)take((size_t)NB * 8 * KPOS * 96 * 2);
  p.vt = (u16*)take((size_t)NB * 8 * 64 * KPOS * 2);
  p.a1 = (u16*)take((size_t)NB * 64 * 64 * 2 * 256 * 2);
  p.yf = (u16*)take((size_t)MT * 512 * 2);
  if (off > ws_size) { fprintf(stderr, "workspace too small: need %zu have %zu\n", off, ws_size); return; }
  (void)hipMemsetAsync(p.bar, 0, (size_t)XCD_BAR_WORDS * 4, stream);
  void* args[] = {&p};
  hipError_t e = hipLaunchCooperativeKernel((void*)fwd_megakernel, dim3(grid_blocks), dim3(NT_), args, LDS_BYTES, stream);
  if (e != hipSuccess) fprintf(stderr, "cooperative launch failed: %s (grid %d)\n", hipGetErrorString(e), grid_blocks);
}
```
